# Optimizing an MI355X kernel written in HIP

```python
import jax, jax.numpy as jnp
from jax import lax
import numpy as np

D_MODEL = 1024
BATCH = 8
SEQ = 4096
DEPTH = 2

HEAD_DIM = 64
ATTN_GROUPS = ((128, 1), (512, 4), (2048, 16))
N_GROUPS = 3
HEADS_PER_GROUP = 4
ATTN_WIDTH = N_GROUPS * HEADS_PER_GROUP * HEAD_DIM
ATTN_OUT = HEADS_PER_GROUP * HEAD_DIM
WIN_BLOCK = 128
ROPE_THETA = 10000.0

GMLP_CHUNK = 128
GMLP_GROUPS = 4
GMLP_GROUP_DIM = 128
GMLP_WIDTH = GMLP_GROUPS * GMLP_GROUP_DIM

N_EXPERTS = 32
TOP_K = 4
D_FF = D_MODEL
SWIGLU_ALPHA = 1.702
SWIGLU_LIMIT = 7.0
MOE_BLOCK = 128

N_BRANCH = 2
IN_WIDTH = 3 * ATTN_WIDTH + 2 * GMLP_WIDTH + N_BRANCH * D_MODEL
RMS_EPS = 1e-5
LN_EPS = 1e-5
NEG_INF = -1e30

kernel_name = "hybrid_dilated_attn_gmlp_moe_block"


def rmsnorm(x, g):
    xf = x.astype(jnp.float32)
    y = xf * lax.rsqrt(jnp.mean(xf * xf, axis=-1, keepdims=True) + RMS_EPS)
    return (y * g.astype(jnp.float32)).astype(x.dtype)


def layernorm(x, g, b):
    xf = x.astype(jnp.float32)
    mu = jnp.mean(xf, axis=-1, keepdims=True)
    var = jnp.mean(jnp.square(xf - mu), axis=-1, keepdims=True)
    y = (xf - mu) * lax.rsqrt(var + LN_EPS)
    return (y * g.astype(jnp.float32) + b.astype(jnp.float32)).astype(x.dtype)


def rope(x, positions):
    half = HEAD_DIM // 2
    inv_freq = ROPE_THETA ** (-jnp.arange(half, dtype=jnp.float32) / half)
    ang = positions.astype(jnp.float32)[..., None] * inv_freq
    cos = jnp.cos(ang)[:, :, None, :]
    sin = jnp.sin(ang)[:, :, None, :]
    xf = x.astype(jnp.float32)
    x1, x2 = xf[..., :half], xf[..., half:]
    out = jnp.concatenate([x1 * cos - x2 * sin, x2 * cos + x1 * sin], axis=-1)
    return out.astype(x.dtype)


def dilated_window_attention(q, k, v, window, dilation):
    B, S, H, Dh = q.shape
    r = dilation
    L = S // r
    wn = window // r
    nb = -(-L // WIN_BLOCK)
    Lp = nb * WIN_BLOCK

    def to_sub(t):
        t = t.reshape(B, L, r, H, Dh).transpose(0, 2, 1, 3, 4).reshape(B * r, L, H, Dh)
        t = jnp.pad(t, ((0, 0), (0, Lp - L), (0, 0), (0, 0)))
        return t.reshape(B * r, nb, WIN_BLOCK, H, Dh)

    qs, ks, vs = to_sub(q), to_sub(k), to_sub(v)

    def with_prev(t):
        prev = jnp.pad(t, ((0, 0), (1, 0), (0, 0), (0, 0), (0, 0)))[:, :-1]
        return jnp.concatenate([prev, t], axis=2)

    kb, vb = with_prev(ks), with_prev(vs)
    s = jnp.einsum('znqhd,znkhd->znhqk', qs.astype(jnp.float32), kb.astype(jnp.float32))
    s = s * (Dh ** -0.5)
    qi = jnp.arange(WIN_BLOCK)[:, None]
    kj = jnp.arange(2 * WIN_BLOCK)[None, :]
    dist = WIN_BLOCK + qi - kj
    band = (dist >= 0) & (dist <= wn)
    key_pos = jnp.arange(nb)[:, None, None] * WIN_BLOCK - WIN_BLOCK + kj
    valid = band[None] & (key_pos >= 0)
    s = jnp.where(valid[None, :, None], s, NEG_INF)
    m = jnp.max(s, axis=-1, keepdims=True)
    p = jnp.exp(s - m)
    den = jnp.sum(p, axis=-1, keepdims=True)
    o = jnp.einsum('znhqk,znkhd->znqhd', p, vb.astype(jnp.float32))
    o = o / den.transpose(0, 1, 3, 2, 4)
    lse = (m + jnp.log(den)).transpose(0, 1, 3, 2, 4)

    def from_sub(t):
        t = t.reshape(B, r, Lp, H, t.shape[-1])[:, :, :L]
        return t.transpose(0, 2, 1, 3, 4).reshape(B, S, H, t.shape[-1])

    return from_sub(o), from_sub(lse)


def token_mixers(h, positions, w_in, w_s, b_s, ln_g, ln_b, w_pa, w_pg, w_o):
    B, S, _ = h.shape
    proj = h @ w_in
    cuts = [ATTN_WIDTH, 2 * ATTN_WIDTH, 3 * ATTN_WIDTH,
            3 * ATTN_WIDTH + GMLP_WIDTH, 3 * ATTN_WIDTH + 2 * GMLP_WIDTH]
    q, k, v, u, vg, gates = jnp.split(proj, cuts, axis=-1)

    n_heads = N_GROUPS * HEADS_PER_GROUP
    grp = (B, S, N_GROUPS, HEADS_PER_GROUP, HEAD_DIM)
    q = rope(q.reshape(B, S, n_heads, HEAD_DIM), positions).reshape(grp)
    k = rope(k.reshape(B, S, n_heads, HEAD_DIM), positions).reshape(grp)
    v = v.reshape(grp)
    outs, lses = [], []
    for g, (win, dil) in enumerate(ATTN_GROUPS):
        o_g, l_g = dilated_window_attention(q[:, :, g], k[:, :, g], v[:, :, g], win, dil)
        outs.append(o_g)
        lses.append(l_g)
    o_all = jnp.stack(outs, axis=0)
    w_den = jax.nn.softmax(jnp.stack(lses, axis=0), axis=0)
    attn = jnp.sum(w_den * o_all, axis=0).reshape(B, S, ATTN_OUT).astype(h.dtype)

    u = jax.nn.gelu(u)
    vg = layernorm(jax.nn.gelu(vg), ln_g, ln_b)
    nc = S // GMLP_CHUNK
    vc = vg.reshape(B, nc, GMLP_CHUNK, GMLP_GROUPS, GMLP_GROUP_DIM)
    tri = jnp.tril(jnp.ones((GMLP_CHUNK, GMLP_CHUNK), dtype=bool))
    ws = jnp.where(tri[None], w_s, jnp.zeros_like(w_s))
    mixed = jnp.einsum('gts,bnsgc->bntgc', ws, vc) + b_s.T[None, None, :, :, None]
    gm = u * mixed.reshape(B, S, GMLP_WIDTH)

    g_a, g_g = jnp.split(gates, N_BRANCH, axis=-1)
    merged = jax.nn.sigmoid(g_a) * (attn @ w_pa) + jax.nn.sigmoid(g_g) * (gm @ w_pg)
    return merged @ w_o


def clamped_swiglu(hb):
    x_glu = jnp.minimum(hb[..., ::2], SWIGLU_LIMIT)
    x_lin = jnp.clip(hb[..., 1::2], -SWIGLU_LIMIT, SWIGLU_LIMIT)
    return x_glu * jax.nn.sigmoid(SWIGLU_ALPHA * x_glu) * (x_lin + 1)


def moe(h, w_router, b_router, w1, b1, w2, b2):
    B, S, D = h.shape
    N = B * S
    xt = h.reshape(N, D)
    logits = (xt @ w_router + b_router).astype(jnp.float32)
    top_vals, top_idx = lax.top_k(logits, TOP_K)
    gate = jax.nn.softmax(top_vals, axis=-1)

    A = N * TOP_K
    e_flat = top_idx.reshape(A)
    tok_flat = jnp.arange(A, dtype=jnp.int32) // TOP_K
    order = jnp.argsort(e_flat)
    e_sorted = e_flat[order]
    tok_sorted = tok_flat[order]
    gate_sorted = gate.reshape(A)[order]

    counts = jnp.zeros((N_EXPERTS,), jnp.int32).at[e_flat].add(1)
    start = jnp.cumsum(counts) - counts
    padded = (counts + MOE_BLOCK - 1) // MOE_BLOCK * MOE_BLOCK
    pad_end = jnp.cumsum(padded)
    pad_start = pad_end - padded
    rank = jnp.arange(A, dtype=jnp.int32) - start[e_sorted]
    dest = pad_start[e_sorted] + rank

    n_blocks = -(-A // MOE_BLOCK) + N_EXPERTS
    P = n_blocks * MOE_BLOCK
    buf = jnp.zeros((P, D), h.dtype).at[dest].set(xt[tok_sorted])
    block_start = jnp.arange(n_blocks, dtype=jnp.int32) * MOE_BLOCK
    block_e = jnp.minimum(jnp.searchsorted(pad_end, block_start, side='right'),
                          N_EXPERTS - 1).astype(jnp.int32)

    def expert_block(args):
        xb, e = args
        hb = xb @ w1[e] + b1[e]
        return clamped_swiglu(hb) @ w2[e] + b2[e]

    out = lax.map(expert_block, (buf.reshape(n_blocks, MOE_BLOCK, D), block_e))
    y_assign = out.reshape(P, D)[dest] * gate_sorted[:, None].astype(out.dtype)
    y = jax.ops.segment_sum(y_assign, tok_sorted, num_segments=N)
    return y.reshape(B, S, D).astype(h.dtype)


def setup_inputs(seed: int = 0) -> dict:
    key = jax.random.key(seed)
    ks = jax.random.split(key, 24)

    def nrm(k, shape, scale):
        return jax.random.normal(k, shape, jnp.float32) * scale

    x = nrm(ks[0], (BATCH, SEQ, D_MODEL), 1.0)
    c = nrm(ks[1], (BATCH, D_MODEL), 1.0)
    positions = (jax.random.randint(ks[2], (BATCH, 1), 0, 1024, dtype=jnp.int32)
                 + jnp.arange(SEQ, dtype=jnp.int32)[None, :])
    return {
        "x": x,
        "c": c,
        "positions": positions,
        "w_ada": nrm(ks[3], (DEPTH, D_MODEL, 6 * D_MODEL), 0.5 * D_MODEL ** -0.5),
        "b_ada": nrm(ks[4], (DEPTH, 6 * D_MODEL), 0.02),
        "norm1_g": 1.0 + nrm(ks[5], (DEPTH, D_MODEL), 0.02),
        "w_in": nrm(ks[6], (DEPTH, D_MODEL, IN_WIDTH), D_MODEL ** -0.5),
        "w_s": nrm(ks[7], (DEPTH, GMLP_GROUPS, GMLP_CHUNK, GMLP_CHUNK), GMLP_CHUNK ** -0.5),
        "b_s": 1.0 + nrm(ks[8], (DEPTH, GMLP_GROUPS, GMLP_CHUNK), 0.1),
        "ln_g": 1.0 + nrm(ks[9], (DEPTH, GMLP_WIDTH), 0.02),
        "ln_b": nrm(ks[10], (DEPTH, GMLP_WIDTH), 0.02),
        "w_pa": nrm(ks[11], (DEPTH, ATTN_OUT, D_MODEL), ATTN_OUT ** -0.5),
        "w_pg": nrm(ks[12], (DEPTH, GMLP_WIDTH, D_MODEL), GMLP_WIDTH ** -0.5),
        "w_o": nrm(ks[13], (DEPTH, D_MODEL, D_MODEL), D_MODEL ** -0.5),
        "norm2_g": 1.0 + nrm(ks[14], (DEPTH, D_MODEL), 0.02),
        "w_router": nrm(ks[15], (DEPTH, D_MODEL, N_EXPERTS), D_MODEL ** -0.5),
        "b_router": nrm(ks[16], (DEPTH, N_EXPERTS), 0.01),
        "w1": nrm(ks[17], (DEPTH, N_EXPERTS, D_MODEL, 2 * D_FF), D_MODEL ** -0.5),
        "b1": nrm(ks[18], (DEPTH, N_EXPERTS, 2 * D_FF), 0.01),
        "w2": nrm(ks[19], (DEPTH, N_EXPERTS, D_FF, D_MODEL), D_FF ** -0.5),
        "b2": nrm(ks[20], (DEPTH, N_EXPERTS, D_MODEL), 0.01),
        "final_g": 1.0 + nrm(ks[21], (D_MODEL,), 0.02),
    }


def reference(x, c, positions, w_ada, b_ada, norm1_g, w_in, w_s, b_s, ln_g, ln_b,
              w_pa, w_pg, w_o, norm2_g, w_router, b_router, w1, b1, w2, b2, final_g):
    h = x
    for l in range(DEPTH):
        mod = jax.nn.silu(c) @ w_ada[l] + b_ada[l]
        sh1, sc1, g1, sh2, sc2, g2 = jnp.split(mod[:, None, :], 6, axis=-1)
        a = rmsnorm(h, norm1_g[l]) * (1 + sc1) + sh1
        h = h + g1 * token_mixers(a, positions, w_in[l], w_s[l], b_s[l], ln_g[l], ln_b[l],
                                  w_pa[l], w_pg[l], w_o[l])
        f = rmsnorm(h, norm2_g[l]) * (1 + sc2) + sh2
        h = h + g2 * moe(f, w_router[l], b_router[l], w1[l], b1[l], w2[l], b2[l])
    return rmsnorm(h, final_g)
```

```cpp
#include <hip/hip_runtime.h>
#include <cstdio>
#include <cstdint>

#ifndef MK_PER_PHASE
#define MK_PER_PHASE 0
#endif
#ifndef MK_CHECKS
#define MK_CHECKS 0
#endif

constexpr int D = 1024, BATCH = 8, SEQ = 4096, NTOK = BATCH * SEQ, DEPTH = 2;
constexpr int AW = 768, AO = 256, GW = 512, INW = 5376, NE = 32, TOPK = 4, NASG = NTOK * TOPK, DFF = 1024;
constexpr float RMS_EPS = 1e-5f, LN_EPS = 1e-5f;
constexpr int NWAVES = 8, NTHR = 512;
constexpr int NTILE128 = NTOK / 128;
constexpr float LOG2E = 1.4426950408889634f, LN2 = 0.6931471805599453f;
constexpr float QSCALE = 0.125f * LOG2E;

constexpr size_t MiB = 1u << 20;
constexpr size_t WS_CTL = 0, CTL_ZERO_BYTES = 1 * MiB;
constexpr size_t WS_MOD = 1 * MiB;
constexpr size_t WS_ROPEC = 2 * MiB;
constexpr size_t WS_ROPES = 6 * MiB;
constexpr size_t WS_WRH = 10 * MiB;
constexpr size_t WS_WRL = 10 * MiB + 512 * 1024;
constexpr size_t WS_WSB = 11 * MiB;
constexpr size_t WS_B1P = 12 * MiB;
constexpr size_t WS_WTIN = 13 * MiB;
constexpr size_t WS_WTPA = 34 * MiB;
constexpr size_t WS_WTPG = 35 * MiB;
constexpr size_t WS_WTO = 37 * MiB;
constexpr size_t WS_W1T = 41 * MiB;
constexpr size_t WS_W2T = 297 * MiB;
constexpr size_t WS_HB1 = 425 * MiB;
constexpr size_t WS_HB2 = 553 * MiB;
constexpr size_t WS_AIN = 681 * MiB;
constexpr size_t WS_QB = 745 * MiB, WS_KB = 793 * MiB, WS_VB = 841 * MiB;
constexpr size_t WS_UB = 889 * MiB, WS_VGB = 921 * MiB;
constexpr size_t WS_GB = 953 * MiB;
constexpr size_t WS_OG = 1081 * MiB;
constexpr size_t WS_LSE = 1129 * MiB;
constexpr size_t WS_ATT = 1131 * MiB;
constexpr size_t WS_GM = 1147 * MiB;
constexpr size_t WS_TMP = 1179 * MiB;
constexpr size_t WS_MRG = 1243 * MiB;
constexpr size_t WS_TOPI = 1307 * MiB;
constexpr size_t WS_TOPG = 1307 * MiB + 512 * 1024;
constexpr size_t WS_POS = 1308 * MiB;
constexpr size_t WS_WGH = 1308 * MiB + 512 * 1024;
constexpr size_t WS_ETAB = 1308 * MiB + 640 * 1024;
constexpr size_t WS_SORT = 1309 * MiB;
constexpr size_t WS_ACT = 1310 * MiB;
constexpr size_t WS_Y = 1567 * MiB;
constexpr size_t WS_END = 1824 * MiB;
static_assert(WS_ACT + (size_t)(NASG + 256) * 1024 * 2 <= WS_Y && WS_Y + (size_t)(NASG + 256) * 1024 * 2 <= WS_END, "ws map");

constexpr int CW_TMO = 0, CW_CODE = 1, CW_BAR = 4096, CW_ERR = 16384;

constexpr int RING_BYTES = 131072;
constexpr int IDX_OFF = 139264;
constexpr int TAB_OFF = 141312;
constexpr int MISC_OFF = 141824;
constexpr int LDS_BYTES = 147456;

#define GAS __attribute__((address_space(1)))
#define LAS __attribute__((address_space(3)))
typedef unsigned short bf16;
typedef float f32x2 __attribute__((ext_vector_type(2)));
typedef float f32x4 __attribute__((ext_vector_type(4)));
typedef float f32x16 __attribute__((ext_vector_type(16)));
typedef short bf16x8 __attribute__((ext_vector_type(8)));
typedef short s16x4 __attribute__((ext_vector_type(4)));
typedef unsigned u32x2 __attribute__((ext_vector_type(2)));
typedef unsigned u32x4 __attribute__((ext_vector_type(4)));
typedef int i32x4 __attribute__((ext_vector_type(4)));
typedef __bf16 bf16x2_t __attribute__((ext_vector_type(2)));
typedef GAS unsigned gu32;
#define RLX_AGENT __ATOMIC_RELAXED, __HIP_MEMORY_SCOPE_AGENT
#define LDS_WAIT() asm volatile("s_waitcnt lgkmcnt(0)" ::: "memory")
#define VM_WAIT() asm volatile("s_waitcnt vmcnt(0)" ::: "memory")

__device__ __forceinline__ unsigned pk2(float lo, float hi) { f32x2 v = {lo, hi}; bf16x2_t b = __builtin_convertvector(v, bf16x2_t); return __builtin_bit_cast(unsigned, b); }
__device__ __forceinline__ float bf_lo(unsigned w) { return __uint_as_float(w << 16); }
__device__ __forceinline__ float bf_hi(unsigned w) { return __uint_as_float(w & 0xffff0000u); }
__device__ __forceinline__ float bf2f(bf16 b) { return __uint_as_float(((unsigned)b) << 16); }
__device__ __forceinline__ float wave_sum(float v) {
#pragma unroll
    for (int o = 1; o < 64; o <<= 1) v += __shfl_xor(v, o);
    return v;
}
__device__ __forceinline__ float fast_exp2(float x) { return __builtin_amdgcn_exp2f(x); }
__device__ __forceinline__ float fast_rcp(float x) { return __builtin_amdgcn_rcpf(x); }
__device__ __forceinline__ float sigmoidf_(float x) { return fast_rcp(1.0f + fast_exp2(-LOG2E * x)); }
__device__ __forceinline__ float gelu_tanh(float x) {
    const float u = x + 0.044715f * x * x * x;
    return x * fast_rcp(1.0f + fast_exp2(-2.0f * 0.7978845608028654f * LOG2E * u));
}

#define XB_TMO      128
#define XB_XCNT(j)  (256  + 64 * (j))
#define XB_XSUB(j)  (1280 + 64 * (j))
#define XB_XGEN(j)  (2304 + 64 * (j))
#define XB_TOP      3328
#define XB_TOPGEN   3392
#define XCD_BAR_WORDS 3456
#define XB_SPIN_CAP (1u << 18)
__device__ __forceinline__ unsigned xb_ld(unsigned* p)              { return __hip_atomic_load(p, __ATOMIC_RELAXED, __HIP_MEMORY_SCOPE_AGENT); }
__device__ __forceinline__ unsigned xb_add(unsigned* p, unsigned v) { return __hip_atomic_fetch_add(p, v, __ATOMIC_RELAXED, __HIP_MEMORY_SCOPE_AGENT); }
__device__ __forceinline__ unsigned xb_xcc_id() { return (unsigned)__builtin_amdgcn_s_getreg((3 << 11) | 20) & 0xFu; }
#define XB_SPIN(cond, bar) do { unsigned _sp = 0; while (cond) { __builtin_amdgcn_s_sleep(1); \
    if ((++_sp & 255u) == 0u) { if (xb_ld(&(bar)[XB_TMO])) break; if (_sp > XB_SPIN_CAP) { atomicAdd(&(bar)[XB_TMO], 1u); break; } } } } while (0)
struct XcdBarrier { unsigned* bar; unsigned x; volatile LAS unsigned* st; };
__device__ __forceinline__ XcdBarrier xcd_barrier_post(unsigned* bar, volatile LAS unsigned* st) {
    XcdBarrier b; b.bar = bar; b.x = xb_xcc_id(); b.st = st;
    if (threadIdx.x == 0) (void)xb_add(&bar[XB_XCNT(b.x)], 1u);
    return b;
}
__device__ __forceinline__ void xcd_barrier_complete(unsigned* bar, unsigned x, unsigned& nloc, unsigned& nx) {
    const unsigned G = gridDim.x * gridDim.y * gridDim.z;
    unsigned sum, cnt, mine, sp = 0u;
    for (;;) {
        sum = 0u; cnt = 0u; mine = 0u;
#pragma unroll
        for (unsigned j = 0; j < 16; ++j) { const unsigned c = xb_ld(&bar[XB_XCNT(j)]); sum += c; cnt += (c > 0u) ? 1u : 0u; mine = (j == x) ? c : mine; }
        if (sum == G) break;
        __builtin_amdgcn_s_sleep(1);
        if ((++sp & 255u) == 0u) { if (xb_ld(&bar[XB_TMO])) break; if (sp > XB_SPIN_CAP) { atomicAdd(&bar[XB_TMO], 1u); break; } }
    }
    nloc = mine > 0u ? mine : 1u; nx = cnt > 0u ? cnt : 1u;
}
__device__ __forceinline__ void xcd_barrier(const XcdBarrier& b) {
    asm volatile("s_waitcnt vmcnt(0)" ::: "memory");
    __syncthreads();
    if (threadIdx.x == 0) {
        unsigned* bar = b.bar;
        __builtin_amdgcn_s_waitcnt(0);
        unsigned nloc = b.st[0], nx = b.st[1];
        if (nloc == 0u) { xcd_barrier_complete(bar, b.x, nloc, nx); b.st[0] = nloc; b.st[1] = nx; }
        const unsigned old = xb_add(&bar[XB_XSUB(b.x)], 1u);
        const unsigned gen = old / nloc;
        if (old + 1u == (gen + 1u) * nloc) {
            __builtin_amdgcn_fence(__ATOMIC_RELEASE, "agent");
            asm volatile("s_waitcnt vmcnt(0)" ::: "memory");
            const unsigned og = xb_add(&bar[XB_TOP], 1u);
            const unsigned tg = og / nx;
            if (og + 1u == (tg + 1u) * nx) xb_add(&bar[XB_TOPGEN], 1u);
            else XB_SPIN(xb_ld(&bar[XB_TOPGEN]) == tg, bar);
            __builtin_amdgcn_fence(__ATOMIC_ACQUIRE, "agent");
            xb_add(&bar[XB_XGEN(b.x)], 1u);
            asm volatile("s_waitcnt vmcnt(0)" ::: "memory");
        } else {
            XB_SPIN(xb_ld(&bar[XB_XGEN(b.x)]) == gen, bar);
            __builtin_amdgcn_fence(__ATOMIC_ACQUIRE, "agent");
            asm volatile("s_waitcnt vmcnt(0)" ::: "memory");
        }
    }
    __syncthreads();
}

namespace pg8 {
constexpr int BM = 256, BK = 64, HALF = 128, HTB = HALF * BK * 2, STAGE_BYTES = 8 * HTB, NXCD = 8, WGM = 8;
__host__ __device__ __forceinline__ int lds_byte(int r, int c) { const int st = (r >> 4) * 2 + (c >> 5), rr = r & 15, cc = c & 31, ob = rr * 64 + cc * 2; return st * 1024 + (ob ^ (((ob >> 9) & 1) << 5)); }
__host__ __device__ __forceinline__ void stage_rc(int b, int& R, int& C) { const int st = b / 1024, sb = b % 1024, swz = sb ^ (((sb >> 9) & 1) << 5); R = (st >> 1) * 16 + swz / 64; C = (st & 1) * 32 + (swz % 64) / 2; }
__host__ __device__ __forceinline__ int perm32(int rho) { const int n = rho >> 4, i = rho & 15; return 8 * (i >> 2) + 4 * n + (i & 3); }

struct Unit { int pm, pn; const char* A; const char* B; int e, rows, row0; };

struct TileOrder {
    int nM, nN, nwg, G, c;
    __device__ __forceinline__ void init(int nM_, int nN_, int G_, int c_) { nM = nM_; nN = nN_; nwg = nM * nN; G = G_; c = c_; }
    __device__ __forceinline__ bool tile(int i, int& pm, int& pn) const {
        const long L = (long)i * G + c; if (L >= nwg) return false;
        int wgid = (int)L; { const int q = nwg / NXCD, r = nwg % NXCD, xcd = wgid % NXCD, off = wgid / NXCD; wgid = (xcd < r ? xcd * (q + 1) : r * (q + 1) + (xcd - r) * q) + off; }
        const int nig = WGM * nN, gid = wgid / nig, fm = gid * WGM, gsz = (nM - fm) < WGM ? (nM - fm) : WGM;
        pm = fm + ((wgid % nig) % gsz); pn = (wgid % nig) / gsz; return true;
    }
};
struct PlainSched {
    TileOrder T; const char* A; const char* B; int K;
    __device__ __forceinline__ bool next(int i, Unit& u) const {
        if (!T.tile(i, u.pm, u.pn)) return false;
        u.A = A + (size_t)u.pm * 256 * K * 2; u.B = B + (size_t)u.pn * 256 * K * 2; u.e = 0; u.rows = 256; u.row0 = u.pm * 256; return true;
    }
};
struct MoeSched {
    TileOrder T; const char* A; const char* B; int K; size_t bstride  ; const LAS int* tab; bool gather;
    __device__ __forceinline__ bool next(int i, Unit& u) const {
        int pmg;
        if (!T.tile(i, pmg, u.pn)) return false;
        const int lane = threadIdx.x & 63;
        const int ts = tab[64 + ((lane < 32) ? lane + 1 : 32)];
        const unsigned long long m = __ballot((lane < 32) && (ts <= pmg));
        const int e = __builtin_amdgcn_readfirstlane(__popcll(m));
        const int t = pmg - tab[64 + e];
        const int cnt = tab[e], off = tab[32 + e];
        u.pm = pmg; u.e = e; u.row0 = off + 256 * t; u.rows = (cnt - 256 * t) < 256 ? (cnt - 256 * t) : 256;
        u.A = gather ? A : A + (size_t)u.row0 * K * 2;
        u.B = B + (size_t)e * bstride + (size_t)u.pn * 256 * K * 2;
        return true;
    }
};

typedef f32x4 Acc[2][2][4][2];

template <class Epi, class Sched, bool GATHER>
__device__ __forceinline__ void gemm_phase(LAS unsigned char* lds, const int K, const Sched& S, const Epi& E, const int* gidx, LAS int* idxl) {
    int tid_ = threadIdx.x; asm volatile("" : "+v"(tid_));
    const int tid = tid_, wid = __builtin_amdgcn_readfirstlane(tid >> 6), lane = tid & 63, wr = wid >> 2, wc = wid & 3, fr = lane & 15, fq = lane >> 4;
    const int nt = K / BK;
    unsigned voffA[2], voffB[2];
#pragma unroll
    for (int i = 0; i < 2; ++i) { int R, C; stage_rc(tid * 16 + i * 8192, R, C); const int Rb = Epi::PERM ? ((R & ~31) + perm32(R & 31)) : R;
        voffA[i] = (unsigned)(R * K + C) * 2u; voffB[i] = (unsigned)(Rb * K + C) * 2u; }
    const size_t kstep = (size_t)(BK * 2);
    const size_t hstep = (size_t)HALF * K * 2;
    const unsigned ldsw = (unsigned)wid * 1024u;
    const int aoff = lds_byte(wr * 64 + fr, fq * 8), boff = lds_byte(wc * 32 + fr, fq * 8);
    unsigned vc00 = 0, vc01 = 0, vc10 = 0, vc11 = 0;
#define PG8_GOFF(ip, pre) do { int R0_, C0_, R1_, C1_; stage_rc(tid * 16, R0_, C0_); stage_rc(tid * 16 + 8192, R1_, C1_); \
        const int i00 = (ip)[R0_], i01 = (ip)[R1_], i10 = (ip)[128 + R0_], i11 = (ip)[128 + R1_]; \
        pre##00 = (unsigned)(i00 * K + C0_) * 2u; pre##01 = (unsigned)(i01 * K + C1_) * 2u; pre##10 = (unsigned)(i10 * K + C0_) * 2u; pre##11 = (unsigned)(i11 * K + C1_) * 2u; } while (0)
#define PG8_SA(b, h) (((b) * 2 + (h)) * HTB)
#define PG8_SB(b, h) ((4 + (b) * 2 + (h)) * HTB)
#define PG8_GL(sbase, voff32, dst) do { unsigned keep_; asm volatile("s_mov_b32 %0, m0\n\ts_mov_b32 m0, %3\n\ts_nop 0\n\tglobal_load_lds_dwordx4 %1, %2\n\ts_mov_b32 m0, %0" \
        : "=&s"(keep_) : "v"(voff32), "s"(sbase), "s"((unsigned)(__UINTPTR_TYPE__)(dst)) : "memory"); } while (0)
#define PG8_STAGE(bufoff, gbase, voff) do { const unsigned long long _b = (unsigned long long)(gbase); PG8_GL(_b, (voff)[0], lds + (bufoff) + ldsw); PG8_GL(_b, (voff)[1], lds + (bufoff) + ldsw + 8192); } while (0)
#define PG8_STAGE2(bufoff, gbase, v0, v1) do { const unsigned long long _b = (unsigned long long)(gbase); PG8_GL(_b, v0, lds + (bufoff) + ldsw); PG8_GL(_b, v1, lds + (bufoff) + ldsw + 8192); } while (0)
#define PG8_STAGE_A(bufoff, p, h, nx) do { if constexpr (GATHER) { if (h == 0) { if (nx) PG8_STAGE2(bufoff, p, u00, u01); else PG8_STAGE2(bufoff, p, vc00, vc01); } else { if (nx) PG8_STAGE2(bufoff, p, u10, u11); else PG8_STAGE2(bufoff, p, vc10, vc11); } } \
        else PG8_STAGE(bufoff, (p) + (h) * hstep, voffA); } while (0)
#define PG8_LDA(dst, b, h) do { _Pragma("unroll") for (int m = 0; m < 4; ++m) _Pragma("unroll") for (int k = 0; k < 2; ++k) dst[m][k] = *(const LAS bf16x8*)(lds + PG8_SA(b, h) + aoff + m * 2048 + k * 1024); } while (0)
#define PG8_LDB(dst, b, h) do { _Pragma("unroll") for (int n = 0; n < 2; ++n) _Pragma("unroll") for (int k = 0; k < 2; ++k) dst[n][k] = *(const LAS bf16x8*)(lds + PG8_SB(b, h) + boff + n * 2048 + k * 1024); } while (0)
#define PG8_MMA(ai, bj, At, Bt) do { __builtin_amdgcn_s_setprio(1); _Pragma("unroll") for (int m = 0; m < 4; ++m) _Pragma("unroll") for (int n = 0; n < 2; ++n) _Pragma("unroll") for (int k = 0; k < 2; ++k) \
        acc[ai][bj][m][n] = __builtin_amdgcn_mfma_f32_16x16x32_bf16(Bt[n][k], At[m][k], acc[ai][bj][m][n], 0, 0, 0); __builtin_amdgcn_s_setprio(0); } while (0)
#define PG8_WAIT_V(n) asm volatile("s_waitcnt vmcnt(" #n ")" ::: "memory")
#define PG8_WAIT_L(n) asm volatile("s_waitcnt lgkmcnt(" #n ")" ::: "memory")
#define PG8_BAR __builtin_amdgcn_s_barrier()
#define PG8_SCHED __builtin_amdgcn_sched_barrier(0)
    Unit cur, nxt; int ui = 0;
    if (!S.next(0, cur)) return;
    Acc acc;
#pragma unroll
    for (int a = 0; a < 2; ++a)
#pragma unroll
        for (int b = 0; b < 2; ++b)
#pragma unroll
            for (int m = 0; m < 4; ++m)
#pragma unroll
                for (int n = 0; n < 2; ++n) acc[a][b][m][n] = (f32x4){0.f, 0.f, 0.f, 0.f};
    bf16x8 At[4][2], B0[2][2], B1[2][2];
    const char* cA = cur.A; const char* cB = cur.B;
    if constexpr (GATHER) {
        const int* gp_ = gidx + cur.row0; PG8_GOFF(gp_, vc);
        asm volatile("s_waitcnt vmcnt(0)" ::: "memory");
    }
    unsigned u00 = 0, u01 = 0, u10 = 0, u11 = 0;
    PG8_STAGE(PG8_SB(0, 0), cB, voffB); PG8_STAGE(PG8_SB(0, 1), cB + hstep, voffB); PG8_STAGE_A(PG8_SA(0, 0), cA, 0, false); PG8_STAGE_A(PG8_SA(0, 1), cA, 1, false);
    if (wr == 1) PG8_BAR;
    PG8_WAIT_V(2); PG8_BAR;
    PG8_STAGE(PG8_SB(1, 0), cB + kstep, voffB); PG8_STAGE_A(PG8_SA(1, 0), cA + kstep, 0, false); PG8_STAGE(PG8_SB(1, 1), cB + hstep + kstep, voffB);
    PG8_WAIT_V(6); PG8_BAR;
    for (;;) {
        const bool has_next = S.next(ui + 1, nxt);
        const char* nA = has_next ? nxt.A : cA; const char* nB = has_next ? nxt.B : cB;
        if constexpr (GATHER) {
            if (has_next && wid < 4) __builtin_amdgcn_global_load_lds((const unsigned*)(gidx + nxt.row0 + wid * 64 + lane), (LAS unsigned*)(idxl + ((ui + 1) & 1) * 256 + wid * 64), 4, 0, 0);
        }
        for (int t = 0; t < nt; t += 2) {
            const bool last = (t == nt - 2);
            const char* a1 = cA + (size_t)(t + 1) * kstep;
            const char* a2 = last ? nA : cA + (size_t)(t + 2) * kstep; const char* b2 = last ? nB : cB + (size_t)(t + 2) * kstep;
            const char* a3 = a2 + kstep; const char* b3 = b2 + kstep;
            if constexpr (GATHER) {
                u00 = vc00; u01 = vc01; u10 = vc10; u11 = vc11;
                if (last && has_next) { const LAS int* ip = idxl + ((ui + 1) & 1) * 256; PG8_GOFF(ip, u); }
            }
            PG8_LDB(B0, 0, 0); PG8_LDB(B1, 0, 1); PG8_SCHED; PG8_LDA(At, 0, 0); PG8_STAGE_A(PG8_SA(1, 1), a1, 1, false);
            PG8_WAIT_V(8); PG8_WAIT_L(0); PG8_BAR; PG8_MMA(0, 0, At, B0); PG8_MMA(0, 1, At, B1); PG8_BAR; PG8_SCHED;
            PG8_LDA(At, 0, 1); PG8_STAGE(PG8_SB(0, 0), b2, voffB); PG8_STAGE(PG8_SB(0, 1), b2 + hstep, voffB); PG8_STAGE_A(PG8_SA(0, 0), a2, 0, true);
            PG8_WAIT_V(8); PG8_WAIT_L(0); PG8_BAR; PG8_MMA(1, 0, At, B0); PG8_MMA(1, 1, At, B1); PG8_BAR; PG8_SCHED;
            PG8_LDB(B0, 1, 0); PG8_LDB(B1, 1, 1); PG8_SCHED; PG8_LDA(At, 1, 0); PG8_STAGE_A(PG8_SA(0, 1), a2, 1, true);
            PG8_WAIT_V(8); PG8_WAIT_L(0); PG8_BAR; PG8_MMA(0, 0, At, B0); PG8_MMA(0, 1, At, B1); PG8_BAR; PG8_SCHED;
            PG8_LDA(At, 1, 1); PG8_STAGE(PG8_SB(1, 0), b3, voffB); PG8_STAGE(PG8_SB(1, 1), b3 + hstep, voffB); PG8_STAGE_A(PG8_SA(1, 0), a3, 0, true);
            PG8_WAIT_V(8); PG8_WAIT_L(0); PG8_BAR; PG8_MMA(1, 0, At, B0); PG8_MMA(1, 1, At, B1); PG8_BAR; PG8_SCHED;
        }
        if (wr == 0) PG8_BAR;
        E(acc, cur, wr, wc, fr, fq);
        if (!has_next) break;
#pragma unroll
        for (int a = 0; a < 2; ++a)
#pragma unroll
            for (int b = 0; b < 2; ++b)
#pragma unroll
                for (int m = 0; m < 4; ++m)
#pragma unroll
                    for (int n = 0; n < 2; ++n) acc[a][b][m][n] = (f32x4){0.f, 0.f, 0.f, 0.f};
        cur = nxt; cA = nA; cB = nB; ++ui;
        if constexpr (GATHER) { vc00 = u00; vc01 = u01; vc10 = u10; vc11 = u11; }
        if (wr == 1) PG8_BAR;
    }
    PG8_WAIT_V(0);
    PG8_BAR;
#undef PG8_SA
#undef PG8_SB
#undef PG8_GL
#undef PG8_STAGE
#undef PG8_STAGE2
#undef PG8_STAGE_A
#undef PG8_GOFF
#undef PG8_LDA
#undef PG8_LDB
#undef PG8_MMA
#undef PG8_WAIT_V
#undef PG8_WAIT_L
#undef PG8_BAR
#undef PG8_SCHED
}

__device__ __forceinline__ u32x4 pack8(f32x4 a, f32x4 b) { u32x4 w; w.x = pk2(a[0], a[1]); w.y = pk2(a[2], a[3]); w.z = pk2(b[0], b[1]); w.w = pk2(b[2], b[3]); return w; }

struct EpiIn {
    static constexpr bool PERM = true;
    bf16 *Q, *Kb, *V, *U, *VG, *G; const float* ropec; const float* ropes;
    __device__ __forceinline__ void operator()(const Acc& acc, const Unit& u, int wr, int wc, int fr, int fq) const {
        const int pn = u.pn, row0 = u.pm * 256 + wr * 64 + fr, cl = wc * 32 + 8 * fq;
        if (pn < 6) {
            bf16* base = (pn < 3) ? Q : Kb; const int g = (pn < 3) ? pn : pn - 3; const float sc = (pn < 3) ? QSCALE : 1.0f;
            const int i4 = 4 * (4 * (wc & 1) + fq);
#pragma unroll
            for (int ai = 0; ai < 2; ++ai)
#pragma unroll
                for (int m = 0; m < 4; ++m) { const int row = row0 + ai * 128 + m * 16;
                    const f32x4 cs = *(const f32x4*)(ropec + (size_t)row * 32 + i4), sn = *(const f32x4*)(ropes + (size_t)row * 32 + i4);
#pragma unroll
                    for (int bj = 0; bj < 2; ++bj) { const f32x4 x1 = acc[ai][bj][m][0], x2 = acc[ai][bj][m][1];
                        const f32x4 o1 = (x1 * cs - x2 * sn) * sc, o2 = (x2 * cs + x1 * sn) * sc;
                        *(u32x4*)(base + (size_t)row * AW + g * 256 + bj * 128 + cl) = pack8(o1, o2); }
                    __builtin_amdgcn_sched_barrier(0); }
        } else if (pn < 9) {
            const int cb = (pn - 6) * 256;
#pragma unroll
            for (int ai = 0; ai < 2; ++ai)
#pragma unroll
                for (int m = 0; m < 4; ++m) { const int row = row0 + ai * 128 + m * 16;
#pragma unroll
                    for (int bj = 0; bj < 2; ++bj) *(u32x4*)(V + (size_t)row * AW + cb + bj * 128 + cl) = pack8(acc[ai][bj][m][0], acc[ai][bj][m][1]);
                    __builtin_amdgcn_sched_barrier(0); }
        } else if (pn < 13) {
            bf16* base = (pn < 11) ? U : VG; const int cb = ((pn - 9) & 1) * 256;
#pragma unroll
            for (int ai = 0; ai < 2; ++ai)
#pragma unroll
                for (int m = 0; m < 4; ++m) { const int row = row0 + ai * 128 + m * 16;
#pragma unroll
                    for (int bj = 0; bj < 2; ++bj) { f32x4 a = acc[ai][bj][m][0], b = acc[ai][bj][m][1];
#pragma unroll
                        for (int j = 0; j < 4; ++j) { a[j] = gelu_tanh(a[j]); b[j] = gelu_tanh(b[j]); }
                        *(u32x4*)(base + (size_t)row * GW + cb + bj * 128 + cl) = pack8(a, b); }
                    __builtin_amdgcn_sched_barrier(0); }
        } else {
            const int cb = (pn - 13) * 256;
#pragma unroll
            for (int ai = 0; ai < 2; ++ai)
#pragma unroll
                for (int m = 0; m < 4; ++m) { const int row = row0 + ai * 128 + m * 16;
#pragma unroll
                    for (int bj = 0; bj < 2; ++bj) { f32x4 a = acc[ai][bj][m][0], b = acc[ai][bj][m][1];
#pragma unroll
                        for (int j = 0; j < 4; ++j) { a[j] = sigmoidf_(a[j]); b[j] = sigmoidf_(b[j]); }
                        *(u32x4*)(G + (size_t)row * 2048 + cb + bj * 128 + cl) = pack8(a, b); }
                    __builtin_amdgcn_sched_barrier(0); }
        }
    }
};
__device__ __forceinline__ void unpack8(u32x4 w, f32x4& a, f32x4& b) { a = (f32x4){bf_lo(w.x), bf_hi(w.x), bf_lo(w.y), bf_hi(w.y)}; b = (f32x4){bf_lo(w.z), bf_hi(w.z), bf_lo(w.w), bf_hi(w.w)}; }
struct EpiMul1 {
    static constexpr bool PERM = true;
    const bf16* G; bf16* T;
    __device__ __forceinline__ void operator()(const Acc& acc, const Unit& u, int wr, int wc, int fr, int fq) const {
        const int row0 = u.pm * 256 + wr * 64 + fr, c0 = u.pn * 256 + wc * 32 + 8 * fq;
#pragma unroll
        for (int ai = 0; ai < 2; ++ai)
#pragma unroll
            for (int m = 0; m < 4; ++m) { const int row = row0 + ai * 128 + m * 16;
#pragma unroll
                for (int bj = 0; bj < 2; ++bj) { f32x4 ga, gb; unpack8(*(const u32x4*)(G + (size_t)row * 2048 + 1024 + c0 + bj * 128), ga, gb);
                    *(u32x4*)(T + (size_t)row * D + c0 + bj * 128) = pack8(acc[ai][bj][m][0] * ga, acc[ai][bj][m][1] * gb); }
                asm volatile("" ::: "memory"); __builtin_amdgcn_sched_barrier(0); }
    }
};
struct EpiMul2 {
    static constexpr bool PERM = true;
    const bf16* G; const bf16* T; bf16* O;
    __device__ __forceinline__ void operator()(const Acc& acc, const Unit& u, int wr, int wc, int fr, int fq) const {
        const int row0 = u.pm * 256 + wr * 64 + fr, c0 = u.pn * 256 + wc * 32 + 8 * fq;
#pragma unroll
        for (int ai = 0; ai < 2; ++ai)
#pragma unroll
            for (int m = 0; m < 4; ++m) { const int row = row0 + ai * 128 + m * 16;
#pragma unroll
                for (int bj = 0; bj < 2; ++bj) { f32x4 ga, gb, ta, tb; unpack8(*(const u32x4*)(G + (size_t)row * 2048 + c0 + bj * 128), ga, gb); unpack8(*(const u32x4*)(T + (size_t)row * D + c0 + bj * 128), ta, tb);
                    *(u32x4*)(O + (size_t)row * D + c0 + bj * 128) = pack8(acc[ai][bj][m][0] * ga + ta, acc[ai][bj][m][1] * gb + tb); }
                asm volatile("" ::: "memory"); __builtin_amdgcn_sched_barrier(0); }
    }
};
struct EpiRes {
    static constexpr bool PERM = true;
    const float* Hin; float* Hout; const float* g1;
    __device__ __forceinline__ void operator()(const Acc& acc, const Unit& u, int wr, int wc, int fr, int fq) const {
        const int row0 = u.pm * 256 + wr * 64 + fr, c0 = u.pn * 256 + wc * 32 + 8 * fq;
        const float* gp = g1 + (size_t)((u.pm * 256) / SEQ) * 6144;
        f32x4 gv[2][2];
#pragma unroll
        for (int bj = 0; bj < 2; ++bj) { gv[bj][0] = *(const f32x4*)(gp + c0 + bj * 128); gv[bj][1] = *(const f32x4*)(gp + c0 + bj * 128 + 4); }
#pragma unroll
        for (int ai = 0; ai < 2; ++ai)
#pragma unroll
            for (int m = 0; m < 4; ++m) { const size_t ro = (size_t)(row0 + ai * 128 + m * 16) * D;
#pragma unroll
                for (int bj = 0; bj < 2; ++bj) { const size_t o = ro + c0 + bj * 128;
                    const f32x4 h0 = *(const f32x4*)(Hin + o), h1 = *(const f32x4*)(Hin + o + 4);
                    *(f32x4*)(Hout + o) = h0 + gv[bj][0] * acc[ai][bj][m][0]; *(f32x4*)(Hout + o + 4) = h1 + gv[bj][1] * acc[ai][bj][m][1]; }
                asm volatile("" ::: "memory"); __builtin_amdgcn_sched_barrier(0); }
    }
};
struct EpiSwiglu {
    static constexpr bool PERM = true;
    const float* b1p; bf16* ACT;
    __device__ __forceinline__ void operator()(const Acc& acc, const Unit& u, int wr, int wc, int fr, int fq) const {
        const float* bp = b1p + (size_t)u.e * 2048 + u.pn * 256 + wc * 32 + 8 * fq;
        f32x4 bv[2][2];
#pragma unroll
        for (int bj = 0; bj < 2; ++bj) { bv[bj][0] = *(const f32x4*)(bp + bj * 128); bv[bj][1] = *(const f32x4*)(bp + bj * 128 + 4); }
        const int ac0 = u.pn * 128 + 8 * (4 * wc + fq);
#pragma unroll
        for (int ai = 0; ai < 2; ++ai)
#pragma unroll
            for (int m = 0; m < 4; ++m) { const int rl = ai * 128 + wr * 64 + m * 16 + fr;
                f32x4 o[2];
#pragma unroll
                for (int bj = 0; bj < 2; ++bj) { const f32x4 gl = acc[ai][bj][m][0] + bv[bj][0], li = acc[ai][bj][m][1] + bv[bj][1];
#pragma unroll
                    for (int j = 0; j < 4; ++j) { const float xg = fminf(gl[j], 7.0f), xl = fminf(fmaxf(li[j], -7.0f), 7.0f); o[bj][j] = xg * sigmoidf_(1.702f * xg) * (xl + 1.0f); } }
                if (rl < u.rows) *(u32x4*)(ACT + (size_t)(u.row0 + rl) * DFF + ac0) = pack8(o[0], o[1]);
                __builtin_amdgcn_sched_barrier(0); }
    }
};
struct EpiY {
    static constexpr bool PERM = true;
    const float* b2; bf16* Y;
    __device__ __forceinline__ void operator()(const Acc& acc, const Unit& u, int wr, int wc, int fr, int fq) const {
        const int c0 = u.pn * 256 + wc * 32 + 8 * fq;
        const float* bp = b2 + (size_t)u.e * 1024 + c0;
        f32x4 bv[2][2];
#pragma unroll
        for (int bj = 0; bj < 2; ++bj) { bv[bj][0] = *(const f32x4*)(bp + bj * 128); bv[bj][1] = *(const f32x4*)(bp + bj * 128 + 4); }
#pragma unroll
        for (int ai = 0; ai < 2; ++ai)
#pragma unroll
            for (int m = 0; m < 4; ++m) { const int rl = ai * 128 + wr * 64 + m * 16 + fr;
                if (rl < u.rows) {
#pragma unroll
                    for (int bj = 0; bj < 2; ++bj) *(u32x4*)(Y + (size_t)(u.row0 + rl) * D + c0 + bj * 128) = pack8(acc[ai][bj][m][0] + bv[bj][0], acc[ai][bj][m][1] + bv[bj][1]); }
                __builtin_amdgcn_sched_barrier(0); }
    }
};
}

enum { IN_X = 0, IN_C, IN_POS, IN_WADA, IN_BADA, IN_N1G, IN_WIN, IN_WS, IN_BS, IN_LNG, IN_LNB, IN_WPA, IN_WPG, IN_WO, IN_N2G, IN_WR, IN_BR, IN_W1, IN_B1, IN_W2, IN_B2, IN_FG, IN_OUT };
struct Args { const float* in[22]; const int* positions; float* out; unsigned char* ws; int ph_lo, ph_hi; };
struct Frame {
    LAS unsigned char* lds; volatile LAS unsigned* MISC; gu32* ctl;
    int tid, lane, wave, vcu, G;
    unsigned char* ws_;
};
__device__ __forceinline__ unsigned char* ws_of(const Frame& F) { unsigned long long p = (unsigned long long)F.ws_; asm volatile("" : "+s"(p)); return (unsigned char*)p; }
__device__ __forceinline__ Frame opaque_frame(const Frame& F0) { Frame F = F0; asm volatile("" : "+v"(F.tid)); F.lane = F.tid & 63; asm volatile("" : "+s"(F.wave), "+s"(F.vcu), "+s"(F.G)); return F; }
__device__ __forceinline__ const float* inp(const Frame& F, int i) {
    const volatile LAS unsigned* t = F.MISC + 16 + 2 * i; const unsigned lo = __builtin_amdgcn_readfirstlane(t[0]), hi = __builtin_amdgcn_readfirstlane(t[1]);
    return (const float*)(((unsigned long long)hi << 32) | lo); }

template <int MODE> __device__ __forceinline__ int dest_row(int n) {
    if (MODE == 1) {
        if (n < 2 * AW) { const int hb = n & ~63, d = n & 63, half = d >> 5, f = d & 31; return hb + 8 * (f >> 2) + 4 * half + (f & 3); }
        return n;
    } else if (MODE == 2) {
        const int ac = n >> 1, typ = n & 1, pn = ac >> 7, al = ac & 127, q8 = al >> 3, bj = (al >> 2) & 1, j = al & 3, wc = q8 >> 2, fq = q8 & 3;
        return 256 * pn + 128 * bj + 32 * wc + 8 * fq + 4 * typ + j;
    }
    return n;
}
template <int MODE> __device__ __forceinline__ void cvt_item(const float* W, int K, int N, bf16* WT, LAS float* scr, int item, int lane) {
    const int nblk = N / 64, kb = item / nblk, nb = item % nblk, k0 = kb * 64, n0 = nb * 64;
    const int lr = lane >> 4, lc = (lane & 15) * 4;
    f32x4 v[16];
#pragma unroll
    for (int i = 0; i < 16; ++i) v[i] = *(const f32x4*)(W + (size_t)(k0 + 4 * i + lr) * N + n0 + lc);
#pragma unroll
    for (int i = 0; i < 16; ++i) { LAS float* s = scr + (4 * i + lr) * 65 + lc; s[0] = v[i][0]; s[1] = v[i][1]; s[2] = v[i][2]; s[3] = v[i][3]; }
    LDS_WAIT(); asm volatile("" ::: "memory");
    const int kc = lane & 7;
#pragma unroll
    for (int jj = 0; jj < 8; ++jj) { const int n = (lane >> 3) + 8 * jj; const LAS float* s = scr + (8 * kc) * 65 + n;
        u32x4 o; o.x = pk2(s[0], s[65]); o.y = pk2(s[2 * 65], s[3 * 65]); o.z = pk2(s[4 * 65], s[5 * 65]); o.w = pk2(s[6 * 65], s[7 * 65]);
        *(u32x4*)(WT + (size_t)dest_row<MODE>(n0 + n) * K + k0 + 8 * kc) = o; }
    LDS_WAIT(); asm volatile("" ::: "memory");
}

__device__ __forceinline__ void modnorm_store(const f32x4 (&v)[4], const float* g, const float* sc, const float* sh, bf16* orow, int lane) {
    float s = 0.f;
#pragma unroll
    for (int j = 0; j < 4; ++j) s += (v[j][0] * v[j][0] + v[j][1] * v[j][1]) + (v[j][2] * v[j][2] + v[j][3] * v[j][3]);
    const float rstd = 1.0f / sqrtf(wave_sum(s) * (1.0f / D) + RMS_EPS);
#pragma unroll
    for (int j = 0; j < 4; ++j) { const int c = 4 * lane + 256 * j; const f32x4 gv = *(const f32x4*)(g + c), sv = *(const f32x4*)(sc + c), hv = *(const f32x4*)(sh + c);
        const f32x4 y = v[j] * rstd * gv * (sv + 1.0f) + hv; u32x2 w; w.x = pk2(y[0], y[1]); w.y = pk2(y[2], y[3]); *(u32x2*)(orow + c) = w; }
}

__device__ __forceinline__ void phase_pr0(const Frame& F0) {
    const Frame F = opaque_frame(F0);
    unsigned char* ws = ws_of(F);
    const float* in_c = inp(F, IN_C); const float* in_wada = inp(F, IN_WADA); const float* in_bada = inp(F, IN_BADA); const int* in_pos = (const int*)inp(F, IN_POS);
    const float* in_wr = inp(F, IN_WR); const float* in_ws = inp(F, IN_WS); const float* in_b1 = inp(F, IN_B1);
    {
        LAS float* sl = (LAS float*)F.lds;
        LAS float* red = (LAS float*)(F.lds + 32768);
        float* MOD = (float*)(ws + WS_MOD);
        for (int i = F.tid; i < BATCH * D; i += NTHR) { const int b = i >> 10, k = i & 1023; const float cv = in_c[i]; sl[k * 8 + b] = cv * sigmoidf_(cv); }
        __syncthreads();
        for (int it = blockIdx.x; it < DEPTH * 96; it += F.G) {
            const int l = it / 96, col = (it % 96) * 64 + F.lane;
            const float* W = in_wada + (size_t)l * D * 6144 + col;
            float a[8];
#pragma unroll
            for (int b = 0; b < 8; ++b) a[b] = 0.f;
            const int kb = F.wave * 128;
#pragma unroll 8
            for (int k = 0; k < 128; ++k) { const float w = W[(size_t)(kb + k) * 6144]; const f32x4 s0 = *(const LAS f32x4*)(sl + (kb + k) * 8), s1 = *(const LAS f32x4*)(sl + (kb + k) * 8 + 4);
                a[0] += s0[0] * w; a[1] += s0[1] * w; a[2] += s0[2] * w; a[3] += s0[3] * w; a[4] += s1[0] * w; a[5] += s1[1] * w; a[6] += s1[2] * w; a[7] += s1[3] * w; }
#pragma unroll
            for (int b = 0; b < 8; ++b) red[(F.wave * 8 + b) * 64 + F.lane] = a[b];
            __syncthreads();
            { const int b = F.wave; float s = 0.f;
#pragma unroll
              for (int w = 0; w < 8; ++w) s += red[(w * 8 + b) * 64 + F.lane];
              MOD[((size_t)l * BATCH + b) * 6144 + col] = s + in_bada[l * 6144 + col]; }
            __syncthreads();
        }
        __syncthreads();
    }
    const int gw = F.vcu * NWAVES + F.wave, NGW = F.G * NWAVES;
    const int gt = F.vcu * NTHR + F.tid, NGT = F.G * NTHR;
    {
        float* RC = (float*)(ws + WS_ROPEC); float* RS = (float*)(ws + WS_ROPES);
        for (int i = gt; i < NTOK * 32; i += NGT) { const int row = i >> 5, f = i & 31;
            const float invf = (float)exp(-(double)f * (9.210340371976184 / 32.0));
            const float ang = (float)in_pos[row] * invf;
            const double x = (double)ang; const double k = rint(x * 0.15915494309189535); const float r = (float)(x - k * 6.283185307179586);
            RC[i] = __cosf(r); RS[i] = __sinf(r); }
    }
    {
        bf16* WRH = (bf16*)(ws + WS_WRH); bf16* WRL = (bf16*)(ws + WS_WRL);
        for (int i = gt; i < DEPTH * NE * D; i += NGT) { const int l = i / (NE * D), e = (i / D) % NE, d = i % D; const float w = in_wr[((size_t)l * D + d) * NE + e];
            const unsigned h = pk2(w, 0.f) & 0xffffu; const float lo = w - bf2f((bf16)h); WRH[i] = (bf16)h; WRL[i] = (bf16)(pk2(lo, 0.f) & 0xffffu); }
        bf16* WSB = (bf16*)(ws + WS_WSB);
        for (int i = gt; i < DEPTH * 4 * 128 * 128; i += NGT) { const int t = (i >> 7) & 127, s = i & 127; WSB[i] = (s <= t) ? (bf16)(pk2(in_ws[i], 0.f) & 0xffffu) : (bf16)0; }
        float* B1P = (float*)(ws + WS_B1P);
        for (int i = gt; i < DEPTH * NE * 2048; i += NGT) { const int n = i & 2047; B1P[(i & ~2047) + dest_row<2>(n)] = in_b1[i]; }
    }
    {
        LAS float* scr = (LAS float*)(F.lds + F.wave * 16640);
        const float* in_win = inp(F, IN_WIN); const float* in_wpa = inp(F, IN_WPA); const float* in_wpg = inp(F, IN_WPG); const float* in_wo = inp(F, IN_WO); const float* in_w1 = inp(F, IN_W1); const float* in_w2 = inp(F, IN_W2);
        constexpr int I_IN = 16 * 84, I_PA = 4 * 16, I_PG = 8 * 16, I_O = 16 * 16, I_1 = 16 * 32, I_2 = 16 * 16;
        constexpr int N_IN = DEPTH * I_IN, N_PA = DEPTH * I_PA, N_PG = DEPTH * I_PG, N_O = DEPTH * I_O, N_1 = DEPTH * NE * I_1, N_2 = DEPTH * NE * I_2;
        constexpr int NITEMS = N_IN + N_PA + N_PG + N_O + N_1 + N_2;
        for (int it = gw; it < NITEMS; it += NGW) {
            int r = it;
            if (r < N_IN) { const int m = r / I_IN; cvt_item<1>(in_win + (size_t)m * D * INW, D, INW, (bf16*)(ws + WS_WTIN) + (size_t)m * INW * D, scr, r % I_IN, F.lane); continue; } r -= N_IN;
            if (r < N_PA) { const int m = r / I_PA; cvt_item<0>(in_wpa + (size_t)m * AO * D, AO, D, (bf16*)(ws + WS_WTPA) + (size_t)m * D * AO, scr, r % I_PA, F.lane); continue; } r -= N_PA;
            if (r < N_PG) { const int m = r / I_PG; cvt_item<0>(in_wpg + (size_t)m * GW * D, GW, D, (bf16*)(ws + WS_WTPG) + (size_t)m * D * GW, scr, r % I_PG, F.lane); continue; } r -= N_PG;
            if (r < N_O) { const int m = r / I_O; cvt_item<0>(in_wo + (size_t)m * D * D, D, D, (bf16*)(ws + WS_WTO) + (size_t)m * D * D, scr, r % I_O, F.lane); continue; } r -= N_O;
            if (r < N_1) { const int m = r / I_1; cvt_item<2>(in_w1 + (size_t)m * D * 2048, D, 2048, (bf16*)(ws + WS_W1T) + (size_t)m * 2048 * D, scr, r % I_1, F.lane); continue; } r -= N_1;
            { const int m = r / I_2; cvt_item<0>(in_w2 + (size_t)m * DFF * D, DFF, D, (bf16*)(ws + WS_W2T) + (size_t)m * D * DFF, scr, r % I_2, F.lane); }
        }
    }
}

__device__ __forceinline__ void phase_pr1(const Frame& F0) {
    const Frame F = opaque_frame(F0);
    const int gw = F.vcu * NWAVES + F.wave, NGW = F.G * NWAVES;
    unsigned char* ws = ws_of(F);
    const float* MOD = (const float*)(ws + WS_MOD); bf16* AIN = (bf16*)(ws + WS_AIN);
    const float* in_x = inp(F, IN_X); const float* in_n1g = inp(F, IN_N1G);
    for (int t = gw; t < NTOK; t += NGW) { const int b = t / SEQ; const float* mp = MOD + (size_t)b * 6144;
        f32x4 v[4];
#pragma unroll
        for (int j = 0; j < 4; ++j) v[j] = *(const f32x4*)(in_x + (size_t)t * D + 4 * F.lane + 256 * j);
        modnorm_store(v, in_n1g, mp + 1024, mp, AIN + (size_t)t * D, F.lane); }
}

__device__ __forceinline__ int crow(int r, int hi) { return (r & 3) + 8 * (r >> 2) + 4 * hi; }
constexpr int VSTR = 192;
__device__ __forceinline__ s16x4 tr_read(const LAS unsigned char* p) { typedef short v4i16_t __attribute__((ext_vector_type(4))); return __builtin_bit_cast(s16x4, __builtin_amdgcn_ds_read_tr16_b64_v4i16((LAS v4i16_t*)p)); }
__device__ __forceinline__ float half_swap_max(float m) { auto rr = __builtin_amdgcn_permlane32_swap(__float_as_uint(m), __float_as_uint(m), false, false); return fmaxf(__uint_as_float(rr[0]), __uint_as_float(rr[1])); }
__device__ __forceinline__ float half_swap_sum(float m) { auto rr = __builtin_amdgcn_permlane32_swap(__float_as_uint(m), __float_as_uint(m), false, false); return __uint_as_float(rr[0]) + __uint_as_float(rr[1]); }

__device__ __forceinline__ void attn_item(const bf16* Qb, const bf16* Kb, const bf16* Vb, bf16* OGg, float* LSEg, int b, int r, int j, int n, int g, int h, int I, LAS unsigned char* vt, int lane) {
    const int q = lane & 31, hh = lane >> 5;
    const int colbase = g * 256 + h * 64;
    const size_t rowq = (size_t)b * SEQ + (size_t)(n * 128 + 32 * I + q) * r + j;
    bf16x8 qf[4];
#pragma unroll
    for (int s = 0; s < 4; ++s) qf[s] = *(const bf16x8*)(Qb + rowq * AW + colbase + 16 * s + 8 * hh);
    f32x16 o0, o1;
#pragma unroll
    for (int i = 0; i < 16; ++i) { o0[i] = 0.f; o1[i] = 0.f; }
    float mrun = -1e30f, lrun = 0.f;
    const int Jlo = (n == 0 && I < 4) ? 4 : I, Jhi = I + 4;
    const int gi = (lane >> 4) & 1, q4 = (lane & 15) >> 2, p4 = lane & 3;
    const LAS unsigned char* trb = vt + (4 * hh + q4) * VSTR + (16 * gi + 4 * p4) * 2;
    bf16x8 kf[4]; u32x4 vr[4];
    auto load_tile = [&](int J, bf16x8 (&kk)[4], u32x4 (&vv)[4]) {
        const size_t rowk = (size_t)b * SEQ + (size_t)((n - 1) * 128 + 32 * J + q) * r + j;
#pragma unroll
        for (int s = 0; s < 4; ++s) kk[s] = *(const bf16x8*)(Kb + rowk * AW + colbase + 16 * s + 8 * hh);
#pragma unroll
        for (int i = 0; i < 4; ++i) { const int p = lane + 64 * i, vrow = p >> 3, ch = p & 7;
            const size_t rowv = (size_t)b * SEQ + (size_t)((n - 1) * 128 + 32 * J + vrow) * r + j;
            vv[i] = *(const u32x4*)(Vb + rowv * AW + colbase + 8 * ch); }
    };
    load_tile(Jlo, kf, vr);
    for (int J = Jlo; J <= Jhi; ++J) {
        bf16x8 kn[4]; u32x4 vn[4];
        const int Jn = (J < Jhi) ? J + 1 : J;
        load_tile(Jn, kn, vn);
        f32x16 st;
#pragma unroll
        for (int i = 0; i < 16; ++i) st[i] = 0.f;
#pragma unroll
        for (int s = 0; s < 4; ++s) st = __builtin_amdgcn_mfma_f32_32x32x16_bf16(kf[s], qf[s], st, 0, 0, 0);
#pragma unroll
        for (int i = 0; i < 4; ++i) { const int p = lane + 64 * i; *(LAS u32x4*)(vt + (p >> 3) * VSTR + (p & 7) * 16) = vr[i]; }
        if (J == I) {
#pragma unroll
            for (int i = 0; i < 16; ++i) if (crow(i, hh) < q) st[i] = -1e30f;
        }
        if (J == I + 4) {
#pragma unroll
            for (int i = 0; i < 16; ++i) if (crow(i, hh) > q) st[i] = -1e30f;
        }
        float mx = st[0];
#pragma unroll
        for (int i = 1; i < 16; ++i) mx = fmaxf(mx, st[i]);
        mx = half_swap_max(mx);
        const float mnew = fmaxf(mrun, mx), alpha = fast_exp2(mrun - mnew);
        float rs = 0.f;
#pragma unroll
        for (int i = 0; i < 16; ++i) { st[i] = fast_exp2(st[i] - mnew); rs += st[i]; }
        rs = half_swap_sum(rs);
        lrun = lrun * alpha + rs; mrun = mnew;
#pragma unroll
        for (int i = 0; i < 16; ++i) { o0[i] *= alpha; o1[i] *= alpha; }
        bf16x8 pf[2];
#pragma unroll
        for (int s = 0; s < 2; ++s) { u32x4 w; w.x = pk2(st[8 * s + 0], st[8 * s + 1]); w.y = pk2(st[8 * s + 2], st[8 * s + 3]); w.z = pk2(st[8 * s + 4], st[8 * s + 5]); w.w = pk2(st[8 * s + 6], st[8 * s + 7]); pf[s] = __builtin_bit_cast(bf16x8, w); }
        LDS_WAIT();
#pragma unroll
        for (int s = 0; s < 2; ++s) {
            const s16x4 a0 = tr_read(trb + (16 * s) * VSTR), a1 = tr_read(trb + (16 * s + 8) * VSTR);
            const s16x4 c0 = tr_read(trb + (16 * s) * VSTR + 64), c1 = tr_read(trb + (16 * s + 8) * VSTR + 64);
            const bf16x8 v0 = (bf16x8){a0[0], a0[1], a0[2], a0[3], a1[0], a1[1], a1[2], a1[3]}, v1 = (bf16x8){c0[0], c0[1], c0[2], c0[3], c1[0], c1[1], c1[2], c1[3]};
            o0 = __builtin_amdgcn_mfma_f32_32x32x16_bf16(v0, pf[s], o0, 0, 0, 0);
            o1 = __builtin_amdgcn_mfma_f32_32x32x16_bf16(v1, pf[s], o1, 0, 0, 0);
        }
        LDS_WAIT();
#pragma unroll
        for (int s = 0; s < 4; ++s) { kf[s] = kn[s]; vr[s] = vn[s]; }
    }
    const float inv = 1.0f / lrun;
    bf16* op = OGg + rowq * AO + h * 64 + 4 * hh;
#pragma unroll
    for (int rq = 0; rq < 4; ++rq) {
        u32x2 w0, w1;
        w0.x = pk2(o0[4 * rq] * inv, o0[4 * rq + 1] * inv); w0.y = pk2(o0[4 * rq + 2] * inv, o0[4 * rq + 3] * inv);
        w1.x = pk2(o1[4 * rq] * inv, o1[4 * rq + 1] * inv); w1.y = pk2(o1[4 * rq + 2] * inv, o1[4 * rq + 3] * inv);
        *(u32x2*)(op + 8 * rq) = w0; *(u32x2*)(op + 32 + 8 * rq) = w1; }
    if (hh == 0) LSEg[rowq * 4 + h] = (mrun + __log2f(lrun)) * LN2;
}

__device__ __forceinline__ void phase_attn(const Frame& F0) {
    const Frame F = opaque_frame(F0);
    unsigned char* ws = ws_of(F);
    const bf16* Qb = (const bf16*)(ws + WS_QB); const bf16* Kb = (const bf16*)(ws + WS_KB); const bf16* Vb = (const bf16*)(ws + WS_VB);
    bf16* OG = (bf16*)(ws + WS_OG); float* LSE = (float*)(ws + WS_LSE);
    LAS unsigned char* vt = F.lds + F.wave * (32 * VSTR);
    for (int blk = blockIdx.x; blk < 768; blk += F.G) {
        const int g = blk >> 8, rem = blk & 255, b = rem >> 5, jn = rem & 31;
        const int r = (g == 0) ? 1 : (g == 1 ? 4 : 16), j = jn % r, n = jn / r;
        const int h = F.wave >> 1;
#pragma unroll 1
        for (int ii = 0; ii < 2; ++ii) attn_item(Qb, Kb, Vb, OG + (size_t)g * NTOK * AO, LSE + (size_t)g * NTOK * 4, b, r, j, n, g, h, 2 * (F.wave & 1) + ii, vt, F.lane);
    }
}

constexpr int ISTR = 320;
__device__ __forceinline__ void phase_gmlp(const Frame& F0, int l) {
    const Frame F = opaque_frame(F0);
    unsigned char* ws = ws_of(F);
    const bf16* VG = (const bf16*)(ws + WS_VGB); const bf16* U = (const bf16*)(ws + WS_UB); bf16* GM = (bf16*)(ws + WS_GM);
    const bf16* WSB = (const bf16*)(ws + WS_WSB) + (size_t)l * 4 * 128 * 128;
    const float* lng = inp(F, IN_LNG) + l * GW; const float* lnb = inp(F, IN_LNB) + l * GW; const float* bs = inp(F, IN_BS) + l * 4 * 128;
    LAS unsigned char* img = F.lds; LAS f32x2* ST = (LAS f32x2*)(F.lds + 128 * ISTR);
    const int lane = F.lane, q = lane & 31, hh = lane >> 5, gi = (lane >> 4) & 1, q4 = (lane & 15) >> 2, p4 = lane & 3;
    for (int un = blockIdx.x; un < NTILE128; un += F.G) {
        const size_t R0 = (size_t)un * 128;
        __syncthreads();
        for (int i = 0; i < 16; ++i) { const int tk = F.wave * 16 + i; f32x4 a, b2; pg8::unpack8(*(const u32x4*)(VG + (R0 + tk) * GW + 8 * lane), a, b2);
            const float s = wave_sum((a[0] + a[1]) + (a[2] + a[3]) + (b2[0] + b2[1]) + (b2[2] + b2[3])); const float mean = s * (1.0f / GW);
            const f32x4 da = a - mean, db = b2 - mean; const float ss = wave_sum((da[0] * da[0] + da[1] * da[1]) + (da[2] * da[2] + da[3] * da[3]) + (db[0] * db[0] + db[1] * db[1]) + (db[2] * db[2] + db[3] * db[3]));
            if (lane == 0) ST[tk] = (f32x2){mean, 1.0f / sqrtf(ss * (1.0f / GW) + LN_EPS)}; }
        __syncthreads();
        for (int g = 0; g < 4; ++g) {
            { const int ch = lane & 15; f32x4 ga, gb, ba, bb;
              ga = *(const f32x4*)(lng + g * 128 + 8 * ch); gb = *(const f32x4*)(lng + g * 128 + 8 * ch + 4); ba = *(const f32x4*)(lnb + g * 128 + 8 * ch); bb = *(const f32x4*)(lnb + g * 128 + 8 * ch + 4);
#pragma unroll
              for (int i = 0; i < 4; ++i) { const int tk = F.wave * 16 + ((lane + 64 * i) >> 4); f32x4 a, b2; pg8::unpack8(*(const u32x4*)(VG + (R0 + tk) * GW + g * 128 + 8 * ch), a, b2);
                  const f32x2 st = ST[tk]; a = (a - st.x) * st.y * ga + ba; b2 = (b2 - st.x) * st.y * gb + bb;
                  *(LAS u32x4*)(img + tk * ISTR + ch * 16) = pg8::pack8(a, b2); } }
            __syncthreads();
            const int tt = F.wave >> 1;
            f32x16 acc[2];
#pragma unroll
            for (int i = 0; i < 16; ++i) { acc[0][i] = 0.f; acc[1][i] = 0.f; }
            const bf16* wrow = WSB + ((size_t)g * 128 + 32 * tt + q) * 128 + 8 * hh;
            for (int ks = 0; ks < 2 * (tt + 1); ++ks) {
                const bf16x8 bfrag = *(const bf16x8*)(wrow + 16 * ks);
#pragma unroll
                for (int cc = 0; cc < 2; ++cc) { const int ct = 2 * (F.wave & 1) + cc;
                    const LAS unsigned char* tb = img + (16 * ks + 8 * hh + q4) * ISTR + (32 * ct + 16 * gi + 4 * p4) * 2;
                    const s16x4 a0 = tr_read(tb), a1 = tr_read(tb + 4 * ISTR);
                    const bf16x8 af = (bf16x8){a0[0], a0[1], a0[2], a0[3], a1[0], a1[1], a1[2], a1[3]};
                    acc[cc] = __builtin_amdgcn_mfma_f32_32x32x16_bf16(af, bfrag, acc[cc], 0, 0, 0); }
            }
            { const int t = 32 * tt + q; const size_t row = R0 + t; const float bias = bs[g * 128 + t];
#pragma unroll
              for (int cc = 0; cc < 2; ++cc) { const int ct = 2 * (F.wave & 1) + cc;
#pragma unroll
                  for (int rq = 0; rq < 4; ++rq) { const int c0 = g * 128 + 32 * ct + 8 * rq + 4 * hh; const u32x2 uw = *(const u32x2*)(U + row * GW + c0);
                      u32x2 w; w.x = pk2((acc[cc][4 * rq] + bias) * bf_lo(uw.x), (acc[cc][4 * rq + 1] + bias) * bf_hi(uw.x)); w.y = pk2((acc[cc][4 * rq + 2] + bias) * bf_lo(uw.y), (acc[cc][4 * rq + 3] + bias) * bf_hi(uw.y));
                      *(u32x2*)(GM + row * GW + c0) = w; } } }
            __syncthreads();
        }
    }
}

__device__ __forceinline__ void phase_merge(const Frame& F0) {
    const Frame F = opaque_frame(F0);
    const int gw = F.vcu * NWAVES + F.wave, NGW = F.G * NWAVES;
    unsigned char* ws = ws_of(F);
    const bf16* OG = (const bf16*)(ws + WS_OG); const float* LSE = (const float*)(ws + WS_LSE); bf16* ATT = (bf16*)(ws + WS_ATT);
    const int lane = F.lane, h = lane >> 4;
    for (int t = gw; t < NTOK; t += NGW) {
        const float l0 = LSE[(size_t)t * 4 + h], l1 = LSE[((size_t)NTOK + t) * 4 + h], l2 = LSE[((size_t)2 * NTOK + t) * 4 + h];
        const float mx = fmaxf(l0, fmaxf(l1, l2)); float w0 = fast_exp2((l0 - mx) * LOG2E), w1 = fast_exp2((l1 - mx) * LOG2E), w2 = fast_exp2((l2 - mx) * LOG2E);
        const float inv = 1.0f / (w0 + w1 + w2); w0 *= inv; w1 *= inv; w2 *= inv;
        const u32x2 a = *(const u32x2*)(OG + (size_t)t * AO + 4 * lane), b = *(const u32x2*)(OG + ((size_t)NTOK + t) * AO + 4 * lane), c = *(const u32x2*)(OG + ((size_t)2 * NTOK + t) * AO + 4 * lane);
        u32x2 w; w.x = pk2(w0 * bf_lo(a.x) + w1 * bf_lo(b.x) + w2 * bf_lo(c.x), w0 * bf_hi(a.x) + w1 * bf_hi(b.x) + w2 * bf_hi(c.x));
        w.y = pk2(w0 * bf_lo(a.y) + w1 * bf_lo(b.y) + w2 * bf_lo(c.y), w0 * bf_hi(a.y) + w1 * bf_hi(b.y) + w2 * bf_hi(c.y));
        *(u32x2*)(ATT + (size_t)t * AO + 4 * lane) = w;
    }
}

__device__ __forceinline__ void phase_router(const Frame& F0, int l) {
    const Frame F = opaque_frame(F0);
    unsigned char* ws = ws_of(F);
    const float* H = (const float*)(ws + WS_HB1); bf16* FB = (bf16*)(ws + WS_AIN);
    const float* MOD = (const float*)(ws + WS_MOD) + (size_t)l * BATCH * 6144;
    const bf16* WRH = (const bf16*)(ws + WS_WRH) + (size_t)l * NE * D; const bf16* WRL = (const bf16*)(ws + WS_WRL) + (size_t)l * NE * D;
    int* TOPI = (int*)(ws + WS_TOPI); float* TOPG = (float*)(ws + WS_TOPG); int* WGH = (int*)(ws + WS_WGH);
    const float* n2g = inp(F, IN_N2G) + l * D; const float* br = inp(F, IN_BR) + l * NE;
    LAS float* LG = (LAS float*)(F.lds + F.wave * 2048);
    LAS int* EX = (LAS int*)(F.lds + 16384);
    LAS int* HIST = (LAS int*)(F.lds + 16384 + 2048);
    const int lane = F.lane, tl = lane & 15, kq = lane >> 4;
    for (int tile = blockIdx.x; tile < NTILE128; tile += F.G) {
        __syncthreads();
        if (F.tid < 32) HIST[F.tid] = 0;
        const int T = tile * 128 + F.wave * 16 + tl, b = (tile * 128) / SEQ;
        const float* hrow = H + (size_t)T * D + 8 * kq;
        const float* sc2 = MOD + (size_t)b * 6144 + 4 * 1024; const float* sh2 = MOD + (size_t)b * 6144 + 3 * 1024;
        float ss = 0.f;
#pragma unroll 8
        for (int ks = 0; ks < 32; ++ks) { const f32x4 a = *(const f32x4*)(hrow + 32 * ks), c = *(const f32x4*)(hrow + 32 * ks + 4);
            ss += (a[0] * a[0] + a[1] * a[1]) + (a[2] * a[2] + a[3] * a[3]) + (c[0] * c[0] + c[1] * c[1]) + (c[2] * c[2] + c[3] * c[3]); }
        ss += __shfl_xor(ss, 16); ss += __shfl_xor(ss, 32);
        const float rstd = 1.0f / sqrtf(ss * (1.0f / D) + RMS_EPS);
        f32x4 acc0 = {0.f, 0.f, 0.f, 0.f}, acc1 = {0.f, 0.f, 0.f, 0.f};
#pragma unroll 2
        for (int ks = 0; ks < 32; ++ks) { const int c0 = 32 * ks + 8 * kq;
            f32x4 a = *(const f32x4*)(hrow + 32 * ks), c = *(const f32x4*)(hrow + 32 * ks + 4);
            const f32x4 g0 = *(const f32x4*)(n2g + c0), g1 = *(const f32x4*)(n2g + c0 + 4), s0 = *(const f32x4*)(sc2 + c0), s1 = *(const f32x4*)(sc2 + c0 + 4), h0 = *(const f32x4*)(sh2 + c0), h1 = *(const f32x4*)(sh2 + c0 + 4);
            a = a * rstd * g0 * (s0 + 1.0f) + h0; c = c * rstd * g1 * (s1 + 1.0f) + h1;
            const u32x4 hi = pg8::pack8(a, c); f32x4 ah, ch; pg8::unpack8(hi, ah, ch); const u32x4 lo = pg8::pack8(a - ah, c - ch);
            *(u32x4*)(FB + (size_t)T * D + c0) = hi;
            const bf16x8 fh = __builtin_bit_cast(bf16x8, hi), fl = __builtin_bit_cast(bf16x8, lo);
            const bf16x8 wh0 = *(const bf16x8*)(WRH + (size_t)tl * D + c0), wh1 = *(const bf16x8*)(WRH + (size_t)(16 + tl) * D + c0);
            const bf16x8 wl0 = *(const bf16x8*)(WRL + (size_t)tl * D + c0), wl1 = *(const bf16x8*)(WRL + (size_t)(16 + tl) * D + c0);
            acc0 = __builtin_amdgcn_mfma_f32_16x16x32_bf16(fh, wh0, acc0, 0, 0, 0); acc0 = __builtin_amdgcn_mfma_f32_16x16x32_bf16(fl, wh0, acc0, 0, 0, 0); acc0 = __builtin_amdgcn_mfma_f32_16x16x32_bf16(fh, wl0, acc0, 0, 0, 0);
            acc1 = __builtin_amdgcn_mfma_f32_16x16x32_bf16(fh, wh1, acc1, 0, 0, 0); acc1 = __builtin_amdgcn_mfma_f32_16x16x32_bf16(fl, wh1, acc1, 0, 0, 0); acc1 = __builtin_amdgcn_mfma_f32_16x16x32_bf16(fh, wl1, acc1, 0, 0, 0); }
        { const float b0 = br[tl], b1 = br[16 + tl];
#pragma unroll
          for (int rg = 0; rg < 4; ++rg) { LG[(4 * kq + rg) * 32 + tl] = acc0[rg] + b0; LG[(4 * kq + rg) * 32 + 16 + tl] = acc1[rg] + b1; } }
        LDS_WAIT();
        if (lane < 16) {
            float v[32];
#pragma unroll
            for (int i = 0; i < 8; ++i) { const f32x4 x = *(const LAS f32x4*)(LG + lane * 32 + 4 * i); v[4 * i] = x[0]; v[4 * i + 1] = x[1]; v[4 * i + 2] = x[2]; v[4 * i + 3] = x[3]; }
            int ti[4]; float tv[4];
#pragma unroll
            for (int k = 0; k < 4; ++k) { float best = -3.0e38f; int bi = 0;
#pragma unroll
                for (int e = 0; e < 32; ++e) { const bool taken = (k > 0 && ti[0] == e) || (k > 1 && ti[1] == e) || (k > 2 && ti[2] == e); if (!taken && v[e] > best) { best = v[e]; bi = e; } }
                ti[k] = bi; tv[k] = best; }
            const float e1 = fast_exp2((tv[1] - tv[0]) * LOG2E), e2 = fast_exp2((tv[2] - tv[0]) * LOG2E), e3 = fast_exp2((tv[3] - tv[0]) * LOG2E); const float inv = 1.0f / (1.0f + e1 + e2 + e3);
            const int Tt = tile * 128 + F.wave * 16 + lane;
            *(i32x4*)(TOPI + (size_t)Tt * 4) = (i32x4){ti[0], ti[1], ti[2], ti[3]}; *(f32x4*)(TOPG + (size_t)Tt * 4) = (f32x4){inv, e1 * inv, e2 * inv, e3 * inv};
            *(LAS i32x4*)(EX + (F.wave * 16 + lane) * 4) = (i32x4){ti[0], ti[1], ti[2], ti[3]};
        }
        __syncthreads();
        __hip_atomic_fetch_add(&HIST[EX[F.tid]], 1, __ATOMIC_RELAXED, __HIP_MEMORY_SCOPE_WORKGROUP);
        __syncthreads();
        if (F.tid < 32) WGH[tile * 32 + F.tid] = HIST[F.tid];
    }
}

__device__ __forceinline__ void phase_positions(const Frame& F0) {
    const Frame F = opaque_frame(F0);
    unsigned char* ws = ws_of(F);
    const int* WGH = (const int*)(ws + WS_WGH); const int* TOPI = (const int*)(ws + WS_TOPI);
    int* POS = (int*)(ws + WS_POS); int* SORT = (int*)(ws + WS_SORT); int* ETAB = (int*)(ws + WS_ETAB);
    LAS int* PT = (LAS int*)F.lds;
    LAS int* PB = PT + 512;
    LAS int* CNT = PB + 512;
    LAS int* BASE = CNT + 32;
    LAS int* WC = BASE + 32;
    const int lane = F.lane;
    for (int tile = blockIdx.x; tile < NTILE128; tile += F.G) {
        __syncthreads();
        { const int e = F.tid & 31, part = F.tid >> 5; int tot = 0, bef = 0;
#pragma unroll 1
          for (int t = part * 16; t < part * 16 + 16; ++t) { const int c = WGH[t * 32 + e]; tot += c; bef += (t < tile) ? c : 0; }
          PT[part * 32 + e] = tot; PB[part * 32 + e] = bef; }
        __syncthreads();
        if (F.tid < 32) { int tot = 0, bef = 0;
#pragma unroll
            for (int p = 0; p < 16; ++p) { tot += PT[p * 32 + F.tid]; bef += PB[p * 32 + F.tid]; }
            CNT[F.tid] = tot; BASE[F.tid] = bef; }
        __syncthreads();
        if (F.tid == 0) { int off = 0, ts = 0;
            for (int e = 0; e < 32; ++e) { const int c = CNT[e]; BASE[e] += off;
                if (tile == 0) { ETAB[e] = c; ETAB[32 + e] = off; ETAB[64 + e] = ts; }
                off += c; ts += (c + 255) >> 8; }
            if (tile == 0) ETAB[96] = ts; }
        if (tile == 0 && F.tid < 256) SORT[NASG + F.tid] = 0;
        const int tok = tile * 128 + (F.tid >> 2), k = F.tid & 3;
        const int e = TOPI[(size_t)tok * 4 + k];
        int rnk = 0, mycnt = 0;
#pragma unroll 1
        for (int E = 0; E < 32; ++E) { const unsigned long long m = __ballot(e == E); if (e == E) rnk = __popcll(m & ((1ull << lane) - 1ull)); if (lane == E) mycnt = __popcll(m); }
        if (lane < 32) WC[F.wave * 32 + lane] = mycnt;
        __syncthreads();
        int wo = 0;
        for (int w = 0; w < F.wave; ++w) wo += WC[w * 32 + e];
        const int pos = BASE[e] + wo + rnk;
        SORT[pos] = tok; POS[(size_t)tok * 4 + k] = pos;
    }
}

__device__ __forceinline__ void phase_loadtab(const Frame& F0) {
    const Frame F = opaque_frame(F0);
    unsigned char* ws = ws_of(F);
    LAS int* tab = (LAS int*)(F.lds + TAB_OFF);
    __syncthreads();
    if (F.tid < 97) tab[F.tid] = ((const int*)(ws + WS_ETAB))[F.tid];
    __syncthreads();
}

__device__ __forceinline__ void phase_combine(const Frame& F0, int l) {
    const Frame F = opaque_frame(F0);
    const int gw = F.vcu * NWAVES + F.wave, NGW = F.G * NWAVES;
    unsigned char* ws = ws_of(F);
    const float* in_n1g = inp(F, IN_N1G) + (l + 1 < DEPTH ? (l + 1) * D : 0); const float* in_fg = inp(F, IN_FG); float* outp = (float*)inp(F, IN_OUT);
    const float* H1 = (const float*)(ws + WS_HB1); float* H2 = (float*)(ws + WS_HB2); const bf16* Y = (const bf16*)(ws + WS_Y);
    const int* POS = (const int*)(ws + WS_POS); const float* TOPG = (const float*)(ws + WS_TOPG);
    const float* MOD = (const float*)(ws + WS_MOD); bf16* AIN = (bf16*)(ws + WS_AIN);
    const int lane = F.lane;
    for (int t = gw; t < NTOK; t += NGW) {
        const int b = t / SEQ; const float* g2 = MOD + ((size_t)l * BATCH + b) * 6144 + 5 * 1024;
        const i32x4 ps = *(const i32x4*)(POS + (size_t)t * 4); const f32x4 gt = *(const f32x4*)(TOPG + (size_t)t * 4);
        f32x4 v[4];
#pragma unroll
        for (int j = 0; j < 4; ++j) { const int c = 4 * lane + 256 * j;
            const u32x2 y0 = *(const u32x2*)(Y + (size_t)ps.x * D + c), y1 = *(const u32x2*)(Y + (size_t)ps.y * D + c), y2 = *(const u32x2*)(Y + (size_t)ps.z * D + c), y3 = *(const u32x2*)(Y + (size_t)ps.w * D + c);
            f32x4 s;
            s[0] = gt[0] * bf_lo(y0.x) + gt[1] * bf_lo(y1.x) + gt[2] * bf_lo(y2.x) + gt[3] * bf_lo(y3.x);
            s[1] = gt[0] * bf_hi(y0.x) + gt[1] * bf_hi(y1.x) + gt[2] * bf_hi(y2.x) + gt[3] * bf_hi(y3.x);
            s[2] = gt[0] * bf_lo(y0.y) + gt[1] * bf_lo(y1.y) + gt[2] * bf_lo(y2.y) + gt[3] * bf_lo(y3.y);
            s[3] = gt[0] * bf_hi(y0.y) + gt[1] * bf_hi(y1.y) + gt[2] * bf_hi(y2.y) + gt[3] * bf_hi(y3.y);
            v[j] = *(const f32x4*)(H1 + (size_t)t * D + c) + *(const f32x4*)(g2 + c) * s; }
        if (l + 1 < DEPTH) {
#pragma unroll
            for (int j = 0; j < 4; ++j) *(f32x4*)(H2 + (size_t)t * D + 4 * lane + 256 * j) = v[j];
            const float* mp = MOD + ((size_t)(l + 1) * BATCH + b) * 6144;
            modnorm_store(v, in_n1g, mp + 1024, mp, AIN + (size_t)t * D, lane);
        } else {
            float s = 0.f;
#pragma unroll
            for (int j = 0; j < 4; ++j) s += (v[j][0] * v[j][0] + v[j][1] * v[j][1]) + (v[j][2] * v[j][2] + v[j][3] * v[j][3]);
            const float rstd = 1.0f / sqrtf(wave_sum(s) * (1.0f / D) + RMS_EPS);
#pragma unroll
            for (int j = 0; j < 4; ++j) { const int c = 4 * lane + 256 * j; *(f32x4*)(outp + (size_t)t * D + c) = v[j] * rstd * *(const f32x4*)(in_fg + c); }
        }
    }
}

constexpr int PH_PR0 = 0, PH_PR1 = 1, PH_L0 = 2, PH_PER_LAYER = 10, PH_TOTAL = PH_L0 + DEPTH * PH_PER_LAYER;

__global__ void __launch_bounds__(NTHR, 2) mk_fwd(Args args) {
    extern __shared__ __attribute__((aligned(16))) unsigned char lds_raw[];
    Frame F;
    F.lds = (LAS unsigned char*)lds_raw;
    F.MISC = (volatile LAS unsigned*)(F.lds + MISC_OFF);
    F.tid = threadIdx.x; F.lane = F.tid & 63; F.wave = __builtin_amdgcn_readfirstlane(F.tid >> 6);
    F.G = gridDim.x; { const int bx = blockIdx.x; F.vcu = (F.G % 8 == 0) ? (bx % 8) * (F.G / 8) + bx / 8 : bx; }
    F.ws_ = args.ws; F.ctl = (gu32*)(args.ws + WS_CTL);
    for (int u = F.tid; u < (LDS_BYTES - MISC_OFF) / 4; u += NTHR) ((LAS unsigned*)(F.lds + MISC_OFF))[u] = 0u;
    __syncthreads();
    if (F.tid == 0) {
        LAS unsigned long long* pt = (LAS unsigned long long*)(F.lds + MISC_OFF + 64);
#define PT_(i) pt[i] = (unsigned long long)args.in[i]
        PT_(0); PT_(1); PT_(2); PT_(3); PT_(4); PT_(5); PT_(6); PT_(7); PT_(8); PT_(9); PT_(10); PT_(11); PT_(12); PT_(13); PT_(14); PT_(15); PT_(16); PT_(17); PT_(18); PT_(19); PT_(20); PT_(21);
#undef PT_
        pt[IN_POS] = (unsigned long long)args.positions; pt[IN_OUT] = (unsigned long long)args.out;
    }
    __syncthreads();
    XcdBarrier bar; bar.bar = (unsigned*)(F.ctl + CW_BAR); bar.x = 0; bar.st = nullptr;
#if !MK_PER_PHASE
    bar = xcd_barrier_post((unsigned*)(F.ctl + CW_BAR), F.MISC + 8);
#endif
    const int lo = args.ph_lo, hi = args.ph_hi;
#ifndef MK_EN
#define MK_EN 0x1FFF
#endif
#define EN(j) (((MK_EN) >> (j)) & 1)
#define IN(k) (lo <= (k) && (k) < hi)
#if MK_PER_PHASE
#define SEAM(k) do { } while (0)
#else
#define SEAM(k) do { if (IN(k) && IN((k) + 1)) xcd_barrier(bar); } while (0)
#endif
    if (EN(0) && IN(PH_PR0)) { phase_pr0(F); } SEAM(PH_PR0);
    if (EN(1) && IN(PH_PR1)) { phase_pr1(F); } SEAM(PH_PR1);
    for (int l = 0; l < DEPTH; ++l) {
        const int P = PH_L0 + l * PH_PER_LAYER;
        if (EN(2) && IN(P + 0)) { unsigned char* ws = ws_of(F);
            pg8::PlainSched S; S.T.init(NTOK / 256, INW / 256, F.G, (int)blockIdx.x); S.A = (const char*)(ws + WS_AIN); S.B = (const char*)(ws + WS_WTIN) + (size_t)l * INW * D * 2; S.K = D;
            pg8::EpiIn E{(bf16*)(ws + WS_QB), (bf16*)(ws + WS_KB), (bf16*)(ws + WS_VB), (bf16*)(ws + WS_UB), (bf16*)(ws + WS_VGB), (bf16*)(ws + WS_GB), (const float*)(ws + WS_ROPEC), (const float*)(ws + WS_ROPES)};
            pg8::gemm_phase<pg8::EpiIn, pg8::PlainSched, false>(F.lds, D, S, E, nullptr, nullptr);
        }
        SEAM(P + 0);
        if (EN(3) && IN(P + 1)) { phase_attn(F); } if (EN(4) && IN(P + 1)) { phase_gmlp(F, l); }
        SEAM(P + 1);
        if (EN(5) && IN(P + 2)) { unsigned char* ws = ws_of(F);
            pg8::PlainSched S; S.T.init(NTOK / 256, D / 256, F.G, (int)blockIdx.x); S.A = (const char*)(ws + WS_GM); S.B = (const char*)(ws + WS_WTPG) + (size_t)l * D * GW * 2; S.K = GW;
            pg8::EpiMul1 E{(const bf16*)(ws + WS_GB), (bf16*)(ws + WS_TMP)};
            pg8::gemm_phase<pg8::EpiMul1, pg8::PlainSched, false>(F.lds, GW, S, E, nullptr, nullptr);
            phase_merge(F);
        }
        SEAM(P + 2);
        if (EN(6) && IN(P + 3)) { unsigned char* ws = ws_of(F);
            pg8::PlainSched S; S.T.init(NTOK / 256, D / 256, F.G, (int)blockIdx.x); S.A = (const char*)(ws + WS_ATT); S.B = (const char*)(ws + WS_WTPA) + (size_t)l * D * AO * 2; S.K = AO;
            pg8::EpiMul2 E{(const bf16*)(ws + WS_GB), (const bf16*)(ws + WS_TMP), (bf16*)(ws + WS_MRG)};
            pg8::gemm_phase<pg8::EpiMul2, pg8::PlainSched, false>(F.lds, AO, S, E, nullptr, nullptr);
        }
        SEAM(P + 3);
        if (EN(7) && IN(P + 4)) { unsigned char* ws = ws_of(F); const float* MODl = (const float*)(ws + WS_MOD) + (size_t)l * BATCH * 6144;
            pg8::PlainSched S; S.T.init(NTOK / 256, D / 256, F.G, (int)blockIdx.x); S.A = (const char*)(ws + WS_MRG); S.B = (const char*)(ws + WS_WTO) + (size_t)l * D * D * 2; S.K = D;
            pg8::EpiRes E{l == 0 ? inp(F, IN_X) : (const float*)(ws + WS_HB2), (float*)(ws + WS_HB1), MODl + 2 * 1024};
            pg8::gemm_phase<pg8::EpiRes, pg8::PlainSched, false>(F.lds, D, S, E, nullptr, nullptr);
        }
        SEAM(P + 4);
        if (EN(8) && IN(P + 5)) { phase_router(F, l); }
        SEAM(P + 5);
        if (EN(9) && IN(P + 6)) { phase_positions(F); }
        SEAM(P + 6);
        if (IN(P + 7) || IN(P + 8)) phase_loadtab(F);
        if (EN(10) && IN(P + 7)) { unsigned char* ws = ws_of(F);
            LAS int* tab = (LAS int*)(F.lds + TAB_OFF);
            pg8::MoeSched S; S.T.init(tab[96], 2048 / 256, F.G, (int)blockIdx.x); S.A = (const char*)(ws + WS_AIN); S.B = (const char*)(ws + WS_W1T) + (size_t)l * NE * 2048 * D * 2; S.K = D; S.bstride = (size_t)2048 * D * 2; S.tab = tab; S.gather = true;
            pg8::EpiSwiglu E{(const float*)(ws + WS_B1P) + (size_t)l * NE * 2048, (bf16*)(ws + WS_ACT)};
            pg8::gemm_phase<pg8::EpiSwiglu, pg8::MoeSched, true>(F.lds, D, S, E, (const int*)(ws + WS_SORT), (LAS int*)(F.lds + IDX_OFF));
        }
        SEAM(P + 7);
        if (EN(11) && IN(P + 8)) { unsigned char* ws = ws_of(F);
            LAS int* tab = (LAS int*)(F.lds + TAB_OFF);
            pg8::MoeSched S; S.T.init(tab[96], D / 256, F.G, (int)blockIdx.x); S.A = (const char*)(ws + WS_ACT); S.B = (const char*)(ws + WS_W2T) + (size_t)l * NE * D * DFF * 2; S.K = DFF; S.bstride = (size_t)D * DFF * 2; S.tab = tab; S.gather = false;
            pg8::EpiY E{inp(F, IN_B2) + (size_t)l * NE * D, (bf16*)(ws + WS_Y)};
            pg8::gemm_phase<pg8::EpiY, pg8::MoeSched, false>(F.lds, DFF, S, E, nullptr, nullptr);
        }
        SEAM(P + 8);
        if (EN(12) && IN(P + 9)) { phase_combine(F, l); }
        if (l + 1 < DEPTH) SEAM(P + 9);
    }
#undef IN
#undef SEAM
}

extern "C" void kernel_launch(void* const* d_in, const int* in_sizes, int n_in, void* d_out, int out_size, void* d_ws, size_t ws_size, hipStream_t stream) {
    static int grid = 0;
    if (grid == 0) {
        if (n_in != 22 || in_sizes[0] != NTOK * D || out_size != NTOK * D || ws_size < WS_END) { fprintf(stderr, "kernel_launch: unexpected shapes (n_in %d, in0 %d, out %d, ws %zu)\n", n_in, n_in > 0 ? in_sizes[0] : -1, out_size, ws_size); grid = -1; return; }
        int dev = 0, cus = 0, per_cu = 0;
        if (hipGetDevice(&dev) != hipSuccess || hipDeviceGetAttribute(&cus, hipDeviceAttributeMultiprocessorCount, dev) != hipSuccess) { grid = -1; return; }
        if (hipFuncSetAttribute((const void*)mk_fwd, hipFuncAttributeMaxDynamicSharedMemorySize, LDS_BYTES) != hipSuccess) { fprintf(stderr, "kernel_launch: hipFuncSetAttribute failed\n"); grid = -1; return; }
        if (hipOccupancyMaxActiveBlocksPerMultiprocessor(&per_cu, (const void*)mk_fwd, NTHR, LDS_BYTES) != hipSuccess || per_cu < 1) fprintf(stderr, "kernel_launch: occupancy query reports %d\n", per_cu);
        (void)hipGetLastError();
        grid = cus;
    }
    if (grid < 0) return;
    if (hipMemsetAsync((char*)d_ws + WS_CTL, 0, CTL_ZERO_BYTES, stream) != hipSuccess) return;
    Args a{};
    for (int i = 0; i < 22; ++i) a.in[i] = (const float*)d_in[i];
    a.positions = (const int*)d_in[IN_POS]; a.out = (float*)d_out; a.ws = (unsigned char*)d_ws;
#if MK_PER_PHASE
    for (int p = 0; p < PH_TOTAL; ++p) { a.ph_lo = p; a.ph_hi = p + 1; hipLaunchKernelGGL(mk_fwd, dim3(grid), dim3(NTHR), LDS_BYTES, stream, a); }
#else
    a.ph_lo = 0; a.ph_hi = PH_TOTAL; hipLaunchKernelGGL(mk_fwd, dim3(grid), dim3(NTHR), LDS_BYTES, stream, a);
#endif
}
```

```cpp
#include <hip/hip_runtime.h>
#include <cstdio>
#include <cstdint>

#ifndef MK_PER_PHASE
#define MK_PER_PHASE 0
#endif
#ifndef MK_CHECKS
#define MK_CHECKS 0
#endif

constexpr int D = 1024, BATCH = 8, SEQ = 4096, NTOK = BATCH * SEQ, DEPTH = 2;
constexpr int AW = 768, AO = 256, GW = 512, INW = 5376, NE = 32, TOPK = 4, NASG = NTOK * TOPK, DFF = 1024;
constexpr float RMS_EPS = 1e-5f, LN_EPS = 1e-5f;
constexpr int NWAVES = 8, NTHR = 512;
constexpr int NTILE128 = NTOK / 128;
constexpr float LOG2E = 1.4426950408889634f, LN2 = 0.6931471805599453f;
constexpr float QSCALE = 0.125f * LOG2E;
constexpr float F8_WSCALE = 64.0f, F8_XSCALE = 4.0f;
constexpr int F8_WS_E8M0 = 0x79797979, F8_XS_E8M0 = 0x7d7d7d7d;

constexpr size_t MiB = 1u << 20;
constexpr size_t WS_CTL = 0, CTL_ZERO_BYTES = 1 * MiB;
constexpr size_t WS_MOD = 1 * MiB;
constexpr size_t WS_ROPEC = 2 * MiB;
constexpr size_t WS_ROPES = 6 * MiB;
constexpr size_t WS_WRH = 10 * MiB;
constexpr size_t WS_WRL = 10 * MiB + 512 * 1024;
constexpr size_t WS_WSB = 11 * MiB;
constexpr size_t WS_B1P = 12 * MiB;
constexpr size_t WS_WTIN = 13 * MiB;
constexpr size_t WS_WTPA = 34 * MiB;
constexpr size_t WS_WTPG = 35 * MiB;
constexpr size_t WS_WTO = 37 * MiB;
constexpr size_t WS_W1T = 41 * MiB;
constexpr size_t WS_W2T = 297 * MiB;
constexpr size_t WS_HB1 = 425 * MiB;
constexpr size_t WS_HB2 = 553 * MiB;
constexpr size_t WS_AIN = 681 * MiB;
constexpr size_t WS_QB = 745 * MiB, WS_KB = 793 * MiB, WS_VB = 841 * MiB;
constexpr size_t WS_UB = 889 * MiB, WS_VGB = 921 * MiB;
constexpr size_t WS_GB = 953 * MiB;
constexpr size_t WS_OG = 1081 * MiB;
constexpr size_t WS_LSE = 1129 * MiB;
constexpr size_t WS_ATT = 1131 * MiB;
constexpr size_t WS_GM = 1147 * MiB;
constexpr size_t WS_TMP = 1179 * MiB;
constexpr size_t WS_MRG = 1243 * MiB;
constexpr size_t WS_TOPI = 1307 * MiB;
constexpr size_t WS_TOPG = 1307 * MiB + 512 * 1024;
constexpr size_t WS_POS = 1308 * MiB;
constexpr size_t WS_WGH = 1308 * MiB + 512 * 1024;
constexpr size_t WS_ETAB = 1308 * MiB + 640 * 1024;
constexpr size_t WS_SORT = 1309 * MiB;
constexpr size_t WS_ACT = 1310 * MiB;
constexpr size_t WS_Y = 1567 * MiB;
constexpr size_t WS_END = 1824 * MiB;
static_assert(WS_ACT + (size_t)(NASG + 256) * 1024 * 2 <= WS_Y && WS_Y + (size_t)(NASG + 256) * 1024 * 2 <= WS_END, "ws map");

constexpr int CW_TMO = 0, CW_CODE = 1, CW_BAR = 4096, CW_ERR = 16384;

constexpr int RING_BYTES = 131072;
constexpr int IDX_OFF = 139264;
constexpr int TAB_OFF = 141312;
constexpr int MISC_OFF = 141824;
constexpr int LDS_BYTES = 147456;

#define GAS __attribute__((address_space(1)))
#define LAS __attribute__((address_space(3)))
typedef unsigned short bf16;
typedef float f32x2 __attribute__((ext_vector_type(2)));
typedef float f32x4 __attribute__((ext_vector_type(4)));
typedef float f32x16 __attribute__((ext_vector_type(16)));
typedef short bf16x8 __attribute__((ext_vector_type(8)));
typedef short s16x4 __attribute__((ext_vector_type(4)));
typedef unsigned u32x2 __attribute__((ext_vector_type(2)));
typedef unsigned u32x4 __attribute__((ext_vector_type(4)));
typedef int i32x4 __attribute__((ext_vector_type(4)));
typedef __bf16 bf16x2_t __attribute__((ext_vector_type(2)));
typedef GAS unsigned gu32;
#define RLX_AGENT __ATOMIC_RELAXED, __HIP_MEMORY_SCOPE_AGENT
#define LDS_WAIT() asm volatile("s_waitcnt lgkmcnt(0)" ::: "memory")
#define VM_WAIT() asm volatile("s_waitcnt vmcnt(0)" ::: "memory")

__device__ __forceinline__ unsigned pk2(float lo, float hi) { f32x2 v = {lo, hi}; bf16x2_t b = __builtin_convertvector(v, bf16x2_t); return __builtin_bit_cast(unsigned, b); }
__device__ __forceinline__ float clamp448(float x) { return __builtin_amdgcn_fmed3f(x, -448.0f, 448.0f); }
__device__ __forceinline__ unsigned pk4_fp8(float a, float b, float c, float d) {
    unsigned t = 0; t = __builtin_amdgcn_cvt_pk_fp8_f32(clamp448(a), clamp448(b), t, false); t = __builtin_amdgcn_cvt_pk_fp8_f32(clamp448(c), clamp448(d), t, true); return t; }
__device__ __forceinline__ float bf_lo(unsigned w) { return __uint_as_float(w << 16); }
__device__ __forceinline__ float bf_hi(unsigned w) { return __uint_as_float(w & 0xffff0000u); }
__device__ __forceinline__ float bf2f(bf16 b) { return __uint_as_float(((unsigned)b) << 16); }
__device__ __forceinline__ float wave_sum(float v) {
#pragma unroll
    for (int o = 1; o < 64; o <<= 1) v += __shfl_xor(v, o);
    return v;
}
__device__ __forceinline__ float fast_exp2(float x) { return __builtin_amdgcn_exp2f(x); }
__device__ __forceinline__ float fast_rcp(float x) { return __builtin_amdgcn_rcpf(x); }
__device__ __forceinline__ float sigmoidf_(float x) { return fast_rcp(1.0f + fast_exp2(-LOG2E * x)); }
__device__ __forceinline__ float gelu_tanh(float x) {
    const float u = x + 0.044715f * x * x * x;
    return x * fast_rcp(1.0f + fast_exp2(-2.0f * 0.7978845608028654f * LOG2E * u));
}

#define XB_TMO      128
#define XB_XCNT(j)  (256  + 64 * (j))
#define XB_XSUB(j)  (1280 + 64 * (j))
#define XB_XGEN(j)  (2304 + 64 * (j))
#define XB_TOP      3328
#define XB_TOPGEN   3392
#define XCD_BAR_WORDS 3456
#define XB_SPIN_CAP (1u << 18)
__device__ __forceinline__ unsigned xb_ld(unsigned* p)              { return __hip_atomic_load(p, __ATOMIC_RELAXED, __HIP_MEMORY_SCOPE_AGENT); }
__device__ __forceinline__ unsigned xb_add(unsigned* p, unsigned v) { return __hip_atomic_fetch_add(p, v, __ATOMIC_RELAXED, __HIP_MEMORY_SCOPE_AGENT); }
__device__ __forceinline__ unsigned xb_xcc_id() { return (unsigned)__builtin_amdgcn_s_getreg((3 << 11) | 20) & 0xFu; }
#define XB_SPIN(cond, bar) do { unsigned _sp = 0; while (cond) { __builtin_amdgcn_s_sleep(1); \
    if ((++_sp & 255u) == 0u) { if (xb_ld(&(bar)[XB_TMO])) break; if (_sp > XB_SPIN_CAP) { atomicAdd(&(bar)[XB_TMO], 1u); break; } } } } while (0)
struct XcdBarrier { unsigned* bar; unsigned x; volatile LAS unsigned* st; };
__device__ __forceinline__ XcdBarrier xcd_barrier_post(unsigned* bar, volatile LAS unsigned* st) {
    XcdBarrier b; b.bar = bar; b.x = xb_xcc_id(); b.st = st;
    if (threadIdx.x == 0) (void)xb_add(&bar[XB_XCNT(b.x)], 1u);
    return b;
}
__device__ __forceinline__ void xcd_barrier_complete(unsigned* bar, unsigned x, unsigned& nloc, unsigned& nx) {
    const unsigned G = gridDim.x * gridDim.y * gridDim.z;
    unsigned sum, cnt, mine, sp = 0u;
    for (;;) {
        sum = 0u; cnt = 0u; mine = 0u;
#pragma unroll
        for (unsigned j = 0; j < 16; ++j) { const unsigned c = xb_ld(&bar[XB_XCNT(j)]); sum += c; cnt += (c > 0u) ? 1u : 0u; mine = (j == x) ? c : mine; }
        if (sum == G) break;
        __builtin_amdgcn_s_sleep(1);
        if ((++sp & 255u) == 0u) { if (xb_ld(&bar[XB_TMO])) break; if (sp > XB_SPIN_CAP) { atomicAdd(&bar[XB_TMO], 1u); break; } }
    }
    nloc = mine > 0u ? mine : 1u; nx = cnt > 0u ? cnt : 1u;
}
__device__ __forceinline__ void xcd_barrier(const XcdBarrier& b) {
    asm volatile("s_waitcnt vmcnt(0)" ::: "memory");
    __syncthreads();
    if (threadIdx.x == 0) {
        unsigned* bar = b.bar;
        __builtin_amdgcn_s_waitcnt(0);
        unsigned nloc = b.st[0], nx = b.st[1];
        if (nloc == 0u) { xcd_barrier_complete(bar, b.x, nloc, nx); b.st[0] = nloc; b.st[1] = nx; }
        const unsigned old = xb_add(&bar[XB_XSUB(b.x)], 1u);
        const unsigned gen = old / nloc;
        if (old + 1u == (gen + 1u) * nloc) {
            __builtin_amdgcn_fence(__ATOMIC_RELEASE, "agent");
            asm volatile("s_waitcnt vmcnt(0)" ::: "memory");
            const unsigned og = xb_add(&bar[XB_TOP], 1u);
            const unsigned tg = og / nx;
            if (og + 1u == (tg + 1u) * nx) xb_add(&bar[XB_TOPGEN], 1u);
            else XB_SPIN(xb_ld(&bar[XB_TOPGEN]) == tg, bar);
            __builtin_amdgcn_fence(__ATOMIC_ACQUIRE, "agent");
            xb_add(&bar[XB_XGEN(b.x)], 1u);
            asm volatile("s_waitcnt vmcnt(0)" ::: "memory");
        } else {
            XB_SPIN(xb_ld(&bar[XB_XGEN(b.x)]) == gen, bar);
            __builtin_amdgcn_fence(__ATOMIC_ACQUIRE, "agent");
            asm volatile("s_waitcnt vmcnt(0)" ::: "memory");
        }
    }
    __syncthreads();
}

namespace pg8 {
constexpr int BM = 256, BK = 64, HALF = 128, HTB = HALF * BK * 2, STAGE_BYTES = 8 * HTB, NXCD = 8, WGM = 8;
__host__ __device__ __forceinline__ int lds_byte(int r, int c) { const int st = (r >> 4) * 2 + (c >> 5), rr = r & 15, cc = c & 31, ob = rr * 64 + cc * 2; return st * 1024 + (ob ^ (((ob >> 9) & 1) << 5)); }
__host__ __device__ __forceinline__ void stage_rc(int b, int& R, int& C) { const int st = b / 1024, sb = b % 1024, swz = sb ^ (((sb >> 9) & 1) << 5); R = (st >> 1) * 16 + swz / 64; C = (st & 1) * 32 + (swz % 64) / 2; }
__host__ __device__ __forceinline__ int perm32(int rho) { const int n = rho >> 4, i = rho & 15; return 8 * (i >> 2) + 4 * n + (i & 3); }

struct Unit { int pm, pn; const char* A; const char* B; int e, rows, row0; };

struct TileOrder {
    int nM, nN, nwg, G, c;
    __device__ __forceinline__ void init(int nM_, int nN_, int G_, int c_) { nM = nM_; nN = nN_; nwg = nM * nN; G = G_; c = c_; }
    __device__ __forceinline__ bool tile(int i, int& pm, int& pn) const {
        const long L = (long)i * G + c; if (L >= nwg) return false;
        int wgid = (int)L; { const int q = nwg / NXCD, r = nwg % NXCD, xcd = wgid % NXCD, off = wgid / NXCD; wgid = (xcd < r ? xcd * (q + 1) : r * (q + 1) + (xcd - r) * q) + off; }
        const int nig = WGM * nN, gid = wgid / nig, fm = gid * WGM, gsz = (nM - fm) < WGM ? (nM - fm) : WGM;
        pm = fm + ((wgid % nig) % gsz); pn = (wgid % nig) / gsz; return true;
    }
};
struct PlainSched {
    TileOrder T; const char* A; const char* B; int K;
    __device__ __forceinline__ bool next(int i, Unit& u) const {
        if (!T.tile(i, u.pm, u.pn)) return false;
        u.A = A + (size_t)u.pm * 256 * K * 2; u.B = B + (size_t)u.pn * 256 * K * 2; u.e = 0; u.rows = 256; u.row0 = u.pm * 256; return true;
    }
};
struct MoeSched {
    TileOrder T; const char* A; const char* B; int K; size_t bstride  ; const LAS int* tab; bool gather;
    __device__ __forceinline__ bool next(int i, Unit& u) const {
        int pmg;
        if (!T.tile(i, pmg, u.pn)) return false;
        const int lane = threadIdx.x & 63;
        const int ts = tab[64 + ((lane < 32) ? lane + 1 : 32)];
        const unsigned long long m = __ballot((lane < 32) && (ts <= pmg));
        const int e = __builtin_amdgcn_readfirstlane(__popcll(m));
        const int t = pmg - __builtin_amdgcn_readfirstlane(tab[64 + e]);
        const int cnt = __builtin_amdgcn_readfirstlane(tab[e]), off = __builtin_amdgcn_readfirstlane(tab[32 + e]);
        u.pm = pmg; u.e = e; u.row0 = off + 256 * t; u.rows = (cnt - 256 * t) < 256 ? (cnt - 256 * t) : 256;
        u.A = gather ? A : A + (size_t)u.row0 * K * 2;
        u.B = B + (size_t)e * bstride + (size_t)u.pn * 256 * K * 2;
        return true;
    }
};

typedef f32x4 Acc[2][2][4][2];

template <class Epi, class Sched, bool GATHER, bool F8 = false>
__device__ __forceinline__ void gemm_phase(LAS unsigned char* lds, const int K, const Sched& S, const Epi& E, const int* gidx, LAS int* idxl) {
    int tid_ = threadIdx.x; asm volatile("" : "+v"(tid_));
    const int tid = tid_, wid = __builtin_amdgcn_readfirstlane(tid >> 6), lane = tid & 63, wr = wid >> 2, wc = wid & 3, fr = lane & 15, fq = lane >> 4;
    const int nt = K / BK;
    unsigned voffA[2], voffB[2];
#pragma unroll
    for (int i = 0; i < 2; ++i) { int R, C; stage_rc(tid * 16 + i * 8192, R, C); const int Rb = Epi::PERM ? ((R & ~31) + perm32(R & 31)) : R;
        voffA[i] = (unsigned)(R * K + C) * 2u; voffB[i] = (unsigned)(Rb * K + C) * 2u; }
    const size_t kstep = (size_t)(BK * 2);
    const size_t hstep = (size_t)HALF * K * 2;
    const unsigned ldsw = (unsigned)wid * 1024u;
    const int aoff = lds_byte(wr * 64 + fr, fq * 8), boff = lds_byte(wc * 32 + fr, fq * 8);
    unsigned vc00 = 0, vc01 = 0, vc10 = 0, vc11 = 0;
#define PG8_GOFF(ip, pre) do { int R0_, C0_, R1_, C1_; stage_rc(tid * 16, R0_, C0_); stage_rc(tid * 16 + 8192, R1_, C1_); \
        const int i00 = (ip)[R0_], i01 = (ip)[R1_], i10 = (ip)[128 + R0_], i11 = (ip)[128 + R1_]; \
        pre##00 = (unsigned)(i00 * K + C0_) * 2u; pre##01 = (unsigned)(i01 * K + C1_) * 2u; pre##10 = (unsigned)(i10 * K + C0_) * 2u; pre##11 = (unsigned)(i11 * K + C1_) * 2u; } while (0)
#define PG8_SA(b, h) (((b) * 2 + (h)) * HTB)
#define PG8_SB(b, h) ((4 + (b) * 2 + (h)) * HTB)
#define PG8_GL(sbase, voff32, dst) do { unsigned keep_; asm volatile("s_mov_b32 %0, m0\n\ts_mov_b32 m0, %3\n\ts_nop 0\n\tglobal_load_lds_dwordx4 %1, %2\n\ts_mov_b32 m0, %0" \
        : "=&s"(keep_) : "v"(voff32), "s"(sbase), "s"((unsigned)(__UINTPTR_TYPE__)(dst)) : "memory"); } while (0)
#define PG8_STAGE(bufoff, gbase, voff) do { const unsigned long long _b = (unsigned long long)(gbase); PG8_GL(_b, (voff)[0], lds + (bufoff) + ldsw); PG8_GL(_b, (voff)[1], lds + (bufoff) + ldsw + 8192); } while (0)
#define PG8_STAGE2(bufoff, gbase, v0, v1) do { const unsigned long long _b = (unsigned long long)(gbase); PG8_GL(_b, v0, lds + (bufoff) + ldsw); PG8_GL(_b, v1, lds + (bufoff) + ldsw + 8192); } while (0)
#define PG8_STAGE_A(bufoff, p, h, nx) do { if constexpr (GATHER) { if (h == 0) { if (nx) PG8_STAGE2(bufoff, p, u00, u01); else PG8_STAGE2(bufoff, p, vc00, vc01); } else { if (nx) PG8_STAGE2(bufoff, p, u10, u11); else PG8_STAGE2(bufoff, p, vc10, vc11); } } \
        else PG8_STAGE(bufoff, (p) + (h) * hstep, voffA); } while (0)
#define PG8_LDA(dst, b, h) do { _Pragma("unroll") for (int m = 0; m < 4; ++m) _Pragma("unroll") for (int k = 0; k < 2; ++k) dst[m][k] = *(const LAS bf16x8*)(lds + PG8_SA(b, h) + aoff + m * 2048 + k * 1024); } while (0)
#define PG8_LDB(dst, b, h) do { _Pragma("unroll") for (int n = 0; n < 2; ++n) _Pragma("unroll") for (int k = 0; k < 2; ++k) dst[n][k] = *(const LAS bf16x8*)(lds + PG8_SB(b, h) + boff + n * 2048 + k * 1024); } while (0)
#define PG8_CAT(x0, x1) __builtin_shufflevector(__builtin_bit_cast(i32x4, x0), __builtin_bit_cast(i32x4, x1), 0, 1, 2, 3, 4, 5, 6, 7)
#define PG8_MMA(ai, bj, At, Bt) do { __builtin_amdgcn_s_setprio(1); \
        if constexpr (F8) { _Pragma("unroll") for (int m = 0; m < 4; ++m) _Pragma("unroll") for (int n = 0; n < 2; ++n) \
            asm volatile("v_mfma_scale_f32_16x16x128_f8f6f4 %0, %1, %2, %0, %3, %4 op_sel_hi:[0,0,0]" : "+v"(acc[ai][bj][m][n]) : "v"(PG8_CAT(Bt[n][0], Bt[n][1])), "v"(PG8_CAT(At[m][0], At[m][1])), "v"(sc_w), "v"(sc_x)); } \
        else { _Pragma("unroll") for (int m = 0; m < 4; ++m) _Pragma("unroll") for (int n = 0; n < 2; ++n) _Pragma("unroll") for (int k = 0; k < 2; ++k) \
            acc[ai][bj][m][n] = __builtin_amdgcn_mfma_f32_16x16x32_bf16(Bt[n][k], At[m][k], acc[ai][bj][m][n], 0, 0, 0); } \
        __builtin_amdgcn_s_setprio(0); } while (0)
#define PG8_WAIT_V(n) asm volatile("s_waitcnt vmcnt(" #n ")" ::: "memory")
#define PG8_WAIT_L(n) asm volatile("s_waitcnt lgkmcnt(" #n ")" ::: "memory")
#define PG8_BAR __builtin_amdgcn_s_barrier()
#define PG8_SCHED __builtin_amdgcn_sched_barrier(0)
    const int sc_w = F8_WS_E8M0, sc_x = F8_XS_E8M0;
    Unit cur, nxt; int ui = 0;
    if (!S.next(0, cur)) return;
    Acc acc;
#pragma unroll
    for (int a = 0; a < 2; ++a)
#pragma unroll
        for (int b = 0; b < 2; ++b)
#pragma unroll
            for (int m = 0; m < 4; ++m)
#pragma unroll
                for (int n = 0; n < 2; ++n) acc[a][b][m][n] = (f32x4){0.f, 0.f, 0.f, 0.f};
    bf16x8 At[4][2], B0[2][2], B1[2][2];
    const char* cA = cur.A; const char* cB = cur.B;
    if constexpr (GATHER) {
        const int* gp_ = gidx + cur.row0; PG8_GOFF(gp_, vc);
        asm volatile("s_waitcnt vmcnt(0)" ::: "memory");
    }
    unsigned u00 = 0, u01 = 0, u10 = 0, u11 = 0;
    PG8_STAGE(PG8_SB(0, 0), cB, voffB); PG8_STAGE(PG8_SB(0, 1), cB + hstep, voffB); PG8_STAGE_A(PG8_SA(0, 0), cA, 0, false); PG8_STAGE_A(PG8_SA(0, 1), cA, 1, false);
    if (wr == 1) PG8_BAR;
    PG8_WAIT_V(2); PG8_BAR;
    PG8_STAGE(PG8_SB(1, 0), cB + kstep, voffB); PG8_STAGE_A(PG8_SA(1, 0), cA + kstep, 0, false); PG8_STAGE(PG8_SB(1, 1), cB + hstep + kstep, voffB);
    PG8_WAIT_V(6); PG8_BAR;
    for (;;) {
        const bool has_next = S.next(ui + 1, nxt);
        const char* nA = has_next ? nxt.A : cA; const char* nB = has_next ? nxt.B : cB;
        if constexpr (GATHER) {
            if (has_next && wid < 4) __builtin_amdgcn_global_load_lds((const unsigned*)(gidx + nxt.row0 + wid * 64 + lane), (LAS unsigned*)(idxl + ((ui + 1) & 1) * 256 + wid * 64), 4, 0, 0);
        }
#pragma unroll 1
        for (int t = 0; t < nt; t += 2) {
            const bool last = (t == nt - 2);
            const char* a1 = cA + (size_t)(t + 1) * kstep;
            const char* a2 = last ? nA : cA + (size_t)(t + 2) * kstep; const char* b2 = last ? nB : cB + (size_t)(t + 2) * kstep;
            const char* a3 = a2 + kstep; const char* b3 = b2 + kstep;
            if constexpr (GATHER) {
                u00 = vc00; u01 = vc01; u10 = vc10; u11 = vc11;
                if (last && has_next) { const LAS int* ip = idxl + ((ui + 1) & 1) * 256; PG8_GOFF(ip, u); }
            }
            PG8_LDB(B0, 0, 0); PG8_LDB(B1, 0, 1); PG8_SCHED; PG8_LDA(At, 0, 0); PG8_STAGE_A(PG8_SA(1, 1), a1, 1, false);
            PG8_WAIT_V(8); PG8_WAIT_L(0); PG8_BAR; PG8_MMA(0, 0, At, B0); PG8_MMA(0, 1, At, B1); PG8_BAR; PG8_SCHED;
            PG8_LDA(At, 0, 1); PG8_STAGE(PG8_SB(0, 0), b2, voffB); PG8_STAGE(PG8_SB(0, 1), b2 + hstep, voffB); PG8_STAGE_A(PG8_SA(0, 0), a2, 0, true);
            PG8_WAIT_V(8); PG8_WAIT_L(0); PG8_BAR; PG8_MMA(1, 0, At, B0); PG8_MMA(1, 1, At, B1); PG8_BAR; PG8_SCHED;
            PG8_LDB(B0, 1, 0); PG8_LDB(B1, 1, 1); PG8_SCHED; PG8_LDA(At, 1, 0); PG8_STAGE_A(PG8_SA(0, 1), a2, 1, true);
            PG8_WAIT_V(8); PG8_WAIT_L(0); PG8_BAR; PG8_MMA(0, 0, At, B0); PG8_MMA(0, 1, At, B1); PG8_BAR; PG8_SCHED;
            PG8_LDA(At, 1, 1); PG8_STAGE(PG8_SB(1, 0), b3, voffB); PG8_STAGE(PG8_SB(1, 1), b3 + hstep, voffB); PG8_STAGE_A(PG8_SA(1, 0), a3, 0, true);
            PG8_WAIT_V(8); PG8_WAIT_L(0); PG8_BAR; PG8_MMA(1, 0, At, B0); PG8_MMA(1, 1, At, B1); PG8_BAR; PG8_SCHED;
        }
        if constexpr (F8) asm volatile("s_nop 15\n\ts_nop 15" ::: "memory");
        if (wr == 0) PG8_BAR;
        E(acc, cur, wr, wc, fr, fq);
        if (!has_next) break;
#pragma unroll
        for (int a = 0; a < 2; ++a)
#pragma unroll
            for (int b = 0; b < 2; ++b)
#pragma unroll
                for (int m = 0; m < 4; ++m)
#pragma unroll
                    for (int n = 0; n < 2; ++n) acc[a][b][m][n] = (f32x4){0.f, 0.f, 0.f, 0.f};
        cur = nxt; cA = nA; cB = nB; ++ui;
        if constexpr (GATHER) { vc00 = u00; vc01 = u01; vc10 = u10; vc11 = u11; }
        if (wr == 1) PG8_BAR;
    }
    PG8_WAIT_V(0);
    PG8_BAR;
#undef PG8_SA
#undef PG8_SB
#undef PG8_GL
#undef PG8_STAGE
#undef PG8_STAGE2
#undef PG8_STAGE_A
#undef PG8_GOFF
#undef PG8_LDA
#undef PG8_LDB
#undef PG8_MMA
#undef PG8_CAT
#undef PG8_WAIT_V
#undef PG8_WAIT_L
#undef PG8_BAR
#undef PG8_SCHED
}

__device__ __forceinline__ u32x4 pack8(f32x4 a, f32x4 b) { u32x4 w; w.x = pk2(a[0], a[1]); w.y = pk2(a[2], a[3]); w.z = pk2(b[0], b[1]); w.w = pk2(b[2], b[3]); return w; }

struct EpiIn {
    static constexpr bool PERM = true;
    bf16 *Q, *Kb, *V, *U, *VG, *G; const float* ropec; const float* ropes;
    __device__ __forceinline__ void operator()(const Acc& acc, const Unit& u, int wr, int wc, int fr, int fq) const {
        const int pn = u.pn, row0 = u.pm * 256 + wr * 64 + fr, cl = wc * 32 + 8 * fq;
        if (pn < 6) {
            bf16* base = (pn < 3) ? Q : Kb; const int g = (pn < 3) ? pn : pn - 3; const float sc = (pn < 3) ? QSCALE : 1.0f;
            const int i4 = 4 * (4 * (wc & 1) + fq);
#pragma unroll
            for (int ai = 0; ai < 2; ++ai)
#pragma unroll
                for (int m = 0; m < 4; ++m) { const int row = row0 + ai * 128 + m * 16;
                    const f32x4 cs = *(const f32x4*)(ropec + (size_t)row * 32 + i4), sn = *(const f32x4*)(ropes + (size_t)row * 32 + i4);
#pragma unroll
                    for (int bj = 0; bj < 2; ++bj) { const f32x4 x1 = acc[ai][bj][m][0], x2 = acc[ai][bj][m][1];
                        const f32x4 o1 = (x1 * cs - x2 * sn) * sc, o2 = (x2 * cs + x1 * sn) * sc;
                        *(u32x4*)(base + (size_t)row * AW + g * 256 + bj * 128 + cl) = pack8(o1, o2); }
                    __builtin_amdgcn_sched_barrier(0); }
        } else if (pn < 9) {
            const int cb = (pn - 6) * 256;
#pragma unroll
            for (int ai = 0; ai < 2; ++ai)
#pragma unroll
                for (int m = 0; m < 4; ++m) { const int row = row0 + ai * 128 + m * 16;
#pragma unroll
                    for (int bj = 0; bj < 2; ++bj) *(u32x4*)(V + (size_t)row * AW + cb + bj * 128 + cl) = pack8(acc[ai][bj][m][0], acc[ai][bj][m][1]);
                    __builtin_amdgcn_sched_barrier(0); }
        } else if (pn < 13) {
            bf16* base = (pn < 11) ? U : VG; const int cb = ((pn - 9) & 1) * 256;
#pragma unroll
            for (int ai = 0; ai < 2; ++ai)
#pragma unroll
                for (int m = 0; m < 4; ++m) { const int row = row0 + ai * 128 + m * 16;
#pragma unroll
                    for (int bj = 0; bj < 2; ++bj) { f32x4 a = acc[ai][bj][m][0], b = acc[ai][bj][m][1];
#pragma unroll
                        for (int j = 0; j < 4; ++j) { a[j] = gelu_tanh(a[j]); b[j] = gelu_tanh(b[j]); }
                        *(u32x4*)(base + (size_t)row * GW + cb + bj * 128 + cl) = pack8(a, b); }
                    __builtin_amdgcn_sched_barrier(0); }
        } else {
            const int cb = (pn - 13) * 256;
#pragma unroll
            for (int ai = 0; ai < 2; ++ai)
#pragma unroll
                for (int m = 0; m < 4; ++m) { const int row = row0 + ai * 128 + m * 16;
#pragma unroll
                    for (int bj = 0; bj < 2; ++bj) { f32x4 a = acc[ai][bj][m][0], b = acc[ai][bj][m][1];
#pragma unroll
                        for (int j = 0; j < 4; ++j) { a[j] = sigmoidf_(a[j]); b[j] = sigmoidf_(b[j]); }
                        *(u32x4*)(G + (size_t)row * 2048 + cb + bj * 128 + cl) = pack8(a, b); }
                    __builtin_amdgcn_sched_barrier(0); }
        }
    }
};
__device__ __forceinline__ void unpack8(u32x4 w, f32x4& a, f32x4& b) { a = (f32x4){bf_lo(w.x), bf_hi(w.x), bf_lo(w.y), bf_hi(w.y)}; b = (f32x4){bf_lo(w.z), bf_hi(w.z), bf_lo(w.w), bf_hi(w.w)}; }
struct EpiMul1 {
    static constexpr bool PERM = true;
    const bf16* G; bf16* T;
    __device__ __forceinline__ void operator()(const Acc& acc, const Unit& u, int wr, int wc, int fr, int fq) const {
        const int row0 = u.pm * 256 + wr * 64 + fr, c0 = u.pn * 256 + wc * 32 + 8 * fq;
#pragma unroll
        for (int ai = 0; ai < 2; ++ai)
#pragma unroll
            for (int m = 0; m < 4; ++m) { const int row = row0 + ai * 128 + m * 16;
#pragma unroll
                for (int bj = 0; bj < 2; ++bj) { f32x4 ga, gb; unpack8(*(const u32x4*)(G + (size_t)row * 2048 + 1024 + c0 + bj * 128), ga, gb);
                    *(u32x4*)(T + (size_t)row * D + c0 + bj * 128) = pack8(acc[ai][bj][m][0] * ga, acc[ai][bj][m][1] * gb); }
                asm volatile("" ::: "memory"); __builtin_amdgcn_sched_barrier(0); }
    }
};
struct EpiMul2 {
    static constexpr bool PERM = true;
    const bf16* G; const bf16* T; bf16* O;
    __device__ __forceinline__ void operator()(const Acc& acc, const Unit& u, int wr, int wc, int fr, int fq) const {
        const int row0 = u.pm * 256 + wr * 64 + fr, c0 = u.pn * 256 + wc * 32 + 8 * fq;
#pragma unroll
        for (int ai = 0; ai < 2; ++ai)
#pragma unroll
            for (int m = 0; m < 4; ++m) { const int row = row0 + ai * 128 + m * 16;
#pragma unroll
                for (int bj = 0; bj < 2; ++bj) { f32x4 ga, gb, ta, tb; unpack8(*(const u32x4*)(G + (size_t)row * 2048 + c0 + bj * 128), ga, gb); unpack8(*(const u32x4*)(T + (size_t)row * D + c0 + bj * 128), ta, tb);
                    *(u32x4*)(O + (size_t)row * D + c0 + bj * 128) = pack8(acc[ai][bj][m][0] * ga + ta, acc[ai][bj][m][1] * gb + tb); }
                asm volatile("" ::: "memory"); __builtin_amdgcn_sched_barrier(0); }
    }
};
struct EpiRes {
    static constexpr bool PERM = true;
    const float* Hin; float* Hout; const float* g1;
    __device__ __forceinline__ void operator()(const Acc& acc, const Unit& u, int wr, int wc, int fr, int fq) const {
        const int row0 = u.pm * 256 + wr * 64 + fr, c0 = u.pn * 256 + wc * 32 + 8 * fq;
        const float* gp = g1 + (size_t)((u.pm * 256) / SEQ) * 6144;
        f32x4 gv[2][2];
#pragma unroll
        for (int bj = 0; bj < 2; ++bj) { gv[bj][0] = *(const f32x4*)(gp + c0 + bj * 128); gv[bj][1] = *(const f32x4*)(gp + c0 + bj * 128 + 4); }
#pragma unroll
        for (int ai = 0; ai < 2; ++ai)
#pragma unroll
            for (int m = 0; m < 4; ++m) { const size_t ro = (size_t)(row0 + ai * 128 + m * 16) * D;
#pragma unroll
                for (int bj = 0; bj < 2; ++bj) { const size_t o = ro + c0 + bj * 128;
                    const f32x4 h0 = *(const f32x4*)(Hin + o), h1 = *(const f32x4*)(Hin + o + 4);
                    *(f32x4*)(Hout + o) = h0 + gv[bj][0] * acc[ai][bj][m][0]; *(f32x4*)(Hout + o + 4) = h1 + gv[bj][1] * acc[ai][bj][m][1]; }
                asm volatile("" ::: "memory"); __builtin_amdgcn_sched_barrier(0); }
    }
};
struct EpiSwiglu {
    static constexpr bool PERM = true;
    const float* b1p; unsigned char* ACT;
    __device__ __forceinline__ void operator()(const Acc& acc, const Unit& u, int wr, int wc, int fr, int fq) const {
        const float* bp = b1p + (size_t)u.e * 2048 + u.pn * 256 + wc * 32 + 8 * fq;
        f32x4 bv[2][2];
#pragma unroll
        for (int bj = 0; bj < 2; ++bj) { bv[bj][0] = *(const f32x4*)(bp + bj * 128); bv[bj][1] = *(const f32x4*)(bp + bj * 128 + 4); }
        const int ac0 = u.pn * 128 + 8 * (4 * wc + fq);
#pragma unroll
        for (int ai = 0; ai < 2; ++ai)
#pragma unroll
            for (int m = 0; m < 4; ++m) { const int rl = ai * 128 + wr * 64 + m * 16 + fr;
                f32x4 o[2];
#pragma unroll
                for (int bj = 0; bj < 2; ++bj) { const f32x4 gl = acc[ai][bj][m][0] + bv[bj][0], li = acc[ai][bj][m][1] + bv[bj][1];
#pragma unroll
                    for (int j = 0; j < 4; ++j) { const float xg = fminf(gl[j], 7.0f), xl = fminf(fmaxf(li[j], -7.0f), 7.0f); o[bj][j] = xg * sigmoidf_(1.702f * xg) * (xl + 1.0f); } }
                if (rl < u.rows) { u32x2 w; w.x = pk4_fp8(o[0][0] * F8_XSCALE, o[0][1] * F8_XSCALE, o[0][2] * F8_XSCALE, o[0][3] * F8_XSCALE); w.y = pk4_fp8(o[1][0] * F8_XSCALE, o[1][1] * F8_XSCALE, o[1][2] * F8_XSCALE, o[1][3] * F8_XSCALE);
                    *(u32x2*)(ACT + (size_t)(u.row0 + rl) * DFF + ac0) = w; }
                __builtin_amdgcn_sched_barrier(0); }
    }
};
struct EpiY {
    static constexpr bool PERM = true;
    const float* b2; bf16* Y;
    __device__ __forceinline__ void operator()(const Acc& acc, const Unit& u, int wr, int wc, int fr, int fq) const {
        const int c0 = u.pn * 256 + wc * 32 + 8 * fq;
        const float* bp = b2 + (size_t)u.e * 1024 + c0;
        f32x4 bv[2][2];
#pragma unroll
        for (int bj = 0; bj < 2; ++bj) { bv[bj][0] = *(const f32x4*)(bp + bj * 128); bv[bj][1] = *(const f32x4*)(bp + bj * 128 + 4); }
#pragma unroll
        for (int ai = 0; ai < 2; ++ai)
#pragma unroll
            for (int m = 0; m < 4; ++m) { const int rl = ai * 128 + wr * 64 + m * 16 + fr;
                if (rl < u.rows) {
#pragma unroll
                    for (int bj = 0; bj < 2; ++bj) *(u32x4*)(Y + (size_t)(u.row0 + rl) * D + c0 + bj * 128) = pack8(acc[ai][bj][m][0] + bv[bj][0], acc[ai][bj][m][1] + bv[bj][1]); }
                __builtin_amdgcn_sched_barrier(0); }
    }
};
}

enum { IN_X = 0, IN_C, IN_POS, IN_WADA, IN_BADA, IN_N1G, IN_WIN, IN_WS, IN_BS, IN_LNG, IN_LNB, IN_WPA, IN_WPG, IN_WO, IN_N2G, IN_WR, IN_BR, IN_W1, IN_B1, IN_W2, IN_B2, IN_FG, IN_OUT };
struct Args { const float* in[22]; const int* positions; float* out; unsigned char* ws; int ph_lo, ph_hi; };
struct Frame {
    LAS unsigned char* lds; volatile LAS unsigned* MISC; gu32* ctl;
    int tid, lane, wave, vcu, G;
    unsigned char* ws_;
};
__device__ __forceinline__ unsigned char* ws_of(const Frame& F) { unsigned long long p = (unsigned long long)F.ws_; asm volatile("" : "+s"(p)); return (unsigned char*)(GAS unsigned char*)p; }
__device__ __forceinline__ Frame opaque_frame(const Frame& F0) { Frame F = F0; asm volatile("" : "+v"(F.tid)); F.lane = F.tid & 63; asm volatile("" : "+s"(F.wave), "+s"(F.vcu), "+s"(F.G)); return F; }
__device__ __forceinline__ const float* inp(const Frame& F, int i) {
    const volatile LAS unsigned* t = F.MISC + 16 + 2 * i; const unsigned lo = __builtin_amdgcn_readfirstlane(t[0]), hi = __builtin_amdgcn_readfirstlane(t[1]);
    return (const float*)(const GAS float*)(((unsigned long long)hi << 32) | lo); }

template <int MODE> __device__ __forceinline__ int dest_row(int n) {
    if (MODE == 1) {
        if (n < 2 * AW) { const int hb = n & ~63, d = n & 63, half = d >> 5, f = d & 31; return hb + 8 * (f >> 2) + 4 * half + (f & 3); }
        return n;
    } else if (MODE == 2) {
        const int ac = n >> 1, typ = n & 1, pn = ac >> 7, al = ac & 127, q8 = al >> 3, bj = (al >> 2) & 1, j = al & 3, wc = q8 >> 2, fq = q8 & 3;
        return 256 * pn + 128 * bj + 32 * wc + 8 * fq + 4 * typ + j;
    }
    return n;
}
template <int MODE> __device__ __forceinline__ void cvt_item(const float* W, int K, int N, bf16* WT, LAS float* scr, int item, int lane) {
    const int nblk = N / 64, kb = item / nblk, nb = item % nblk, k0 = kb * 64, n0 = nb * 64;
    const int lr = lane >> 4, lc = (lane & 15) * 4;
    f32x4 v[16];
#pragma unroll
    for (int i = 0; i < 16; ++i) v[i] = *(const f32x4*)(W + (size_t)(k0 + 4 * i + lr) * N + n0 + lc);
#pragma unroll
    for (int i = 0; i < 16; ++i) { LAS float* s = scr + (4 * i + lr) * 65 + lc; s[0] = v[i][0]; s[1] = v[i][1]; s[2] = v[i][2]; s[3] = v[i][3]; }
    LDS_WAIT(); asm volatile("" ::: "memory");
    const int kc = lane & 7;
#pragma unroll
    for (int jj = 0; jj < 8; ++jj) { const int n = (lane >> 3) + 8 * jj; const LAS float* s = scr + (8 * kc) * 65 + n;
        u32x4 o; o.x = pk2(s[0], s[65]); o.y = pk2(s[2 * 65], s[3 * 65]); o.z = pk2(s[4 * 65], s[5 * 65]); o.w = pk2(s[6 * 65], s[7 * 65]);
        *(u32x4*)(WT + (size_t)dest_row<MODE>(n0 + n) * K + k0 + 8 * kc) = o; }
    LDS_WAIT(); asm volatile("" ::: "memory");
}

template <int MODE> __device__ __forceinline__ void cvt_item8(const float* W, int K, int N, unsigned char* WT, LAS unsigned char* scr, int item, int lane) {
    const int nblk = N / 64, kb = item / nblk, nb = item % nblk, k0 = kb * 128, n0 = nb * 64;
    const int lr = lane >> 4, lc = (lane & 15) * 4;
#pragma unroll 1
    for (int hf = 0; hf < 2; ++hf) {
        f32x4 v[16];
#pragma unroll
        for (int i = 0; i < 16; ++i) v[i] = *(const f32x4*)(W + (size_t)(k0 + 64 * hf + 16 * lr + i) * N + n0 + lc) * F8_WSCALE;
#pragma unroll
        for (int c = 0; c < 4; ++c) { u32x4 w;
#pragma unroll
            for (int d = 0; d < 4; ++d) w[d] = pk4_fp8(v[4 * d][c], v[4 * d + 1][c], v[4 * d + 2][c], v[4 * d + 3][c]);
            *(LAS u32x4*)(scr + (lc + c) * 144 + 64 * hf + 16 * lr) = w; }
    }
    LDS_WAIT(); asm volatile("" ::: "memory");
    const int ch = lane & 7;
#pragma unroll
    for (int jj = 0; jj < 8; ++jj) { const int n = (lane >> 3) + 8 * jj;
        *(u32x4*)(WT + (size_t)dest_row<MODE>(n0 + n) * K + k0 + 16 * ch) = *(const LAS u32x4*)(scr + n * 144 + 16 * ch); }
    LDS_WAIT(); asm volatile("" ::: "memory");
}

__device__ __forceinline__ void modnorm_store(const f32x4 (&v)[4], const float* g, const float* sc, const float* sh, bf16* orow, int lane) {
    float s = 0.f;
#pragma unroll
    for (int j = 0; j < 4; ++j) s += (v[j][0] * v[j][0] + v[j][1] * v[j][1]) + (v[j][2] * v[j][2] + v[j][3] * v[j][3]);
    const float rstd = 1.0f / sqrtf(wave_sum(s) * (1.0f / D) + RMS_EPS);
#pragma unroll
    for (int j = 0; j < 4; ++j) { const int c = 4 * lane + 256 * j; const f32x4 gv = *(const f32x4*)(g + c), sv = *(const f32x4*)(sc + c), hv = *(const f32x4*)(sh + c);
        const f32x4 y = v[j] * rstd * gv * (sv + 1.0f) + hv; u32x2 w; w.x = pk2(y[0], y[1]); w.y = pk2(y[2], y[3]); *(u32x2*)(orow + c) = w; }
}

__device__ __forceinline__ void phase_pr0(const Frame& F0) {
    const Frame F = opaque_frame(F0);
    unsigned char* ws = ws_of(F);
    const float* in_c = inp(F, IN_C); const float* in_wada = inp(F, IN_WADA); const float* in_bada = inp(F, IN_BADA); const int* in_pos = (const int*)inp(F, IN_POS);
    const float* in_wr = inp(F, IN_WR); const float* in_ws = inp(F, IN_WS); const float* in_b1 = inp(F, IN_B1);
    {
        LAS float* sl = (LAS float*)F.lds;
        LAS float* red = (LAS float*)(F.lds + 32768);
        float* MOD = (float*)(ws + WS_MOD);
        for (int i = F.tid; i < BATCH * D; i += NTHR) { const int b = i >> 10, k = i & 1023; const float cv = in_c[i]; sl[k * 8 + b] = cv * sigmoidf_(cv); }
        __syncthreads();
        for (int it = blockIdx.x; it < DEPTH * 96; it += F.G) {
            const int l = it / 96, col = (it % 96) * 64 + F.lane;
            const float* W = in_wada + (size_t)l * D * 6144 + col;
            float a[8];
#pragma unroll
            for (int b = 0; b < 8; ++b) a[b] = 0.f;
            const int kb = F.wave * 128;
#pragma unroll 8
            for (int k = 0; k < 128; ++k) { const float w = W[(size_t)(kb + k) * 6144]; const f32x4 s0 = *(const LAS f32x4*)(sl + (kb + k) * 8), s1 = *(const LAS f32x4*)(sl + (kb + k) * 8 + 4);
                a[0] += s0[0] * w; a[1] += s0[1] * w; a[2] += s0[2] * w; a[3] += s0[3] * w; a[4] += s1[0] * w; a[5] += s1[1] * w; a[6] += s1[2] * w; a[7] += s1[3] * w; }
#pragma unroll
            for (int b = 0; b < 8; ++b) red[(F.wave * 8 + b) * 64 + F.lane] = a[b];
            __syncthreads();
            { const int b = F.wave; float s = 0.f;
#pragma unroll
              for (int w = 0; w < 8; ++w) s += red[(w * 8 + b) * 64 + F.lane];
              MOD[((size_t)l * BATCH + b) * 6144 + col] = s + in_bada[l * 6144 + col]; }
            __syncthreads();
        }
        __syncthreads();
    }
    const int gw = F.vcu * NWAVES + F.wave, NGW = F.G * NWAVES;
    const int gt = F.vcu * NTHR + F.tid, NGT = F.G * NTHR;
    {
        float* RC = (float*)(ws + WS_ROPEC); float* RS = (float*)(ws + WS_ROPES);
        for (int i = gt; i < NTOK * 32; i += NGT) { const int row = i >> 5, f = i & 31;
            const float invf = (float)exp(-(double)f * (9.210340371976184 / 32.0));
            const float ang = (float)in_pos[row] * invf;
            const double x = (double)ang; const double k = rint(x * 0.15915494309189535); const float r = (float)(x - k * 6.283185307179586);
            RC[i] = __cosf(r); RS[i] = __sinf(r); }
    }
    {
        bf16* WRH = (bf16*)(ws + WS_WRH); bf16* WRL = (bf16*)(ws + WS_WRL);
        for (int i = gt; i < DEPTH * NE * D; i += NGT) { const int l = i / (NE * D), e = (i / D) % NE, d = i % D; const float w = in_wr[((size_t)l * D + d) * NE + e];
            const unsigned h = pk2(w, 0.f) & 0xffffu; const float lo = w - bf2f((bf16)h); WRH[i] = (bf16)h; WRL[i] = (bf16)(pk2(lo, 0.f) & 0xffffu); }
        bf16* WSB = (bf16*)(ws + WS_WSB);
        for (int i = gt; i < DEPTH * 4 * 128 * 128; i += NGT) { const int t = (i >> 7) & 127, s = i & 127; WSB[i] = (s <= t) ? (bf16)(pk2(in_ws[i], 0.f) & 0xffffu) : (bf16)0; }
        float* B1P = (float*)(ws + WS_B1P);
        for (int i = gt; i < DEPTH * NE * 2048; i += NGT) { const int n = i & 2047; B1P[(i & ~2047) + dest_row<2>(n)] = in_b1[i]; }
    }
    {
        LAS float* scr = (LAS float*)(F.lds + F.wave * 16640);
        const float* in_win = inp(F, IN_WIN); const float* in_wpa = inp(F, IN_WPA); const float* in_wpg = inp(F, IN_WPG); const float* in_wo = inp(F, IN_WO); const float* in_w1 = inp(F, IN_W1); const float* in_w2 = inp(F, IN_W2);
        constexpr int I_IN = 16 * 84, I_PA = 4 * 16, I_PG = 8 * 16, I_O = 16 * 16, I_1 = 8 * 32, I_2 = 8 * 16;
        constexpr int N_IN = DEPTH * I_IN, N_PA = DEPTH * I_PA, N_PG = DEPTH * I_PG, N_O = DEPTH * I_O, N_1 = DEPTH * NE * I_1, N_2 = DEPTH * NE * I_2;
        constexpr int NITEMS = N_IN + N_PA + N_PG + N_O + N_1 + N_2;
        for (int it = gw; it < NITEMS; it += NGW) {
            int r = it;
            if (r < N_IN) { const int m = r / I_IN; cvt_item<1>(in_win + (size_t)m * D * INW, D, INW, (bf16*)(ws + WS_WTIN) + (size_t)m * INW * D, scr, r % I_IN, F.lane); continue; } r -= N_IN;
            if (r < N_PA) { const int m = r / I_PA; cvt_item<0>(in_wpa + (size_t)m * AO * D, AO, D, (bf16*)(ws + WS_WTPA) + (size_t)m * D * AO, scr, r % I_PA, F.lane); continue; } r -= N_PA;
            if (r < N_PG) { const int m = r / I_PG; cvt_item<0>(in_wpg + (size_t)m * GW * D, GW, D, (bf16*)(ws + WS_WTPG) + (size_t)m * D * GW, scr, r % I_PG, F.lane); continue; } r -= N_PG;
            if (r < N_O) { const int m = r / I_O; cvt_item<0>(in_wo + (size_t)m * D * D, D, D, (bf16*)(ws + WS_WTO) + (size_t)m * D * D, scr, r % I_O, F.lane); continue; } r -= N_O;
            if (r < N_1) { const int m = r / I_1; cvt_item8<2>(in_w1 + (size_t)m * D * 2048, D, 2048, (unsigned char*)(ws + WS_W1T) + (size_t)m * 2048 * D, (LAS unsigned char*)scr, r % I_1, F.lane); continue; } r -= N_1;
            { const int m = r / I_2; cvt_item8<0>(in_w2 + (size_t)m * DFF * D, DFF, D, (unsigned char*)(ws + WS_W2T) + (size_t)m * D * DFF, (LAS unsigned char*)scr, r % I_2, F.lane); }
        }
    }
}

__device__ __forceinline__ void phase_pr1(const Frame& F0) {
    const Frame F = opaque_frame(F0);
    const int gw = F.vcu * NWAVES + F.wave, NGW = F.G * NWAVES;
    unsigned char* ws = ws_of(F);
    const float* MOD = (const float*)(ws + WS_MOD); bf16* AIN = (bf16*)(ws + WS_AIN);
    const float* in_x = inp(F, IN_X); const float* in_n1g = inp(F, IN_N1G);
    for (int t = gw; t < NTOK; t += NGW) { const int b = t / SEQ; const float* mp = MOD + (size_t)b * 6144;
        f32x4 v[4];
#pragma unroll
        for (int j = 0; j < 4; ++j) v[j] = *(const f32x4*)(in_x + (size_t)t * D + 4 * F.lane + 256 * j);
        modnorm_store(v, in_n1g, mp + 1024, mp, AIN + (size_t)t * D, F.lane); }
}

__device__ __forceinline__ int crow(int r, int hi) { return (r & 3) + 8 * (r >> 2) + 4 * hi; }
constexpr int VSTR = 192;
__device__ __forceinline__ s16x4 tr_read(const LAS unsigned char* p) { typedef short v4i16_t __attribute__((ext_vector_type(4))); return __builtin_bit_cast(s16x4, __builtin_amdgcn_ds_read_tr16_b64_v4i16((LAS v4i16_t*)p)); }
__device__ __forceinline__ float half_swap_max(float m) { auto rr = __builtin_amdgcn_permlane32_swap(__float_as_uint(m), __float_as_uint(m), false, false); return fmaxf(__uint_as_float(rr[0]), __uint_as_float(rr[1])); }
__device__ __forceinline__ float half_swap_sum(float m) { auto rr = __builtin_amdgcn_permlane32_swap(__float_as_uint(m), __float_as_uint(m), false, false); return __uint_as_float(rr[0]) + __uint_as_float(rr[1]); }

__device__ __forceinline__ void attn_item(const bf16* Qb, const bf16* Kb, const bf16* Vb, bf16* OGg, float* LSEg, int b, int r, int j, int n, int g, int h, int I, LAS unsigned char* vt, int lane) {
    const int q = lane & 31, hh = lane >> 5;
    const int colbase = g * 256 + h * 64;
    const size_t rowq = (size_t)b * SEQ + (size_t)(n * 128 + 32 * I + q) * r + j;
    bf16x8 qf[4];
#pragma unroll
    for (int s = 0; s < 4; ++s) qf[s] = *(const bf16x8*)(Qb + rowq * AW + colbase + 16 * s + 8 * hh);
    f32x16 o0, o1;
#pragma unroll
    for (int i = 0; i < 16; ++i) { o0[i] = 0.f; o1[i] = 0.f; }
    float mrun = -1e30f, lrun = 0.f;
    const int Jlo = (n == 0 && I < 4) ? 4 : I, Jhi = I + 4;
    const int gi = (lane >> 4) & 1, q4 = (lane & 15) >> 2, p4 = lane & 3;
    const LAS unsigned char* trb = vt + (4 * hh + q4) * VSTR + (16 * gi + 4 * p4) * 2;
    bf16x8 kf[4]; u32x4 vr[4];
    auto load_tile = [&](int J, bf16x8 (&kk)[4], u32x4 (&vv)[4]) {
        const size_t rowk = (size_t)b * SEQ + (size_t)((n - 1) * 128 + 32 * J + q) * r + j;
#pragma unroll
        for (int s = 0; s < 4; ++s) kk[s] = *(const bf16x8*)(Kb + rowk * AW + colbase + 16 * s + 8 * hh);
#pragma unroll
        for (int i = 0; i < 4; ++i) { const int p = lane + 64 * i, vrow = p >> 3, ch = p & 7;
            const size_t rowv = (size_t)b * SEQ + (size_t)((n - 1) * 128 + 32 * J + vrow) * r + j;
            vv[i] = *(const u32x4*)(Vb + rowv * AW + colbase + 8 * ch); }
    };
    load_tile(Jlo, kf, vr);
    for (int J = Jlo; J <= Jhi; ++J) {
        bf16x8 kn[4]; u32x4 vn[4];
        const int Jn = (J < Jhi) ? J + 1 : J;
        load_tile(Jn, kn, vn);
        f32x16 st;
#pragma unroll
        for (int i = 0; i < 16; ++i) st[i] = 0.f;
#pragma unroll
        for (int s = 0; s < 4; ++s) st = __builtin_amdgcn_mfma_f32_32x32x16_bf16(kf[s], qf[s], st, 0, 0, 0);
#pragma unroll
        for (int i = 0; i < 4; ++i) { const int p = lane + 64 * i; *(LAS u32x4*)(vt + (p >> 3) * VSTR + (p & 7) * 16) = vr[i]; }
        if (J == I) {
#pragma unroll
            for (int i = 0; i < 16; ++i) if (crow(i, hh) < q) st[i] = -1e30f;
        }
        if (J == I + 4) {
#pragma unroll
            for (int i = 0; i < 16; ++i) if (crow(i, hh) > q) st[i] = -1e30f;
        }
        float mx = st[0];
#pragma unroll
        for (int i = 1; i < 16; ++i) mx = fmaxf(mx, st[i]);
        mx = half_swap_max(mx);
        const float mnew = fmaxf(mrun, mx), alpha = fast_exp2(mrun - mnew);
        float rs = 0.f;
#pragma unroll
        for (int i = 0; i < 16; ++i) { st[i] = fast_exp2(st[i] - mnew); rs += st[i]; }
        rs = half_swap_sum(rs);
        lrun = lrun * alpha + rs; mrun = mnew;
#pragma unroll
        for (int i = 0; i < 16; ++i) { o0[i] *= alpha; o1[i] *= alpha; }
        bf16x8 pf[2];
#pragma unroll
        for (int s = 0; s < 2; ++s) { u32x4 w; w.x = pk2(st[8 * s + 0], st[8 * s + 1]); w.y = pk2(st[8 * s + 2], st[8 * s + 3]); w.z = pk2(st[8 * s + 4], st[8 * s + 5]); w.w = pk2(st[8 * s + 6], st[8 * s + 7]); pf[s] = __builtin_bit_cast(bf16x8, w); }
        LDS_WAIT();
#pragma unroll
        for (int s = 0; s < 2; ++s) {
            const s16x4 a0 = tr_read(trb + (16 * s) * VSTR), a1 = tr_read(trb + (16 * s + 8) * VSTR);
            const s16x4 c0 = tr_read(trb + (16 * s) * VSTR + 64), c1 = tr_read(trb + (16 * s + 8) * VSTR + 64);
            const bf16x8 v0 = (bf16x8){a0[0], a0[1], a0[2], a0[3], a1[0], a1[1], a1[2], a1[3]}, v1 = (bf16x8){c0[0], c0[1], c0[2], c0[3], c1[0], c1[1], c1[2], c1[3]};
            o0 = __builtin_amdgcn_mfma_f32_32x32x16_bf16(v0, pf[s], o0, 0, 0, 0);
            o1 = __builtin_amdgcn_mfma_f32_32x32x16_bf16(v1, pf[s], o1, 0, 0, 0);
        }
        LDS_WAIT();
#pragma unroll
        for (int s = 0; s < 4; ++s) { kf[s] = kn[s]; vr[s] = vn[s]; }
    }
    const float inv = 1.0f / lrun;
    bf16* op = OGg + rowq * AO + h * 64 + 4 * hh;
#pragma unroll
    for (int rq = 0; rq < 4; ++rq) {
        u32x2 w0, w1;
        w0.x = pk2(o0[4 * rq] * inv, o0[4 * rq + 1] * inv); w0.y = pk2(o0[4 * rq + 2] * inv, o0[4 * rq + 3] * inv);
        w1.x = pk2(o1[4 * rq] * inv, o1[4 * rq + 1] * inv); w1.y = pk2(o1[4 * rq + 2] * inv, o1[4 * rq + 3] * inv);
        *(u32x2*)(op + 8 * rq) = w0; *(u32x2*)(op + 32 + 8 * rq) = w1; }
    if (hh == 0) LSEg[rowq * 4 + h] = (mrun + __log2f(lrun)) * LN2;
}

__device__ __forceinline__ void phase_attn(const Frame& F0) {
    const Frame F = opaque_frame(F0);
    unsigned char* ws = ws_of(F);
    const bf16* Qb = (const bf16*)(ws + WS_QB); const bf16* Kb = (const bf16*)(ws + WS_KB); const bf16* Vb = (const bf16*)(ws + WS_VB);
    bf16* OG = (bf16*)(ws + WS_OG); float* LSE = (float*)(ws + WS_LSE);
    LAS unsigned char* vt = F.lds + F.wave * (32 * VSTR);
    for (int blk = blockIdx.x; blk < 768; blk += F.G) {
        const int g = blk >> 8, rem = blk & 255, b = rem >> 5, jn = rem & 31;
        const int r = (g == 0) ? 1 : (g == 1 ? 4 : 16), j = jn % r, n = jn / r;
        const int h = F.wave >> 1;
#pragma unroll 1
        for (int ii = 0; ii < 2; ++ii) attn_item(Qb, Kb, Vb, OG + (size_t)g * NTOK * AO, LSE + (size_t)g * NTOK * 4, b, r, j, n, g, h, 2 * (F.wave & 1) + ii, vt, F.lane);
    }
}

constexpr int ISTR = 320;
__device__ __forceinline__ void phase_gmlp(const Frame& F0, int l) {
    const Frame F = opaque_frame(F0);
    unsigned char* ws = ws_of(F);
    const bf16* VG = (const bf16*)(ws + WS_VGB); const bf16* U = (const bf16*)(ws + WS_UB); bf16* GM = (bf16*)(ws + WS_GM);
    const bf16* WSB = (const bf16*)(ws + WS_WSB) + (size_t)l * 4 * 128 * 128;
    const float* lng = inp(F, IN_LNG) + l * GW; const float* lnb = inp(F, IN_LNB) + l * GW; const float* bs = inp(F, IN_BS) + l * 4 * 128;
    LAS unsigned char* img = F.lds; LAS f32x2* ST = (LAS f32x2*)(F.lds + 128 * ISTR);
    const int lane = F.lane, q = lane & 31, hh = lane >> 5, gi = (lane >> 4) & 1, q4 = (lane & 15) >> 2, p4 = lane & 3;
    for (int un = blockIdx.x; un < NTILE128; un += F.G) {
        const size_t R0 = (size_t)un * 128;
        __syncthreads();
        for (int i = 0; i < 16; ++i) { const int tk = F.wave * 16 + i; f32x4 a, b2; pg8::unpack8(*(const u32x4*)(VG + (R0 + tk) * GW + 8 * lane), a, b2);
            const float s = wave_sum((a[0] + a[1]) + (a[2] + a[3]) + (b2[0] + b2[1]) + (b2[2] + b2[3])); const float mean = s * (1.0f / GW);
            const f32x4 da = a - mean, db = b2 - mean; const float ss = wave_sum((da[0] * da[0] + da[1] * da[1]) + (da[2] * da[2] + da[3] * da[3]) + (db[0] * db[0] + db[1] * db[1]) + (db[2] * db[2] + db[3] * db[3]));
            if (lane == 0) ST[tk] = (f32x2){mean, 1.0f / sqrtf(ss * (1.0f / GW) + LN_EPS)}; }
        __syncthreads();
        for (int g = 0; g < 4; ++g) {
            { const int ch = lane & 15; f32x4 ga, gb, ba, bb;
              ga = *(const f32x4*)(lng + g * 128 + 8 * ch); gb = *(const f32x4*)(lng + g * 128 + 8 * ch + 4); ba = *(const f32x4*)(lnb + g * 128 + 8 * ch); bb = *(const f32x4*)(lnb + g * 128 + 8 * ch + 4);
#pragma unroll
              for (int i = 0; i < 4; ++i) { const int tk = F.wave * 16 + ((lane + 64 * i) >> 4); f32x4 a, b2; pg8::unpack8(*(const u32x4*)(VG + (R0 + tk) * GW + g * 128 + 8 * ch), a, b2);
                  const f32x2 st = ST[tk]; a = (a - st.x) * st.y * ga + ba; b2 = (b2 - st.x) * st.y * gb + bb;
                  *(LAS u32x4*)(img + tk * ISTR + ch * 16) = pg8::pack8(a, b2); } }
            __syncthreads();
            const int tt = F.wave >> 1;
            f32x16 acc[2];
#pragma unroll
            for (int i = 0; i < 16; ++i) { acc[0][i] = 0.f; acc[1][i] = 0.f; }
            const bf16* wrow = WSB + ((size_t)g * 128 + 32 * tt + q) * 128 + 8 * hh;
            for (int ks = 0; ks < 2 * (tt + 1); ++ks) {
                const bf16x8 bfrag = *(const bf16x8*)(wrow + 16 * ks);
#pragma unroll
                for (int cc = 0; cc < 2; ++cc) { const int ct = 2 * (F.wave & 1) + cc;
                    const LAS unsigned char* tb = img + (16 * ks + 8 * hh + q4) * ISTR + (32 * ct + 16 * gi + 4 * p4) * 2;
                    const s16x4 a0 = tr_read(tb), a1 = tr_read(tb + 4 * ISTR);
                    const bf16x8 af = (bf16x8){a0[0], a0[1], a0[2], a0[3], a1[0], a1[1], a1[2], a1[3]};
                    acc[cc] = __builtin_amdgcn_mfma_f32_32x32x16_bf16(af, bfrag, acc[cc], 0, 0, 0); }
            }
            { const int t = 32 * tt + q; const size_t row = R0 + t; const float bias = bs[g * 128 + t];
#pragma unroll
              for (int cc = 0; cc < 2; ++cc) { const int ct = 2 * (F.wave & 1) + cc;
#pragma unroll
                  for (int rq = 0; rq < 4; ++rq) { const int c0 = g * 128 + 32 * ct + 8 * rq + 4 * hh; const u32x2 uw = *(const u32x2*)(U + row * GW + c0);
                      u32x2 w; w.x = pk2((acc[cc][4 * rq] + bias) * bf_lo(uw.x), (acc[cc][4 * rq + 1] + bias) * bf_hi(uw.x)); w.y = pk2((acc[cc][4 * rq + 2] + bias) * bf_lo(uw.y), (acc[cc][4 * rq + 3] + bias) * bf_hi(uw.y));
                      *(u32x2*)(GM + row * GW + c0) = w; } } }
            __syncthreads();
        }
    }
}

__device__ __forceinline__ void phase_merge(const Frame& F0) {
    const Frame F = opaque_frame(F0);
    const int gw = F.vcu * NWAVES + F.wave, NGW = F.G * NWAVES;
    unsigned char* ws = ws_of(F);
    const bf16* OG = (const bf16*)(ws + WS_OG); const float* LSE = (const float*)(ws + WS_LSE); bf16* ATT = (bf16*)(ws + WS_ATT);
    const int lane = F.lane, h = lane >> 4;
    for (int t = gw; t < NTOK; t += NGW) {
        const float l0 = LSE[(size_t)t * 4 + h], l1 = LSE[((size_t)NTOK + t) * 4 + h], l2 = LSE[((size_t)2 * NTOK + t) * 4 + h];
        const float mx = fmaxf(l0, fmaxf(l1, l2)); float w0 = fast_exp2((l0 - mx) * LOG2E), w1 = fast_exp2((l1 - mx) * LOG2E), w2 = fast_exp2((l2 - mx) * LOG2E);
        const float inv = 1.0f / (w0 + w1 + w2); w0 *= inv; w1 *= inv; w2 *= inv;
        const u32x2 a = *(const u32x2*)(OG + (size_t)t * AO + 4 * lane), b = *(const u32x2*)(OG + ((size_t)NTOK + t) * AO + 4 * lane), c = *(const u32x2*)(OG + ((size_t)2 * NTOK + t) * AO + 4 * lane);
        u32x2 w; w.x = pk2(w0 * bf_lo(a.x) + w1 * bf_lo(b.x) + w2 * bf_lo(c.x), w0 * bf_hi(a.x) + w1 * bf_hi(b.x) + w2 * bf_hi(c.x));
        w.y = pk2(w0 * bf_lo(a.y) + w1 * bf_lo(b.y) + w2 * bf_lo(c.y), w0 * bf_hi(a.y) + w1 * bf_hi(b.y) + w2 * bf_hi(c.y));
        *(u32x2*)(ATT + (size_t)t * AO + 4 * lane) = w;
    }
}

__device__ __forceinline__ void phase_router(const Frame& F0, int l) {
    const Frame F = opaque_frame(F0);
    unsigned char* ws = ws_of(F);
    const float* H = (const float*)(ws + WS_HB1); unsigned char* FB = (unsigned char*)(ws + WS_AIN);
    const float* MOD = (const float*)(ws + WS_MOD) + (size_t)l * BATCH * 6144;
    const bf16* WRH = (const bf16*)(ws + WS_WRH) + (size_t)l * NE * D; const bf16* WRL = (const bf16*)(ws + WS_WRL) + (size_t)l * NE * D;
    int* TOPI = (int*)(ws + WS_TOPI); float* TOPG = (float*)(ws + WS_TOPG); int* WGH = (int*)(ws + WS_WGH);
    const float* n2g = inp(F, IN_N2G) + l * D; const float* br = inp(F, IN_BR) + l * NE;
    LAS float* LG = (LAS float*)(F.lds + F.wave * 2048);
    LAS int* EX = (LAS int*)(F.lds + 16384);
    LAS int* HIST = (LAS int*)(F.lds + 16384 + 2048);
    const int lane = F.lane, tl = lane & 15, kq = lane >> 4;
    for (int tile = blockIdx.x; tile < NTILE128; tile += F.G) {
        __syncthreads();
        if (F.tid < 32) HIST[F.tid] = 0;
        const int T = tile * 128 + F.wave * 16 + tl, b = (tile * 128) / SEQ;
        const float* hrow = H + (size_t)T * D + 8 * kq;
        const float* sc2 = MOD + (size_t)b * 6144 + 4 * 1024; const float* sh2 = MOD + (size_t)b * 6144 + 3 * 1024;
        float ss = 0.f;
#pragma unroll 8
        for (int ks = 0; ks < 32; ++ks) { const f32x4 a = *(const f32x4*)(hrow + 32 * ks), c = *(const f32x4*)(hrow + 32 * ks + 4);
            ss += (a[0] * a[0] + a[1] * a[1]) + (a[2] * a[2] + a[3] * a[3]) + (c[0] * c[0] + c[1] * c[1]) + (c[2] * c[2] + c[3] * c[3]); }
        ss += __shfl_xor(ss, 16); ss += __shfl_xor(ss, 32);
        const float rstd = 1.0f / sqrtf(ss * (1.0f / D) + RMS_EPS);
        f32x4 acc0 = {0.f, 0.f, 0.f, 0.f}, acc1 = {0.f, 0.f, 0.f, 0.f};
#pragma unroll 2
        for (int ks = 0; ks < 32; ++ks) { const int c0 = 32 * ks + 8 * kq;
            f32x4 a = *(const f32x4*)(hrow + 32 * ks), c = *(const f32x4*)(hrow + 32 * ks + 4);
            const f32x4 g0 = *(const f32x4*)(n2g + c0), g1 = *(const f32x4*)(n2g + c0 + 4), s0 = *(const f32x4*)(sc2 + c0), s1 = *(const f32x4*)(sc2 + c0 + 4), h0 = *(const f32x4*)(sh2 + c0), h1 = *(const f32x4*)(sh2 + c0 + 4);
            a = a * rstd * g0 * (s0 + 1.0f) + h0; c = c * rstd * g1 * (s1 + 1.0f) + h1;
            const u32x4 hi = pg8::pack8(a, c); f32x4 ah, ch; pg8::unpack8(hi, ah, ch); const u32x4 lo = pg8::pack8(a - ah, c - ch);
            { u32x2 w8; w8.x = pk4_fp8(a[0] * F8_XSCALE, a[1] * F8_XSCALE, a[2] * F8_XSCALE, a[3] * F8_XSCALE); w8.y = pk4_fp8(c[0] * F8_XSCALE, c[1] * F8_XSCALE, c[2] * F8_XSCALE, c[3] * F8_XSCALE); *(u32x2*)(FB + (size_t)T * D + c0) = w8; }
            const bf16x8 fh = __builtin_bit_cast(bf16x8, hi), fl = __builtin_bit_cast(bf16x8, lo);
            const bf16x8 wh0 = *(const bf16x8*)(WRH + (size_t)tl * D + c0), wh1 = *(const bf16x8*)(WRH + (size_t)(16 + tl) * D + c0);
            const bf16x8 wl0 = *(const bf16x8*)(WRL + (size_t)tl * D + c0), wl1 = *(const bf16x8*)(WRL + (size_t)(16 + tl) * D + c0);
            acc0 = __builtin_amdgcn_mfma_f32_16x16x32_bf16(fh, wh0, acc0, 0, 0, 0); acc0 = __builtin_amdgcn_mfma_f32_16x16x32_bf16(fl, wh0, acc0, 0, 0, 0); acc0 = __builtin_amdgcn_mfma_f32_16x16x32_bf16(fh, wl0, acc0, 0, 0, 0);
            acc1 = __builtin_amdgcn_mfma_f32_16x16x32_bf16(fh, wh1, acc1, 0, 0, 0); acc1 = __builtin_amdgcn_mfma_f32_16x16x32_bf16(fl, wh1, acc1, 0, 0, 0); acc1 = __builtin_amdgcn_mfma_f32_16x16x32_bf16(fh, wl1, acc1, 0, 0, 0); }
        { const float b0 = br[tl], b1 = br[16 + tl];
#pragma unroll
          for (int rg = 0; rg < 4; ++rg) { LG[(4 * kq + rg) * 32 + tl] = acc0[rg] + b0; LG[(4 * kq + rg) * 32 + 16 + tl] = acc1[rg] + b1; } }
        LDS_WAIT();
        if (lane < 16) {
            float v[32];
#pragma unroll
            for (int i = 0; i < 8; ++i) { const f32x4 x = *(const LAS f32x4*)(LG + lane * 32 + 4 * i); v[4 * i] = x[0]; v[4 * i + 1] = x[1]; v[4 * i + 2] = x[2]; v[4 * i + 3] = x[3]; }
            int ti[4]; float tv[4];
#pragma unroll
            for (int k = 0; k < 4; ++k) { float best = -3.0e38f; int bi = 0;
#pragma unroll
                for (int e = 0; e < 32; ++e) { const bool taken = (k > 0 && ti[0] == e) || (k > 1 && ti[1] == e) || (k > 2 && ti[2] == e); if (!taken && v[e] > best) { best = v[e]; bi = e; } }
                ti[k] = bi; tv[k] = best; }
            const float e1 = fast_exp2((tv[1] - tv[0]) * LOG2E), e2 = fast_exp2((tv[2] - tv[0]) * LOG2E), e3 = fast_exp2((tv[3] - tv[0]) * LOG2E); const float inv = 1.0f / (1.0f + e1 + e2 + e3);
            const int Tt = tile * 128 + F.wave * 16 + lane;
            *(i32x4*)(TOPI + (size_t)Tt * 4) = (i32x4){ti[0], ti[1], ti[2], ti[3]}; *(f32x4*)(TOPG + (size_t)Tt * 4) = (f32x4){inv, e1 * inv, e2 * inv, e3 * inv};
            *(LAS i32x4*)(EX + (F.wave * 16 + lane) * 4) = (i32x4){ti[0], ti[1], ti[2], ti[3]};
        }
        __syncthreads();
        __hip_atomic_fetch_add(&HIST[EX[F.tid]], 1, __ATOMIC_RELAXED, __HIP_MEMORY_SCOPE_WORKGROUP);
        __syncthreads();
        if (F.tid < 32) WGH[tile * 32 + F.tid] = HIST[F.tid];
    }
}

__device__ __forceinline__ void phase_positions(const Frame& F0) {
    const Frame F = opaque_frame(F0);
    unsigned char* ws = ws_of(F);
    const int* WGH = (const int*)(ws + WS_WGH); const int* TOPI = (const int*)(ws + WS_TOPI);
    int* POS = (int*)(ws + WS_POS); int* SORT = (int*)(ws + WS_SORT); int* ETAB = (int*)(ws + WS_ETAB);
    LAS int* PT = (LAS int*)F.lds;
    LAS int* PB = PT + 512;
    LAS int* CNT = PB + 512;
    LAS int* BASE = CNT + 32;
    LAS int* WC = BASE + 32;
    const int lane = F.lane;
    for (int tile = blockIdx.x; tile < NTILE128; tile += F.G) {
        __syncthreads();
        { const int e = F.tid & 31, part = F.tid >> 5; int tot = 0, bef = 0;
#pragma unroll 1
          for (int t = part * 16; t < part * 16 + 16; ++t) { const int c = WGH[t * 32 + e]; tot += c; bef += (t < tile) ? c : 0; }
          PT[part * 32 + e] = tot; PB[part * 32 + e] = bef; }
        __syncthreads();
        if (F.tid < 32) { int tot = 0, bef = 0;
#pragma unroll
            for (int p = 0; p < 16; ++p) { tot += PT[p * 32 + F.tid]; bef += PB[p * 32 + F.tid]; }
            CNT[F.tid] = tot; BASE[F.tid] = bef; }
        __syncthreads();
        if (F.tid == 0) { int off = 0, ts = 0;
            for (int e = 0; e < 32; ++e) { const int c = CNT[e]; BASE[e] += off;
                if (tile == 0) { ETAB[e] = c; ETAB[32 + e] = off; ETAB[64 + e] = ts; }
                off += c; ts += (c + 255) >> 8; }
            if (tile == 0) ETAB[96] = ts; }
        if (tile == 0 && F.tid < 256) SORT[NASG + F.tid] = 0;
        const int tok = tile * 128 + (F.tid >> 2), k = F.tid & 3;
        const int e = TOPI[(size_t)tok * 4 + k];
        int rnk = 0, mycnt = 0;
#pragma unroll 1
        for (int E = 0; E < 32; ++E) { const unsigned long long m = __ballot(e == E); if (e == E) rnk = __popcll(m & ((1ull << lane) - 1ull)); if (lane == E) mycnt = __popcll(m); }
        if (lane < 32) WC[F.wave * 32 + lane] = mycnt;
        __syncthreads();
        int wo = 0;
        for (int w = 0; w < F.wave; ++w) wo += WC[w * 32 + e];
        const int pos = BASE[e] + wo + rnk;
        SORT[pos] = tok; POS[(size_t)tok * 4 + k] = pos;
    }
}

__device__ __forceinline__ void phase_loadtab(const Frame& F0) {
    const Frame F = opaque_frame(F0);
    unsigned char* ws = ws_of(F);
    LAS int* tab = (LAS int*)(F.lds + TAB_OFF);
    __syncthreads();
    if (F.tid < 97) tab[F.tid] = ((const int*)(ws + WS_ETAB))[F.tid];
    __syncthreads();
}

__device__ __forceinline__ void phase_combine(const Frame& F0, int l) {
    const Frame F = opaque_frame(F0);
    const int gw = F.vcu * NWAVES + F.wave, NGW = F.G * NWAVES;
    unsigned char* ws = ws_of(F);
    const float* in_n1g = inp(F, IN_N1G) + (l + 1 < DEPTH ? (l + 1) * D : 0); const float* in_fg = inp(F, IN_FG); float* outp = (float*)inp(F, IN_OUT);
    const float* H1 = (const float*)(ws + WS_HB1); float* H2 = (float*)(ws + WS_HB2); const bf16* Y = (const bf16*)(ws + WS_Y);
    const int* POS = (const int*)(ws + WS_POS); const float* TOPG = (const float*)(ws + WS_TOPG);
    const float* MOD = (const float*)(ws + WS_MOD); bf16* AIN = (bf16*)(ws + WS_AIN);
    const int lane = F.lane;
    for (int t = gw; t < NTOK; t += NGW) {
        const int b = t / SEQ; const float* g2 = MOD + ((size_t)l * BATCH + b) * 6144 + 5 * 1024;
        const i32x4 ps = *(const i32x4*)(POS + (size_t)t * 4); const f32x4 gt = *(const f32x4*)(TOPG + (size_t)t * 4);
        f32x4 v[4];
#pragma unroll
        for (int j = 0; j < 4; ++j) { const int c = 4 * lane + 256 * j;
            const u32x2 y0 = *(const u32x2*)(Y + (size_t)ps.x * D + c), y1 = *(const u32x2*)(Y + (size_t)ps.y * D + c), y2 = *(const u32x2*)(Y + (size_t)ps.z * D + c), y3 = *(const u32x2*)(Y + (size_t)ps.w * D + c);
            f32x4 s;
            s[0] = gt[0] * bf_lo(y0.x) + gt[1] * bf_lo(y1.x) + gt[2] * bf_lo(y2.x) + gt[3] * bf_lo(y3.x);
            s[1] = gt[0] * bf_hi(y0.x) + gt[1] * bf_hi(y1.x) + gt[2] * bf_hi(y2.x) + gt[3] * bf_hi(y3.x);
            s[2] = gt[0] * bf_lo(y0.y) + gt[1] * bf_lo(y1.y) + gt[2] * bf_lo(y2.y) + gt[3] * bf_lo(y3.y);
            s[3] = gt[0] * bf_hi(y0.y) + gt[1] * bf_hi(y1.y) + gt[2] * bf_hi(y2.y) + gt[3] * bf_hi(y3.y);
            v[j] = *(const f32x4*)(H1 + (size_t)t * D + c) + *(const f32x4*)(g2 + c) * s; }
        if (l + 1 < DEPTH) {
#pragma unroll
            for (int j = 0; j < 4; ++j) *(f32x4*)(H2 + (size_t)t * D + 4 * lane + 256 * j) = v[j];
            const float* mp = MOD + ((size_t)(l + 1) * BATCH + b) * 6144;
            modnorm_store(v, in_n1g, mp + 1024, mp, AIN + (size_t)t * D, lane);
        } else {
            float s = 0.f;
#pragma unroll
            for (int j = 0; j < 4; ++j) s += (v[j][0] * v[j][0] + v[j][1] * v[j][1]) + (v[j][2] * v[j][2] + v[j][3] * v[j][3]);
            const float rstd = 1.0f / sqrtf(wave_sum(s) * (1.0f / D) + RMS_EPS);
#pragma unroll
            for (int j = 0; j < 4; ++j) { const int c = 4 * lane + 256 * j; *(f32x4*)(outp + (size_t)t * D + c) = v[j] * rstd * *(const f32x4*)(in_fg + c); }
        }
    }
}

constexpr int PH_PR0 = 0, PH_PR1 = 1, PH_L0 = 2, PH_PER_LAYER = 10, PH_TOTAL = PH_L0 + DEPTH * PH_PER_LAYER;

__global__ void __launch_bounds__(NTHR, 2) mk_fwd(Args args) {
    extern __shared__ __attribute__((aligned(16))) unsigned char lds_raw[];
    Frame F;
    F.lds = (LAS unsigned char*)lds_raw;
    F.MISC = (volatile LAS unsigned*)(F.lds + MISC_OFF);
    F.tid = threadIdx.x; F.lane = F.tid & 63; F.wave = __builtin_amdgcn_readfirstlane(F.tid >> 6);
    F.G = gridDim.x; { const int bx = blockIdx.x; F.vcu = (F.G % 8 == 0) ? (bx % 8) * (F.G / 8) + bx / 8 : bx; }
    F.ws_ = args.ws; F.ctl = (gu32*)(args.ws + WS_CTL);
    for (int u = F.tid; u < (LDS_BYTES - MISC_OFF) / 4; u += NTHR) ((LAS unsigned*)(F.lds + MISC_OFF))[u] = 0u;
    __syncthreads();
    if (F.tid == 0) {
        LAS unsigned long long* pt = (LAS unsigned long long*)(F.lds + MISC_OFF + 64);
#define PT_(i) pt[i] = (unsigned long long)args.in[i]
        PT_(0); PT_(1); PT_(2); PT_(3); PT_(4); PT_(5); PT_(6); PT_(7); PT_(8); PT_(9); PT_(10); PT_(11); PT_(12); PT_(13); PT_(14); PT_(15); PT_(16); PT_(17); PT_(18); PT_(19); PT_(20); PT_(21);
#undef PT_
        pt[IN_POS] = (unsigned long long)args.positions; pt[IN_OUT] = (unsigned long long)args.out;
    }
    __syncthreads();
    XcdBarrier bar; bar.bar = (unsigned*)(F.ctl + CW_BAR); bar.x = 0; bar.st = nullptr;
#if !MK_PER_PHASE
    bar = xcd_barrier_post((unsigned*)(F.ctl + CW_BAR), F.MISC + 8);
#endif
    const int lo = args.ph_lo, hi = args.ph_hi;
#ifndef MK_EN
#define MK_EN 0x1FFF
#endif
#define EN(j) (((MK_EN) >> (j)) & 1)
#ifndef MK_REP
#define MK_REP 0
#endif
#define RP(j) _Pragma("unroll 1") for (int rr_ = 0; rr_ <= (((MK_REP) >> (j)) & 1) * MK_REPN; ++rr_)
#ifndef MK_REPN
#define MK_REPN 1
#endif
#define IN(k) (lo <= (k) && (k) < hi)
#if MK_PER_PHASE
#define SEAM(k) do { } while (0)
#else
#define SEAM(k) do { if (IN(k) && IN((k) + 1)) xcd_barrier(bar); } while (0)
#endif
    if (EN(0) && IN(PH_PR0)) RP(0) { phase_pr0(F); } SEAM(PH_PR0);
    if (EN(1) && IN(PH_PR1)) RP(1) { phase_pr1(F); } SEAM(PH_PR1);
    for (int l = 0; l < DEPTH; ++l) {
        const int P = PH_L0 + l * PH_PER_LAYER;
        if (EN(2) && IN(P + 0)) RP(2) { unsigned char* ws = ws_of(F);
            pg8::PlainSched S; S.T.init(NTOK / 256, INW / 256, F.G, (int)blockIdx.x); S.A = (const char*)(ws + WS_AIN); S.B = (const char*)(ws + WS_WTIN) + (size_t)l * INW * D * 2; S.K = D;
            pg8::EpiIn E{(bf16*)(ws + WS_QB), (bf16*)(ws + WS_KB), (bf16*)(ws + WS_VB), (bf16*)(ws + WS_UB), (bf16*)(ws + WS_VGB), (bf16*)(ws + WS_GB), (const float*)(ws + WS_ROPEC), (const float*)(ws + WS_ROPES)};
            pg8::gemm_phase<pg8::EpiIn, pg8::PlainSched, false>(F.lds, D, S, E, nullptr, nullptr);
        }
        SEAM(P + 0);
        if (EN(3) && IN(P + 1)) RP(3) { phase_attn(F); } if (EN(4) && IN(P + 1)) RP(4) { phase_gmlp(F, l); }
        SEAM(P + 1);
        if (EN(5) && IN(P + 2)) RP(5) { unsigned char* ws = ws_of(F);
            pg8::PlainSched S; S.T.init(NTOK / 256, D / 256, F.G, (int)blockIdx.x); S.A = (const char*)(ws + WS_GM); S.B = (const char*)(ws + WS_WTPG) + (size_t)l * D * GW * 2; S.K = GW;
            pg8::EpiMul1 E{(const bf16*)(ws + WS_GB), (bf16*)(ws + WS_TMP)};
            pg8::gemm_phase<pg8::EpiMul1, pg8::PlainSched, false>(F.lds, GW, S, E, nullptr, nullptr);
            phase_merge(F);
        }
        SEAM(P + 2);
        if (EN(6) && IN(P + 3)) RP(6) { unsigned char* ws = ws_of(F);
            pg8::PlainSched S; S.T.init(NTOK / 256, D / 256, F.G, (int)blockIdx.x); S.A = (const char*)(ws + WS_ATT); S.B = (const char*)(ws + WS_WTPA) + (size_t)l * D * AO * 2; S.K = AO;
            pg8::EpiMul2 E{(const bf16*)(ws + WS_GB), (const bf16*)(ws + WS_TMP), (bf16*)(ws + WS_MRG)};
            pg8::gemm_phase<pg8::EpiMul2, pg8::PlainSched, false>(F.lds, AO, S, E, nullptr, nullptr);
        }
        SEAM(P + 3);
        if (EN(7) && IN(P + 4)) RP(7) { unsigned char* ws = ws_of(F); const float* MODl = (const float*)(ws + WS_MOD) + (size_t)l * BATCH * 6144;
            pg8::PlainSched S; S.T.init(NTOK / 256, D / 256, F.G, (int)blockIdx.x); S.A = (const char*)(ws + WS_MRG); S.B = (const char*)(ws + WS_WTO) + (size_t)l * D * D * 2; S.K = D;
            pg8::EpiRes E{l == 0 ? inp(F, IN_X) : (const float*)(ws + WS_HB2), (float*)(ws + WS_HB1), MODl + 2 * 1024};
            pg8::gemm_phase<pg8::EpiRes, pg8::PlainSched, false>(F.lds, D, S, E, nullptr, nullptr);
        }
        SEAM(P + 4);
        if (EN(8) && IN(P + 5)) RP(8) { phase_router(F, l); }
        SEAM(P + 5);
        if (EN(9) && IN(P + 6)) RP(9) { phase_positions(F); }
        SEAM(P + 6);
        if (IN(P + 7) || IN(P + 8)) phase_loadtab(F);
        if (EN(10) && IN(P + 7)) RP(10) { unsigned char* ws = ws_of(F);
            LAS int* tab = (LAS int*)(F.lds + TAB_OFF);
            pg8::MoeSched S; S.T.init(tab[96], 2048 / 256, F.G, (int)blockIdx.x); S.A = (const char*)(ws + WS_AIN); S.B = (const char*)(ws + WS_W1T) + (size_t)l * NE * 2048 * D; S.K = D / 2; S.bstride = (size_t)2048 * D; S.tab = tab; S.gather = true;
            pg8::EpiSwiglu E{(const float*)(ws + WS_B1P) + (size_t)l * NE * 2048, (unsigned char*)(ws + WS_ACT)};
            pg8::gemm_phase<pg8::EpiSwiglu, pg8::MoeSched, true, true>(F.lds, D / 2, S, E, (const int*)(ws + WS_SORT), (LAS int*)(F.lds + IDX_OFF));
        }
        SEAM(P + 7);
        if (EN(11) && IN(P + 8)) RP(11) { unsigned char* ws = ws_of(F);
            LAS int* tab = (LAS int*)(F.lds + TAB_OFF);
            pg8::MoeSched S; S.T.init(tab[96], D / 256, F.G, (int)blockIdx.x); S.A = (const char*)(ws + WS_ACT); S.B = (const char*)(ws + WS_W2T) + (size_t)l * NE * D * DFF; S.K = DFF / 2; S.bstride = (size_t)D * DFF; S.tab = tab; S.gather = false;
            pg8::EpiY E{inp(F, IN_B2) + (size_t)l * NE * D, (bf16*)(ws + WS_Y)};
            pg8::gemm_phase<pg8::EpiY, pg8::MoeSched, false, true>(F.lds, DFF / 2, S, E, nullptr, nullptr);
        }
        SEAM(P + 8);
        if (EN(12) && IN(P + 9)) RP(12) { phase_combine(F, l); }
        if (l + 1 < DEPTH) SEAM(P + 9);
    }
#undef IN
#undef SEAM
}

extern "C" void kernel_launch(void* const* d_in, const int* in_sizes, int n_in, void* d_out, int out_size, void* d_ws, size_t ws_size, hipStream_t stream) {
    static int grid = 0;
    if (grid == 0) {
        if (n_in != 22 || in_sizes[0] != NTOK * D || out_size != NTOK * D || ws_size < WS_END) { fprintf(stderr, "kernel_launch: unexpected shapes (n_in %d, in0 %d, out %d, ws %zu)\n", n_in, n_in > 0 ? in_sizes[0] : -1, out_size, ws_size); grid = -1; return; }
        int dev = 0, cus = 0, per_cu = 0;
        if (hipGetDevice(&dev) != hipSuccess || hipDeviceGetAttribute(&cus, hipDeviceAttributeMultiprocessorCount, dev) != hipSuccess) { grid = -1; return; }
        if (hipFuncSetAttribute((const void*)mk_fwd, hipFuncAttributeMaxDynamicSharedMemorySize, LDS_BYTES) != hipSuccess) { fprintf(stderr, "kernel_launch: hipFuncSetAttribute failed\n"); grid = -1; return; }
        if (hipOccupancyMaxActiveBlocksPerMultiprocessor(&per_cu, (const void*)mk_fwd, NTHR, LDS_BYTES) != hipSuccess || per_cu < 1) fprintf(stderr, "kernel_launch: occupancy query reports %d\n", per_cu);
        (void)hipGetLastError();
        grid = cus;
    }
    if (grid < 0) return;
    if (hipMemsetAsync((char*)d_ws + WS_CTL, 0, CTL_ZERO_BYTES, stream) != hipSuccess) return;
    Args a{};
    for (int i = 0; i < 22; ++i) a.in[i] = (const float*)d_in[i];
    a.positions = (const int*)d_in[IN_POS]; a.out = (float*)d_out; a.ws = (unsigned char*)d_ws;
#if MK_PER_PHASE
    for (int p = 0; p < PH_TOTAL; ++p) { a.ph_lo = p; a.ph_hi = p + 1; hipLaunchKernelGGL(mk_fwd, dim3(grid), dim3(NTHR), LDS_BYTES, stream, a);
#ifdef MK_HREP
        { const int ty = p < 2 ? p : 2 + (p - 2) % PH_PER_LAYER; if (ty == MK_HREP) hipLaunchKernelGGL(mk_fwd, dim3(grid), dim3(NTHR), LDS_BYTES, stream, a); }
#endif
    }
#else
    a.ph_lo = 0; a.ph_hi = PH_TOTAL; hipLaunchKernelGGL(mk_fwd, dim3(grid), dim3(NTHR), LDS_BYTES, stream, a);
#endif
}
```

```cpp
#include <hip/hip_runtime.h>
#include <cstdio>
#include <cstdint>

#ifndef MK_PER_PHASE
#define MK_PER_PHASE 0
#endif
#ifndef MK_RELAX
#define MK_TAILIPW 3
#define MK_TAILIPW_P9 2
#define MK_TAILCVT 1
#define MK_RELAX 1
#endif
#ifndef MK_F8SCALED
#define MK_F8SCALED 1
#endif
#ifndef MK_CHECKS
#define MK_CHECKS 0
#endif

constexpr int D = 1024, BATCH = 8, SEQ = 4096, NTOK = BATCH * SEQ, DEPTH = 2;
constexpr int AW = 768, AO = 256, GW = 512, INW = 5376, NE = 32, TOPK = 4, NASG = NTOK * TOPK, DFF = 1024;
constexpr float RMS_EPS = 1e-5f, LN_EPS = 1e-5f;
constexpr int NWAVES = 8, NTHR = 512;
constexpr int NTILE128 = NTOK / 128;
constexpr float LOG2E = 1.4426950408889634f, LN2 = 0.6931471805599453f;
constexpr float QSCALE = 0.125f * LOG2E;
constexpr float F8_WSCALE = 64.0f, F8_XSCALE = 4.0f, F8_YSCALE = 8.0f;
constexpr int F8_WS_E8M0 = 0x79797979, F8_XS_E8M0 = 0x7d7d7d7d;

constexpr size_t MiB = 1u << 20;
constexpr size_t WS_CTL = 0, CTL_ZERO_BYTES = 1 * MiB;
constexpr size_t WS_MOD = 1 * MiB;
constexpr size_t WS_ROPEC = 2 * MiB;
constexpr size_t WS_ROPES = 6 * MiB;
constexpr size_t WS_WRH = 10 * MiB;
constexpr size_t WS_WRL = 10 * MiB + 512 * 1024;
constexpr size_t WS_WSB = 11 * MiB;
constexpr size_t WS_B1P = 12 * MiB;
constexpr size_t WS_WTIN = 13 * MiB;
constexpr size_t WS_WTPA = 34 * MiB;
constexpr size_t WS_WTPG = 35 * MiB;
constexpr size_t WS_WTO = 37 * MiB;
constexpr size_t WS_W1T = 41 * MiB;
constexpr size_t WS_W2T = 297 * MiB;
constexpr size_t WS_HB1 = 425 * MiB;
constexpr size_t WS_HB2 = 553 * MiB;
constexpr size_t WS_AIN = 681 * MiB;
constexpr size_t WS_QB = 745 * MiB, WS_KB = 793 * MiB, WS_VB = 841 * MiB;
constexpr size_t WS_UB = 889 * MiB, WS_VGB = 921 * MiB;
constexpr size_t WS_GB = 953 * MiB;
constexpr size_t WS_OG = 1081 * MiB;
constexpr size_t WS_LSE = 1129 * MiB;
constexpr size_t WS_ATT = 1131 * MiB;
constexpr size_t WS_GM = 1147 * MiB;
constexpr size_t WS_TMP = 1179 * MiB;
constexpr size_t WS_MRG = 1243 * MiB;
constexpr size_t WS_TOPI = 1307 * MiB;
constexpr size_t WS_TOPG = 1307 * MiB + 512 * 1024;
constexpr size_t WS_POS = 1308 * MiB;
constexpr size_t WS_WGH = 1308 * MiB + 512 * 1024;
constexpr size_t WS_ETAB = 1308 * MiB + 640 * 1024;
constexpr size_t WS_SORT = 1309 * MiB;
constexpr size_t WS_ACT = 1310 * MiB;
constexpr size_t WS_Y = 1567 * MiB;
constexpr size_t WS_END = 1824 * MiB;
static_assert(WS_ACT + (size_t)(NASG + 256) * 1024 * 2 <= WS_Y && WS_Y + (size_t)(NASG + 256) * 1024 * 2 <= WS_END, "ws map");

constexpr int CW_TMO = 0, CW_CODE = 1, CW_BAR = 4096, CW_ERR = 16384;

constexpr int RING_BYTES = 131072;
constexpr int BIAS_OFF = 131072;
constexpr int IDX_OFF = 139264;
constexpr int TAB_OFF = 141312;
constexpr int MISC_OFF = 141824;
constexpr int LDS_BYTES = 147456;

#define GAS __attribute__((address_space(1)))
#define LAS __attribute__((address_space(3)))
typedef unsigned short bf16;
typedef float f32x2 __attribute__((ext_vector_type(2)));
typedef float f32x4 __attribute__((ext_vector_type(4)));
typedef float f32x16 __attribute__((ext_vector_type(16)));
typedef short bf16x8 __attribute__((ext_vector_type(8)));
typedef short s16x4 __attribute__((ext_vector_type(4)));
typedef unsigned u32x2 __attribute__((ext_vector_type(2)));
typedef unsigned u32x4 __attribute__((ext_vector_type(4)));
typedef int i32x4 __attribute__((ext_vector_type(4)));
typedef __bf16 bf16x2_t __attribute__((ext_vector_type(2)));
typedef GAS unsigned gu32;
#define RLX_AGENT __ATOMIC_RELAXED, __HIP_MEMORY_SCOPE_AGENT
#define LDS_WAIT() asm volatile("s_waitcnt lgkmcnt(0)" ::: "memory")
#define VM_WAIT() asm volatile("s_waitcnt vmcnt(0)" ::: "memory")

__device__ __forceinline__ unsigned pk2(float lo, float hi) { f32x2 v = {lo, hi}; bf16x2_t b = __builtin_convertvector(v, bf16x2_t); return __builtin_bit_cast(unsigned, b); }
__device__ __forceinline__ float clamp448(float x) { return fminf(fmaxf(x, -448.0f), 448.0f); }
__device__ __forceinline__ unsigned pk4_fp8(float a, float b, float c, float d) {
    unsigned t = 0; t = __builtin_amdgcn_cvt_pk_fp8_f32(clamp448(a), clamp448(b), t, false); t = __builtin_amdgcn_cvt_pk_fp8_f32(clamp448(c), clamp448(d), t, true); return t; }
__device__ __forceinline__ unsigned pk4_fp8_nc(float a, float b, float c, float d) {
    unsigned t = 0; t = __builtin_amdgcn_cvt_pk_fp8_f32(a, b, t, false); t = __builtin_amdgcn_cvt_pk_fp8_f32(c, d, t, true); return t; }
__device__ __forceinline__ void unpk4_fp8(unsigned w, float& a, float& b, float& c, float& d) { const f32x2 lo = __builtin_amdgcn_cvt_pk_f32_fp8((int)w, false), hi = __builtin_amdgcn_cvt_pk_f32_fp8((int)w, true); a = lo[0]; b = lo[1]; c = hi[0]; d = hi[1]; }
__device__ __forceinline__ void unpk8_fp8(u32x2 w, f32x4& a, f32x4& b) { const f32x2 p0 = __builtin_amdgcn_cvt_pk_f32_fp8((int)w.x, false), p1 = __builtin_amdgcn_cvt_pk_f32_fp8((int)w.x, true), p2 = __builtin_amdgcn_cvt_pk_f32_fp8((int)w.y, false), p3 = __builtin_amdgcn_cvt_pk_f32_fp8((int)w.y, true);
    a = (f32x4){p0[0], p0[1], p1[0], p1[1]}; b = (f32x4){p2[0], p2[1], p3[0], p3[1]}; }
__device__ __forceinline__ float bf_lo(unsigned w) { return __uint_as_float(w << 16); }
__device__ __forceinline__ float bf_hi(unsigned w) { return __uint_as_float(w & 0xffff0000u); }
__device__ __forceinline__ float bf2f(bf16 b) { return __uint_as_float(((unsigned)b) << 16); }
__device__ __forceinline__ float wave_sum(float v) {
#pragma unroll
    for (int o = 1; o < 64; o <<= 1) v += __shfl_xor(v, o);
    return v;
}
__device__ __forceinline__ float fast_exp2(float x) { return __builtin_amdgcn_exp2f(x); }
__device__ __forceinline__ float fast_rcp(float x) { return __builtin_amdgcn_rcpf(x); }
__device__ __forceinline__ float sigmoidf_(float x) { return fast_rcp(1.0f + fast_exp2(-LOG2E * x)); }
__device__ __forceinline__ float gelu_tanh(float x) {
    const float u = x + 0.044715f * x * x * x;
    return x * fast_rcp(1.0f + fast_exp2(-2.0f * 0.7978845608028654f * LOG2E * u));
}

__device__ __forceinline__ void glds16(unsigned long long sbase, unsigned voff, unsigned ldsaddr) {
    unsigned keep; asm volatile("s_mov_b32 %0, m0\n\ts_mov_b32 m0, %3\n\ts_nop 0\n\tglobal_load_lds_dwordx4 %1, %2\n\ts_mov_b32 m0, %0" : "=&s"(keep) : "v"(voff), "s"(sbase), "s"(ldsaddr) : "memory");
}

#define XB_TMO      128
#define XB_XCNT(j)  (256  + 64 * (j))
#define XB_XSUB(j)  (1280 + 64 * (j))
#define XB_XGEN(j)  (2304 + 64 * (j))
#define XB_TOP      3328
#define XB_TOPGEN   3392
#define XCD_BAR_WORDS 3456
#define XB_SPIN_CAP (1u << 18)
__device__ __forceinline__ unsigned xb_ld(unsigned* p)              { return __hip_atomic_load(p, __ATOMIC_RELAXED, __HIP_MEMORY_SCOPE_AGENT); }
__device__ __forceinline__ unsigned xb_add(unsigned* p, unsigned v) { return __hip_atomic_fetch_add(p, v, __ATOMIC_RELAXED, __HIP_MEMORY_SCOPE_AGENT); }
__device__ __forceinline__ unsigned xb_xcc_id() { return (unsigned)__builtin_amdgcn_s_getreg((3 << 11) | 20) & 0xFu; }
#define XB_SPIN(cond, bar) do { unsigned _sp = 0; while (cond) { __builtin_amdgcn_s_sleep(1); \
    if ((++_sp & 255u) == 0u) { if (xb_ld(&(bar)[XB_TMO])) break; if (_sp > XB_SPIN_CAP) { atomicAdd(&(bar)[XB_TMO], 1u); break; } } } } while (0)
struct XcdBarrier { unsigned* bar; unsigned x; volatile LAS unsigned* st; };
__device__ __forceinline__ XcdBarrier xcd_barrier_post(unsigned* bar, volatile LAS unsigned* st) {
    XcdBarrier b; b.bar = bar; b.x = xb_xcc_id(); b.st = st;
    if (threadIdx.x == 0) (void)xb_add(&bar[XB_XCNT(b.x)], 1u);
    return b;
}
__device__ __forceinline__ void xcd_barrier_complete(unsigned* bar, unsigned x, unsigned& nloc, unsigned& nx) {
    const unsigned G = gridDim.x * gridDim.y * gridDim.z;
    unsigned sum, cnt, mine, sp = 0u;
    for (;;) {
        sum = 0u; cnt = 0u; mine = 0u;
#pragma unroll
        for (unsigned j = 0; j < 16; ++j) { const unsigned c = xb_ld(&bar[XB_XCNT(j)]); sum += c; cnt += (c > 0u) ? 1u : 0u; mine = (j == x) ? c : mine; }
        if (sum == G) break;
        __builtin_amdgcn_s_sleep(1);
        if ((++sp & 255u) == 0u) { if (xb_ld(&bar[XB_TMO])) break; if (sp > XB_SPIN_CAP) { atomicAdd(&bar[XB_TMO], 1u); break; } }
    }
    nloc = mine > 0u ? mine : 1u; nx = cnt > 0u ? cnt : 1u;
}
__device__ __forceinline__ void xcd_barrier(const XcdBarrier& b) {
    asm volatile("s_waitcnt vmcnt(0)" ::: "memory");
    __syncthreads();
    if (threadIdx.x == 0) {
        unsigned* bar = b.bar;
        __builtin_amdgcn_s_waitcnt(0);
        unsigned nloc = b.st[0], nx = b.st[1];
        if (nloc == 0u) { xcd_barrier_complete(bar, b.x, nloc, nx); b.st[0] = nloc; b.st[1] = nx; }
        const unsigned old = xb_add(&bar[XB_XSUB(b.x)], 1u);
        const unsigned gen = old / nloc;
        if (old + 1u == (gen + 1u) * nloc) {
            __builtin_amdgcn_fence(__ATOMIC_RELEASE, "agent");
            asm volatile("s_waitcnt vmcnt(0)" ::: "memory");
            const unsigned og = xb_add(&bar[XB_TOP], 1u);
            const unsigned tg = og / nx;
            if (og + 1u == (tg + 1u) * nx) xb_add(&bar[XB_TOPGEN], 1u);
            else XB_SPIN(xb_ld(&bar[XB_TOPGEN]) == tg, bar);
            __builtin_amdgcn_fence(__ATOMIC_ACQUIRE, "agent");
            xb_add(&bar[XB_XGEN(b.x)], 1u);
            asm volatile("s_waitcnt vmcnt(0)" ::: "memory");
        } else {
            XB_SPIN(xb_ld(&bar[XB_XGEN(b.x)]) == gen, bar);
            __builtin_amdgcn_fence(__ATOMIC_ACQUIRE, "agent");
            asm volatile("s_waitcnt vmcnt(0)" ::: "memory");
        }
    }
    __syncthreads();
}

namespace pg8 {
constexpr int BM = 256, BK = 64, HALF = 128, HTB = HALF * BK * 2, STAGE_BYTES = 8 * HTB, NXCD = 8, WGM = 8;
__host__ __device__ __forceinline__ int lds_byte(int r, int c) { const int st = (r >> 4) * 2 + (c >> 5), rr = r & 15, cc = c & 31, ob = rr * 64 + cc * 2; return st * 1024 + (ob ^ (((ob >> 9) & 1) << 5)); }
__host__ __device__ __forceinline__ void stage_rc(int b, int& R, int& C) { const int st = b / 1024, sb = b % 1024, swz = sb ^ (((sb >> 9) & 1) << 5); R = (st >> 1) * 16 + swz / 64; C = (st & 1) * 32 + (swz % 64) / 2; }
__host__ __device__ __forceinline__ int perm32(int rho) { const int n = rho >> 4, i = rho & 15; return 8 * (i >> 2) + 4 * n + (i & 3); }

struct Unit { int pm, pn; const char* A; const char* B; int e, rows, row0; };

struct TileOrder {
    int nM, nN, nwg, G, c;
    __device__ __forceinline__ void init(int nM_, int nN_, int G_, int c_) { nM = nM_; nN = nN_; nwg = nM * nN; G = G_; c = c_; }
    __device__ __forceinline__ bool tile(int i, int& pm, int& pn) const {
        const long L = (long)i * G + c; if (L >= nwg) return false;
        int wgid = (int)L; { const int q = nwg / NXCD, r = nwg % NXCD, xcd = wgid % NXCD, off = wgid / NXCD; wgid = (xcd < r ? xcd * (q + 1) : r * (q + 1) + (xcd - r) * q) + off; }
        const int nig = WGM * nN, gid = wgid / nig, fm = gid * WGM, gsz = (nM - fm) < WGM ? (nM - fm) : WGM;
        pm = fm + ((wgid % nig) % gsz); pn = (wgid % nig) / gsz; return true;
    }
};
struct PlainSched {
    TileOrder T; const char* A; const char* B; int K;
    __device__ __forceinline__ bool next(int i, Unit& u) const {
        if (!T.tile(i, u.pm, u.pn)) return false;
        u.A = A + (size_t)u.pm * 256 * K * 2; u.B = B + (size_t)u.pn * 256 * K * 2; u.e = 0; u.rows = 256; u.row0 = u.pm * 256; return true;
    }
};
struct MoeSched {
    TileOrder T; const char* A; const char* B; int K; size_t bstride  ; const LAS int* tab; bool gather;
    __device__ __forceinline__ bool next(int i, Unit& u) const {
        int pmg;
        if (!T.tile(i, pmg, u.pn)) return false;
        const int lane = threadIdx.x & 63;
        const int ts = tab[64 + ((lane < 32) ? lane + 1 : 32)];
        const unsigned long long m = __ballot((lane < 32) && (ts <= pmg));
        const int e = __builtin_amdgcn_readfirstlane(__popcll(m));
        const int t = pmg - __builtin_amdgcn_readfirstlane(tab[64 + e]);
        const int cnt = __builtin_amdgcn_readfirstlane(tab[e]), off = __builtin_amdgcn_readfirstlane(tab[32 + e]);
        u.pm = pmg; u.e = e; u.row0 = off + 256 * t; u.rows = (cnt - 256 * t) < 256 ? (cnt - 256 * t) : 256;
        u.A = gather ? A : A + (size_t)u.row0 * K * 2;
        u.B = B + (size_t)e * bstride + (size_t)u.pn * 256 * K * 2;
        return true;
    }
};

typedef f32x4 Acc[2][2][4][2];

template <class Epi, class Sched, bool GATHER, bool F8 = false, int MIDK = 0>
__device__ __forceinline__ void gemm_phase(LAS unsigned char* lds, const int K, const Sched& S, const Epi& E, const int* gidx, LAS int* idxl, const int variant = 0) {
    int tid_ = threadIdx.x; asm volatile("" : "+v"(tid_));
    const int tid = tid_, wid = __builtin_amdgcn_readfirstlane(tid >> 6), lane = tid & 63, wr = wid >> 2, wc = wid & 3, fr = lane & 15, fq = lane >> 4;
    const int nt = K / BK;
    LAS unsigned char* const lds_top = lds;
    unsigned voffA[2], voffB[2];
#pragma unroll
    for (int i = 0; i < 2; ++i) { int R, C; stage_rc(tid * 16 + i * 8192, R, C); const int Rb = Epi::PERM ? ((R & ~31) + perm32(R & 31)) : R;
        voffA[i] = (unsigned)(R * K + C) * 2u; voffB[i] = (unsigned)(Rb * K + C) * 2u; }
    const size_t kstep = (size_t)(BK * 2);
    const size_t hstep = (size_t)HALF * K * 2;
    const unsigned ldsw = (unsigned)wid * 1024u;
    const int aoff = lds_byte(wr * 64 + fr, fq * 8), boff = lds_byte(wc * 32 + fr, fq * 8);
    unsigned vc00 = 0, vc01 = 0, vc10 = 0, vc11 = 0;
#define PG8_GOFF(ip, pre) do { int R0_, C0_, R1_, C1_; stage_rc(tid * 16, R0_, C0_); stage_rc(tid * 16 + 8192, R1_, C1_); \
        const int i00 = (ip)[R0_], i01 = (ip)[R1_], i10 = (ip)[128 + R0_], i11 = (ip)[128 + R1_]; \
        pre##00 = (unsigned)(i00 * K + C0_) * 2u; pre##01 = (unsigned)(i01 * K + C1_) * 2u; pre##10 = (unsigned)(i10 * K + C0_) * 2u; pre##11 = (unsigned)(i11 * K + C1_) * 2u; } while (0)
#define PG8_SA(b, h) (((b) * 2 + (h)) * HTB)
#define PG8_SB(b, h) ((4 + (b) * 2 + (h)) * HTB)
#define PG8_GL(sbase, voff32, dst) do { if (variant & 4) break; unsigned keep_; asm volatile("s_mov_b32 %0, m0\n\ts_mov_b32 m0, %3\n\ts_nop 0\n\tglobal_load_lds_dwordx4 %1, %2\n\ts_mov_b32 m0, %0" \
        : "=&s"(keep_) : "v"(voff32), "s"(sbase), "s"((unsigned)(__UINTPTR_TYPE__)(dst)) : "memory"); } while (0)
#define PG8_STAGE(bufoff, gbase, voff) do { const unsigned long long _b = (unsigned long long)(gbase); PG8_GL(_b, (voff)[0], lds + (bufoff) + ldsw); PG8_GL(_b, (voff)[1], lds + (bufoff) + ldsw + 8192); } while (0)
#define PG8_STAGE2(bufoff, gbase, v0, v1) do { const unsigned long long _b = (unsigned long long)(gbase); PG8_GL(_b, v0, lds + (bufoff) + ldsw); PG8_GL(_b, v1, lds + (bufoff) + ldsw + 8192); } while (0)
#define PG8_STAGE_A(bufoff, p, h, nx) do { if constexpr (GATHER) { if (h == 0) { if (nx) PG8_STAGE2(bufoff, p, u00, u01); else PG8_STAGE2(bufoff, p, vc00, vc01); } else { if (nx) PG8_STAGE2(bufoff, p, u10, u11); else PG8_STAGE2(bufoff, p, vc10, vc11); } } \
        else PG8_STAGE(bufoff, (p) + (h) * hstep, voffA); } while (0)
#define PG8_LDA(dst, b, h) do { _Pragma("unroll") for (int m = 0; m < 4; ++m) _Pragma("unroll") for (int k = 0; k < 2; ++k) dst[m][k] = *(const LAS bf16x8*)(lds + PG8_SA(b, h) + aoff + m * 2048 + k * 1024); } while (0)
#define PG8_LDB(dst, b, h) do { _Pragma("unroll") for (int n = 0; n < 2; ++n) _Pragma("unroll") for (int k = 0; k < 2; ++k) dst[n][k] = *(const LAS bf16x8*)(lds + PG8_SB(b, h) + boff + n * 2048 + k * 1024); } while (0)
#define PG8_CAT(x0, x1) __builtin_shufflevector(__builtin_bit_cast(i32x4, x0), __builtin_bit_cast(i32x4, x1), 0, 1, 2, 3, 4, 5, 6, 7)
#define PG8_MMA(ai, bj, At, Bt) do { if (variant & 2) break; __builtin_amdgcn_s_setprio(1); \
        if constexpr (F8) { _Pragma("unroll") for (int m = 0; m < 4; ++m) _Pragma("unroll") for (int n = 0; n < 2; ++n) \
            { if (MK_F8SCALED) asm volatile("v_mfma_scale_f32_16x16x128_f8f6f4 %0, %1, %2, %0, %3, %4 op_sel_hi:[0,0,0]" : "+v"(acc[ai][bj][m][n]) : "v"(PG8_CAT(Bt[n][0], Bt[n][1])), "v"(PG8_CAT(At[m][0], At[m][1])), "v"(sc_w), "v"(sc_x)); \
              else asm volatile("v_mfma_f32_16x16x128_f8f6f4 %0, %1, %2, %0" : "+v"(acc[ai][bj][m][n]) : "v"(PG8_CAT(Bt[n][0], Bt[n][1])), "v"(PG8_CAT(At[m][0], At[m][1]))); } } \
        else { _Pragma("unroll") for (int m = 0; m < 4; ++m) _Pragma("unroll") for (int n = 0; n < 2; ++n) _Pragma("unroll") for (int k = 0; k < 2; ++k) \
            asm volatile("v_mfma_f32_16x16x32_bf16 %0, %1, %2, %0" : "+v"(acc[ai][bj][m][n]) : "v"(Bt[n][k]), "v"(At[m][k])); } \
        __builtin_amdgcn_s_setprio(0); } while (0)
#define PG8_WAIT_V(n) asm volatile("s_waitcnt vmcnt(" #n ")" ::: "memory")
#define PG8_WAIT_VR() do { if (fae) asm volatile("s_waitcnt vmcnt(%0)" :: "n"(8 + Epi::NST) : "memory"); else PG8_WAIT_V(8); } while (0)
#define PG8_WAIT_L(n) asm volatile("s_waitcnt lgkmcnt(" #n ")" ::: "memory")
#define PG8_BAR __builtin_amdgcn_s_barrier()
#define PG8_SCHED __builtin_amdgcn_sched_barrier(0)
    const int sc_w = F8_WS_E8M0, sc_x = F8_XS_E8M0;
    Unit cur, nxt; int ui = 0;
    if (!S.next(0, cur)) return;
#if MK_SKEW > 0
    { const unsigned long long t0 = __builtin_amdgcn_s_memrealtime(), dl = (unsigned long long)(((blockIdx.x >> 3) & 3) * MK_SKEW);
      while (__builtin_amdgcn_s_memrealtime() - t0 < dl) __builtin_amdgcn_s_sleep(8); }
#endif
    Acc acc;
#pragma unroll
    for (int a = 0; a < 2; ++a)
#pragma unroll
        for (int b = 0; b < 2; ++b)
#pragma unroll
            for (int m = 0; m < 4; ++m)
#pragma unroll
                for (int n = 0; n < 2; ++n) acc[a][b][m][n] = (f32x4){0.f, 0.f, 0.f, 0.f};
    bf16x8 At[4][2], B0[2][2], B1[2][2];
    const char* cA = cur.A; const char* cB = cur.B;
    if constexpr (GATHER) {
        const int* gp_ = gidx + cur.row0; PG8_GOFF(gp_, vc);
        asm volatile("s_waitcnt vmcnt(0)" ::: "memory");
    }
    unsigned u00 = 0, u01 = 0, u10 = 0, u11 = 0;
    PG8_STAGE(PG8_SB(0, 0), cB, voffB); PG8_STAGE(PG8_SB(0, 1), cB + hstep, voffB); PG8_STAGE_A(PG8_SA(0, 0), cA, 0, false); PG8_STAGE_A(PG8_SA(0, 1), cA, 1, false);
    if (wr == 1) PG8_BAR;
    PG8_WAIT_V(2); PG8_BAR;
    PG8_STAGE(PG8_SB(1, 0), cB + kstep, voffB); PG8_STAGE_A(PG8_SA(1, 0), cA + kstep, 0, false); PG8_STAGE(PG8_SB(1, 1), cB + hstep + kstep, voffB);
    PG8_WAIT_V(6); PG8_BAR;
    for (;;) {
        const bool has_next = S.next(ui + 1, nxt);
        if constexpr (Epi::HAS_VEC) { if (wid == 4) { const unsigned long long vb_ = (unsigned long long)E.vec_ptr(cur); PG8_GL(vb_, (unsigned)(lane * 16), lds_top + BIAS_OFF + (ui & 1) * 1024); } }
        const char* nA = has_next ? nxt.A : cA; const char* nB = has_next ? nxt.B : cB;
        if constexpr (GATHER) {
            if (has_next && wid < 4) __builtin_amdgcn_global_load_lds((const unsigned*)(gidx + nxt.row0 + wid * 64 + lane), (LAS unsigned*)(idxl + ((ui + 1) & 1) * 256 + wid * 64), 4, 0, 0);
        }
#pragma unroll 1
        for (int t = 0; t < nt; t += 2) {
            const bool last = (t == nt - 2);
            const char* a1 = cA + (size_t)(t + 1) * kstep;
            const char* a2 = last ? nA : cA + (size_t)(t + 2) * kstep; const char* b2 = last ? nB : cB + (size_t)(t + 2) * kstep;
            const char* a3 = a2 + kstep; const char* b3 = b2 + kstep;
            const bool fae = MK_RELAX && (t == 0) && (ui > 0);
            if constexpr (GATHER) {
                u00 = vc00; u01 = vc01; u10 = vc10; u11 = vc11;
                if (last && has_next) { const LAS int* ip = idxl + ((ui + 1) & 1) * 256; PG8_GOFF(ip, u); }
            }
            PG8_LDB(B0, 0, 0); PG8_LDB(B1, 0, 1); PG8_SCHED; PG8_LDA(At, 0, 0); if (!fae) PG8_STAGE_A(PG8_SA(1, 1), a1, 1, false);
            PG8_WAIT_VR(); PG8_WAIT_L(0); PG8_BAR; PG8_MMA(0, 0, At, B0); PG8_MMA(0, 1, At, B1); PG8_BAR; PG8_SCHED;
            PG8_LDA(At, 0, 1); PG8_STAGE(PG8_SB(0, 0), b2, voffB); PG8_STAGE(PG8_SB(0, 1), b2 + hstep, voffB); PG8_STAGE_A(PG8_SA(0, 0), a2, 0, true);
            PG8_WAIT_VR(); PG8_WAIT_L(0); PG8_BAR; PG8_MMA(1, 0, At, B0); PG8_MMA(1, 1, At, B1); PG8_BAR; PG8_SCHED;
            PG8_LDB(B0, 1, 0); PG8_LDB(B1, 1, 1); PG8_SCHED; PG8_LDA(At, 1, 0); PG8_STAGE_A(PG8_SA(0, 1), a2, 1, true);
            PG8_WAIT_VR(); PG8_WAIT_L(0); PG8_BAR; PG8_MMA(0, 0, At, B0); PG8_MMA(0, 1, At, B1); PG8_BAR; PG8_SCHED;
            PG8_LDA(At, 1, 1); PG8_STAGE(PG8_SB(1, 0), b3, voffB); PG8_STAGE(PG8_SB(1, 1), b3 + hstep, voffB); PG8_STAGE_A(PG8_SA(1, 0), a3, 0, true);
            PG8_WAIT_V(8); PG8_WAIT_L(0); PG8_BAR; PG8_MMA(1, 0, At, B0); PG8_MMA(1, 1, At, B1); PG8_BAR; PG8_SCHED;
            if constexpr (MIDK > 0) { if (t + 2 == MIDK) { asm volatile("s_nop 15\n\ts_nop 15" ::: "memory"); E.mid(acc, cur, wr, wc, fr, fq); } }
        }
        asm volatile("s_nop 15\n\ts_nop 15" ::: "memory");
        if (wr == 0) PG8_BAR;
        if constexpr (F8 && !MK_F8SCALED) {
#pragma unroll
            for (int a = 0; a < 2; ++a)
#pragma unroll
                for (int b = 0; b < 2; ++b)
#pragma unroll
                    for (int m = 0; m < 4; ++m)
#pragma unroll
                        for (int n = 0; n < 2; ++n) acc[a][b][m][n] *= 1.0f / (F8_WSCALE * F8_XSCALE); }
        if (MK_RELAX && has_next) {
            if constexpr (GATHER) PG8_STAGE2(PG8_SA(1, 1), nA + kstep, u10, u11); else PG8_STAGE(PG8_SA(1, 1), nA + kstep + hstep, voffA); }
        if (variant & 8) cur.rows = 0;
        if (variant & 16) cur.row0 = NASG;
        if (!(variant & 1)) E(acc, cur, wr, wc, fr, fq, (const LAS float*)(lds_top + BIAS_OFF + (ui & 1) * 1024));
        if (!has_next) break;
#pragma unroll
        for (int a = 0; a < 2; ++a)
#pragma unroll
            for (int b = 0; b < 2; ++b)
#pragma unroll
                for (int m = 0; m < 4; ++m)
#pragma unroll
                    for (int n = 0; n < 2; ++n) acc[a][b][m][n] = (f32x4){0.f, 0.f, 0.f, 0.f};
        cur = nxt; cA = nA; cB = nB; ++ui;
        if constexpr (GATHER) { vc00 = u00; vc01 = u01; vc10 = u10; vc11 = u11; }
        if (wr == 1) PG8_BAR;
    }
    PG8_WAIT_V(0);
    PG8_BAR;
#undef PG8_SA
#undef PG8_SB
#undef PG8_GL
#undef PG8_STAGE
#undef PG8_STAGE2
#undef PG8_STAGE_A
#undef PG8_GOFF
#undef PG8_LDA
#undef PG8_LDB
#undef PG8_MMA
#undef PG8_CAT
#undef PG8_WAIT_V
#undef PG8_WAIT_VR
#undef PG8_WAIT_L
#undef PG8_BAR
#undef PG8_SCHED
}

__device__ __forceinline__ u32x4 pack8(f32x4 a, f32x4 b) { u32x4 w; w.x = pk2(a[0], a[1]); w.y = pk2(a[2], a[3]); w.z = pk2(b[0], b[1]); w.w = pk2(b[2], b[3]); return w; }
#ifndef MK_P2F8
#define MK_P2F8 1
#endif
#ifndef MK_NT
#define MK_NT 0
#endif
#ifndef MK_SKEW
#define MK_SKEW 0
#endif
template <class T> __device__ __forceinline__ void st_epi(T* p, T v) { if (MK_NT) __builtin_nontemporal_store(v, p); else *p = v; }

struct EpiIn {
    static constexpr bool PERM = true; static constexpr int NST = 16; static constexpr bool HAS_VEC = false;
    bf16 *Q, *Kb, *V, *U, *VG, *G; const float* ropec; const float* ropes;
    __device__ __forceinline__ void operator()(const Acc& acc, const Unit& u, int wr, int wc, int fr, int fq, const LAS float* lb) const {
        const int pn = u.pn, row0 = u.pm * 256 + wr * 64 + fr, cl = wc * 32 + 8 * fq;
        if (pn < 6) {
            bf16* base = (pn < 3) ? Q : Kb; const int g = (pn < 3) ? pn : pn - 3; const float sc = (pn < 3) ? QSCALE : 1.0f;
            const int i4 = 4 * (4 * (wc & 1) + fq);
#pragma unroll
            for (int ai = 0; ai < 2; ++ai) {
                f32x4 cs[4], sn[4];
#pragma unroll
                for (int m = 0; m < 4; ++m) { const int row = row0 + ai * 128 + m * 16; cs[m] = *(const f32x4*)(ropec + (size_t)row * 32 + i4); sn[m] = *(const f32x4*)(ropes + (size_t)row * 32 + i4); }
#pragma unroll
                for (int m = 0; m < 4; ++m) { const int row = row0 + ai * 128 + m * 16;
#pragma unroll
                    for (int bj = 0; bj < 2; ++bj) { const f32x4 x1 = acc[ai][bj][m][0], x2 = acc[ai][bj][m][1];
                        const f32x4 o1 = (x1 * cs[m] - x2 * sn[m]) * sc, o2 = (x2 * cs[m] + x1 * sn[m]) * sc;
                        st_epi((u32x4*)(base + (size_t)row * AW + g * 256 + bj * 128 + cl), pack8(o1, o2)); } }
                __builtin_amdgcn_sched_barrier(0); }
        } else if (pn < 9) {
            const int cb = (pn - 6) * 256;
#pragma unroll
            for (int ai = 0; ai < 2; ++ai)
#pragma unroll
                for (int m = 0; m < 4; ++m) { const int row = row0 + ai * 128 + m * 16;
#pragma unroll
                    for (int bj = 0; bj < 2; ++bj) st_epi((u32x4*)(V + (size_t)row * AW + cb + bj * 128 + cl), pack8(acc[ai][bj][m][0], acc[ai][bj][m][1]));
                    __builtin_amdgcn_sched_barrier(0); }
        } else if (pn < 13) {
            bf16* base = (pn < 11) ? U : VG; const int cb = ((pn - 9) & 1) * 256;
#pragma unroll
            for (int ai = 0; ai < 2; ++ai)
#pragma unroll
                for (int m = 0; m < 4; ++m) { const int row = row0 + ai * 128 + m * 16;
#pragma unroll
                    for (int bj = 0; bj < 2; ++bj) { f32x4 a = acc[ai][bj][m][0], b = acc[ai][bj][m][1];
#pragma unroll
                        for (int j = 0; j < 4; ++j) { a[j] = gelu_tanh(a[j]); b[j] = gelu_tanh(b[j]); }
                        st_epi((u32x4*)(base + (size_t)row * GW + cb + bj * 128 + cl), pack8(a, b)); }
                    __builtin_amdgcn_sched_barrier(0); }
        } else {
            const int cb = (pn - 13) * 256;
#pragma unroll
            for (int ai = 0; ai < 2; ++ai)
#pragma unroll
                for (int m = 0; m < 4; ++m) { const int row = row0 + ai * 128 + m * 16;
#pragma unroll
                    for (int bj = 0; bj < 2; ++bj) { f32x4 a = acc[ai][bj][m][0], b = acc[ai][bj][m][1];
#pragma unroll
                        for (int j = 0; j < 4; ++j) { a[j] = sigmoidf_(a[j]) * 256.0f; b[j] = sigmoidf_(b[j]) * 256.0f; }
                        u32x2 w8; w8.x = pk4_fp8_nc(a[0], a[1], a[2], a[3]); w8.y = pk4_fp8_nc(b[0], b[1], b[2], b[3]);
                        st_epi((u32x2*)((unsigned char*)G + (size_t)row * 2048 + cb + bj * 128 + cl), w8); }
                    __builtin_amdgcn_sched_barrier(0); }
        }
    }
};
__device__ __forceinline__ void unpack8(u32x4 w, f32x4& a, f32x4& b) { a = (f32x4){bf_lo(w.x), bf_hi(w.x), bf_lo(w.y), bf_hi(w.y)}; b = (f32x4){bf_lo(w.z), bf_hi(w.z), bf_lo(w.w), bf_hi(w.w)}; }
struct EpiMrg {
    static constexpr bool PERM = true; static constexpr int NST = 16; static constexpr bool HAS_VEC = false;
    const bf16* G; bf16* O;
    __device__ __forceinline__ void mid(Acc& acc, const Unit& u, int wr, int wc, int fr, int fq) const {
        const unsigned char* G8 = (const unsigned char*)G;
        const int row0 = u.pm * 256 + wr * 64 + fr, c0 = u.pn * 256 + wc * 32 + 8 * fq;
#pragma unroll
        for (int ai = 0; ai < 2; ++ai) {
            u32x2 wa[4][2], wg[4][2];
#pragma unroll
            for (int m = 0; m < 4; ++m)
#pragma unroll
                for (int bj = 0; bj < 2; ++bj) { const size_t o = (size_t)(row0 + ai * 128 + m * 16) * 2048 + c0 + bj * 128; wa[m][bj] = *(const u32x2*)(G8 + o); wg[m][bj] = *(const u32x2*)(G8 + o + 1024); }
#pragma unroll
            for (int m = 0; m < 4; ++m)
#pragma unroll
                for (int bj = 0; bj < 2; ++bj) { f32x4 a0, a1, g0, g1; unpk8_fp8(wa[m][bj], a0, a1); unpk8_fp8(wg[m][bj], g0, g1);
#pragma unroll
                    for (int j = 0; j < 4; ++j) { acc[ai][bj][m][0][j] *= a0[j] * fast_rcp(fmaxf(g0[j], 1e-30f)); acc[ai][bj][m][1][j] *= a1[j] * fast_rcp(fmaxf(g1[j], 1e-30f)); } }
            asm volatile("" ::: "memory"); __builtin_amdgcn_sched_barrier(0); }
    }
    __device__ __forceinline__ void operator()(const Acc& acc, const Unit& u, int wr, int wc, int fr, int fq, const LAS float* lb) const {
        const unsigned char* G8 = (const unsigned char*)G;
        const int row0 = u.pm * 256 + wr * 64 + fr, c0 = u.pn * 256 + wc * 32 + 8 * fq;
#pragma unroll
        for (int ai = 0; ai < 2; ++ai) {
            u32x2 wg[4][2];
#pragma unroll
            for (int m = 0; m < 4; ++m)
#pragma unroll
                for (int bj = 0; bj < 2; ++bj) wg[m][bj] = *(const u32x2*)(G8 + (size_t)(row0 + ai * 128 + m * 16) * 2048 + 1024 + c0 + bj * 128);
#pragma unroll
            for (int m = 0; m < 4; ++m) { const int row = row0 + ai * 128 + m * 16;
#pragma unroll
                for (int bj = 0; bj < 2; ++bj) { f32x4 g0, g1; unpk8_fp8(wg[m][bj], g0, g1);
                    st_epi((u32x4*)(O + (size_t)row * D + c0 + bj * 128), pack8(acc[ai][bj][m][0] * g0 * (1.0f / 256.0f), acc[ai][bj][m][1] * g1 * (1.0f / 256.0f))); } }
            asm volatile("" ::: "memory"); __builtin_amdgcn_sched_barrier(0); }
    }
};
struct EpiRes {
    static constexpr bool PERM = true; static constexpr int NST = 16; static constexpr bool HAS_VEC = false;
    const float* Hf; const bf16* Hb; bf16* Hout; const float* g1;
    __device__ __forceinline__ void operator()(const Acc& acc, const Unit& u, int wr, int wc, int fr, int fq, const LAS float* lb) const {
        const int row0 = u.pm * 256 + wr * 64 + fr, c0 = u.pn * 256 + wc * 32 + 8 * fq;
        const float* gp = g1 + (size_t)((u.pm * 256) / SEQ) * 6144;
        f32x4 gv[2][2];
#pragma unroll
        for (int bj = 0; bj < 2; ++bj) { gv[bj][0] = *(const f32x4*)(gp + c0 + bj * 128); gv[bj][1] = *(const f32x4*)(gp + c0 + bj * 128 + 4); }
        if (Hb) {
#pragma unroll
            for (int ai = 0; ai < 2; ++ai) {
                u32x4 hw[4][2];
#pragma unroll
                for (int m = 0; m < 4; ++m)
#pragma unroll
                    for (int bj = 0; bj < 2; ++bj) hw[m][bj] = *(const u32x4*)(Hb + (size_t)(row0 + ai * 128 + m * 16) * D + c0 + bj * 128);
#pragma unroll
                for (int m = 0; m < 4; ++m)
#pragma unroll
                    for (int bj = 0; bj < 2; ++bj) { const size_t o = (size_t)(row0 + ai * 128 + m * 16) * D + c0 + bj * 128; f32x4 h0, h1; unpack8(hw[m][bj], h0, h1);
                        st_epi((u32x4*)(Hout + o), pack8(h0 + gv[bj][0] * acc[ai][bj][m][0], h1 + gv[bj][1] * acc[ai][bj][m][1])); }
                asm volatile("" ::: "memory"); __builtin_amdgcn_sched_barrier(0); }
        } else {
#pragma unroll
            for (int ai = 0; ai < 2; ++ai)
#pragma unroll
                for (int mp = 0; mp < 2; ++mp) {
                    f32x4 hx[2][2][2];
#pragma unroll
                    for (int mm = 0; mm < 2; ++mm)
#pragma unroll
                        for (int bj = 0; bj < 2; ++bj) { const size_t o = (size_t)(row0 + ai * 128 + (2 * mp + mm) * 16) * D + c0 + bj * 128; hx[mm][bj][0] = *(const f32x4*)(Hf + o); hx[mm][bj][1] = *(const f32x4*)(Hf + o + 4); }
#pragma unroll
                    for (int mm = 0; mm < 2; ++mm)
#pragma unroll
                        for (int bj = 0; bj < 2; ++bj) { const int m = 2 * mp + mm; const size_t o = (size_t)(row0 + ai * 128 + m * 16) * D + c0 + bj * 128;
                            st_epi((u32x4*)(Hout + o), pack8(hx[mm][bj][0] + gv[bj][0] * acc[ai][bj][m][0], hx[mm][bj][1] + gv[bj][1] * acc[ai][bj][m][1])); }
                    asm volatile("" ::: "memory"); __builtin_amdgcn_sched_barrier(0); }
        }
    }
};
struct EpiSwiglu {
    static constexpr bool PERM = true; static constexpr int NST = 8; static constexpr bool HAS_VEC = true;
    const float* b1p; unsigned char* ACT;
    __device__ __forceinline__ const float* vec_ptr(const Unit& u) const { return b1p + (size_t)u.e * 2048 + u.pn * 256; }
    __device__ __forceinline__ void operator()(const Acc& acc, const Unit& u, int wr, int wc, int fr, int fq, const LAS float* lb) const {
        const LAS float* bp = lb + wc * 32 + 8 * fq;
        f32x4 bv[2][2];
#pragma unroll
        for (int bj = 0; bj < 2; ++bj) { bv[bj][0] = *(const LAS f32x4*)(bp + bj * 128); bv[bj][1] = *(const LAS f32x4*)(bp + bj * 128 + 4); }
        const int ac0 = u.pn * 128 + 8 * (4 * wc + fq);
#pragma unroll
        for (int ai = 0; ai < 2; ++ai)
#pragma unroll
            for (int m = 0; m < 4; ++m) { const int rl = ai * 128 + wr * 64 + m * 16 + fr;
                f32x4 o[2];
#pragma unroll
                for (int bj = 0; bj < 2; ++bj) { const f32x4 gl = acc[ai][bj][m][0] + bv[bj][0], li = acc[ai][bj][m][1] + bv[bj][1];
#pragma unroll
                    for (int j = 0; j < 4; ++j) { const float xg = fminf(gl[j], 7.0f), xl = fminf(fmaxf(li[j], -7.0f), 7.0f); o[bj][j] = xg * sigmoidf_(1.702f * xg) * (xl * F8_XSCALE + F8_XSCALE); } }
                { u32x2 w; w.x = pk4_fp8_nc(o[0][0], o[0][1], o[0][2], o[0][3]); w.y = pk4_fp8_nc(o[1][0], o[1][1], o[1][2], o[1][3]);
                    const int rr = (rl < u.rows) ? (u.row0 + rl) : (NASG + rl);
                    st_epi((u32x2*)(ACT + (size_t)rr * DFF + ac0), w); }
                __builtin_amdgcn_sched_barrier(0); }
    }
};
struct EpiY {
    static constexpr bool PERM = true; static constexpr int NST = 8; static constexpr bool HAS_VEC = true;
    const float* b2; unsigned char* Y;
    __device__ __forceinline__ const float* vec_ptr(const Unit& u) const { return b2 + (size_t)u.e * 1024 + u.pn * 256; }
    __device__ __forceinline__ void operator()(const Acc& acc, const Unit& u, int wr, int wc, int fr, int fq, const LAS float* lb) const {
        const int cl = 64 * wc + 16 * fq, c0 = u.pn * 256 + cl;
        f32x4 bv[2][2];
#pragma unroll
        for (int bj = 0; bj < 2; ++bj) { bv[bj][0] = *(const LAS f32x4*)(lb + cl + 8 * bj); bv[bj][1] = *(const LAS f32x4*)(lb + cl + 8 * bj + 4); }
#pragma unroll
        for (int ai = 0; ai < 2; ++ai)
#pragma unroll
            for (int m = 0; m < 4; ++m) { const int rl = ai * 128 + wr * 64 + m * 16 + fr;
                const int rr = (rl < u.rows) ? (u.row0 + rl) : (NASG + rl);
                u32x4 w;
#pragma unroll
                for (int bj = 0; bj < 2; ++bj) { const f32x4 y0 = (acc[ai][bj][m][0] + bv[bj][0]) * F8_YSCALE, y1 = (acc[ai][bj][m][1] + bv[bj][1]) * F8_YSCALE;
                    w[2 * bj] = pk4_fp8(y0[0], y0[1], y0[2], y0[3]); w[2 * bj + 1] = pk4_fp8(y1[0], y1[1], y1[2], y1[3]); }
                st_epi((u32x4*)(Y + (size_t)rr * D + c0), w);
                __builtin_amdgcn_sched_barrier(0); }
    }
};
}

enum { IN_X = 0, IN_C, IN_POS, IN_WADA, IN_BADA, IN_N1G, IN_WIN, IN_WS, IN_BS, IN_LNG, IN_LNB, IN_WPA, IN_WPG, IN_WO, IN_N2G, IN_WR, IN_BR, IN_W1, IN_B1, IN_W2, IN_B2, IN_FG, IN_OUT };
struct Args { const float* in[22]; const int* positions; float* out; unsigned char* ws; int ph_lo, ph_hi; int variant, pad; };
struct Frame {
    LAS unsigned char* lds; volatile LAS unsigned* MISC; gu32* ctl;
    int tid, lane, wave, vcu, G;
    unsigned char* ws_;
};
__device__ __forceinline__ unsigned char* ws_of(const Frame& F) { unsigned long long p = (unsigned long long)F.ws_; asm volatile("" : "+s"(p)); return (unsigned char*)(GAS unsigned char*)p; }
__device__ __forceinline__ Frame opaque_frame(const Frame& F0) { Frame F = F0; asm volatile("" : "+v"(F.tid)); F.lane = F.tid & 63; asm volatile("" : "+s"(F.wave), "+s"(F.vcu), "+s"(F.G)); return F; }
__device__ __forceinline__ const float* inp(const Frame& F, int i) {
    const volatile LAS unsigned* t = F.MISC + 16 + 2 * i; const unsigned lo = __builtin_amdgcn_readfirstlane(t[0]), hi = __builtin_amdgcn_readfirstlane(t[1]);
    return (const float*)(const GAS float*)(((unsigned long long)hi << 32) | lo); }

template <int MODE> __device__ __forceinline__ int dest_row(int n) {
    if (MODE == 1) {
        if (n < 2 * AW) { const int hb = n & ~63, d = n & 63, half = d >> 5, f = d & 31; return hb + 8 * (f >> 2) + 4 * half + (f & 3); }
        return n;
    } else if (MODE == 2) {
        const int ac = n >> 1, typ = n & 1, pn = ac >> 7, al = ac & 127, q8 = al >> 3, bj = (al >> 2) & 1, j = al & 3, wc = q8 >> 2, fq = q8 & 3;
        return 256 * pn + 128 * bj + 32 * wc + 8 * fq + 4 * typ + j;
    }
    if (MODE == 3) {
        const int l = n & 255; return (n & ~255) + 128 * ((l >> 3) & 1) + 32 * (l >> 6) + 8 * ((l >> 4) & 3) + (l & 7); }
    return n;
}
template <int MODE> __device__ __forceinline__ void cvt_item(const float* W, int K, int N, bf16* WT, LAS float* scr, int item, int lane, int ldk = 0, int koff = 0) {
    if (ldk == 0) ldk = K;
    const int nblk = N / 64, kb = item / nblk, nb = item % nblk, k0 = kb * 64, n0 = nb * 64;
    const int lr = lane >> 4, lc = (lane & 15) * 4;
    f32x4 v[16];
#pragma unroll
    for (int i = 0; i < 16; ++i) v[i] = *(const f32x4*)(W + (size_t)(k0 + 4 * i + lr) * N + n0 + lc);
#pragma unroll
    for (int i = 0; i < 16; ++i) { LAS float* s = scr + (4 * i + lr) * 65 + lc; s[0] = v[i][0]; s[1] = v[i][1]; s[2] = v[i][2]; s[3] = v[i][3]; }
    LDS_WAIT(); asm volatile("" ::: "memory");
    const int kc = lane & 7;
#pragma unroll
    for (int jj = 0; jj < 8; ++jj) { const int n = (lane >> 3) + 8 * jj; const LAS float* s = scr + (8 * kc) * 65 + n;
        u32x4 o; o.x = pk2(s[0], s[65]); o.y = pk2(s[2 * 65], s[3 * 65]); o.z = pk2(s[4 * 65], s[5 * 65]); o.w = pk2(s[6 * 65], s[7 * 65]);
        *(u32x4*)(WT + (size_t)dest_row<MODE>(n0 + n) * ldk + koff + k0 + 8 * kc) = o; }
    LDS_WAIT(); asm volatile("" ::: "memory");
}

template <int MODE> __device__ __forceinline__ void cvt_item8(const float* W, int K, int N, unsigned char* WT, LAS unsigned char* scr, int item, int lane) {
    const int nblk = N / 64, kb = item / nblk, nb = item % nblk, k0 = kb * 128, n0 = nb * 64;
    const int lr = lane >> 4, lc = (lane & 15) * 4;
    f32x4 v[2][16];
#pragma unroll
    for (int hf = 0; hf < 2; ++hf)
#pragma unroll
        for (int i = 0; i < 16; ++i) v[hf][i] = __builtin_nontemporal_load((const f32x4*)(W + (size_t)(k0 + 64 * hf + 16 * lr + i) * N + n0 + lc));
#pragma unroll
    for (int hf = 0; hf < 2; ++hf) {
#pragma unroll
        for (int c = 0; c < 4; ++c) { u32x4 w;
#pragma unroll
            for (int d = 0; d < 4; ++d) w[d] = pk4_fp8(v[hf][4 * d][c] * F8_WSCALE, v[hf][4 * d + 1][c] * F8_WSCALE, v[hf][4 * d + 2][c] * F8_WSCALE, v[hf][4 * d + 3][c] * F8_WSCALE);
            *(LAS u32x4*)(scr + (lc + c) * 144 + 64 * hf + 16 * lr) = w; }
    }
    LDS_WAIT(); asm volatile("" ::: "memory");
    const int ch = lane & 7;
#pragma unroll
    for (int jj = 0; jj < 8; ++jj) { const int n = (lane >> 3) + 8 * jj;
        const u32x4 o = *(const LAS u32x4*)(scr + n * 144 + 16 * ch); u32x4* dp = (u32x4*)(WT + (size_t)dest_row<MODE>(n0 + n) * K + k0 + 16 * ch);
        if (MODE >= 2) __builtin_nontemporal_store(o, dp); else *dp = o; }
    LDS_WAIT(); asm volatile("" ::: "memory");
}

__device__ __forceinline__ void modnorm_store(const f32x4 (&v)[4], const float* g, const float* sc, const float* sh, bf16* orow, int lane) {
    float s = 0.f;
#pragma unroll
    for (int j = 0; j < 4; ++j) s += (v[j][0] * v[j][0] + v[j][1] * v[j][1]) + (v[j][2] * v[j][2] + v[j][3] * v[j][3]);
    const float rstd = 1.0f / sqrtf(wave_sum(s) * (1.0f / D) + RMS_EPS);
#pragma unroll
    for (int j = 0; j < 4; ++j) { const int c = 4 * lane + 256 * j; const f32x4 gv = *(const f32x4*)(g + c), sv = *(const f32x4*)(sc + c), hv = *(const f32x4*)(sh + c);
        const f32x4 y = v[j] * rstd * gv * (sv + 1.0f) + hv;
        if (MK_P2F8) *(unsigned*)((unsigned char*)orow + c) = pk4_fp8(y[0] * F8_XSCALE, y[1] * F8_XSCALE, y[2] * F8_XSCALE, y[3] * F8_XSCALE);
        else { u32x2 w; w.x = pk2(y[0], y[1]); w.y = pk2(y[2], y[3]); *(u32x2*)(orow + c) = w; } }
}

constexpr int Q_I1 = 8 * 32, Q_I2 = 8 * 16, NQ = NE * (Q_I1 + Q_I2);
struct QItem { const float* src; unsigned char* dst; int N, mode, n0; };
__device__ __forceinline__ QItem q_desc(unsigned char* ws, const float* in_w1, const float* in_w2, int layer, int q) {
    QItem d;
    if (q < NE * Q_I1) { const int m = layer * NE + q / Q_I1, item = q % Q_I1, nblk = 2048 / 64, kb = item / nblk, nb = item % nblk;
        d.N = 2048; d.mode = 2; d.n0 = nb * 64; d.src = in_w1 + (size_t)m * D * 2048 + (size_t)(kb * 128) * 2048 + d.n0; d.dst = (unsigned char*)(ws + WS_W1T) + (size_t)m * 2048 * D + kb * 128; }
    else { const int r = q - NE * Q_I1, m = layer * NE + r / Q_I2, item = r % Q_I2, nblk = D / 64, kb = item / nblk, nb = item % nblk;
        d.N = D; d.mode = 3; d.n0 = nb * 64; d.src = in_w2 + (size_t)m * DFF * D + (size_t)(kb * 128) * D + d.n0; d.dst = (unsigned char*)(ws + WS_W2T) + (size_t)m * D * DFF + kb * 128; }
    return d;
}
#define Q_LOAD(v, d, hf) do { _Pragma("unroll") for (int i = 0; i < 16; ++i) v[i] = __builtin_nontemporal_load((const f32x4*)((d).src + (size_t)(64 * (hf) + 16 * lr + i) * (d).N + lc)); } while (0)
#define Q_CONV(v, hf) do { _Pragma("unroll") for (int c = 0; c < 4; ++c) { u32x4 w; \
        _Pragma("unroll") for (int dd = 0; dd < 4; ++dd) w[dd] = pk4_fp8(v[4 * dd][c] * F8_WSCALE, v[4 * dd + 1][c] * F8_WSCALE, v[4 * dd + 2][c] * F8_WSCALE, v[4 * dd + 3][c] * F8_WSCALE); \
        *(LAS u32x4*)(scr + (lc + c) * 144 + 64 * (hf) + 16 * lr) = w; } } while (0)
__device__ __forceinline__ void cvt_seq(unsigned char* ws, const float* in_w1, const float* in_w2, LAS unsigned char* scr, int layer, int first, int stride, int cnt, int lane) {
    if (first >= NQ || cnt <= 0) return;
    const int lr = lane >> 4, lc = (lane & 15) * 4, ch = lane & 7;
    f32x4 va[16], vb[16];
    QItem d = q_desc(ws, in_w1, in_w2, layer, first);
    Q_LOAD(va, d, 0); Q_LOAD(vb, d, 1);
#pragma unroll 1
    for (int j = 0; j < cnt; ++j) {
        const int qn = first + (j + 1) * stride; const bool more = (j + 1 < cnt) && (qn < NQ);
        QItem dn = d; if (more) dn = q_desc(ws, in_w1, in_w2, layer, qn);
        Q_CONV(va, 0);
        if (more) Q_LOAD(va, dn, 0);
        Q_CONV(vb, 1);
        LDS_WAIT(); asm volatile("" ::: "memory");
#pragma unroll
        for (int jj = 0; jj < 8; ++jj) { const int n = (lane >> 3) + 8 * jj; const int nn = d.n0 + n; const int dr = (d.mode == 2) ? dest_row<2>(nn) : dest_row<3>(nn);
            const u32x4 o = *(const LAS u32x4*)(scr + n * 144 + 16 * ch); __builtin_nontemporal_store(o, (u32x4*)(d.dst + (size_t)dr * 1024 + 16 * ch)); }
        LDS_WAIT(); asm volatile("" ::: "memory");
        if (!more) break;
        Q_LOAD(vb, dn, 1);
        d = dn;
    }
}
#undef Q_LOAD
#undef Q_CONV

__device__ __forceinline__ void phase_pr0(const Frame& F0) {
    const Frame F = opaque_frame(F0);
    unsigned char* ws = ws_of(F);
    const float* in_c = inp(F, IN_C); const float* in_wada = inp(F, IN_WADA); const float* in_bada = inp(F, IN_BADA); const int* in_pos = (const int*)inp(F, IN_POS);
    const float* in_wr = inp(F, IN_WR); const float* in_ws = inp(F, IN_WS); const float* in_b1 = inp(F, IN_B1);
    {
        LAS float* sl = (LAS float*)F.lds;
        LAS float* red = (LAS float*)(F.lds + 32768);
        float* MOD = (float*)(ws + WS_MOD);
        for (int i = F.tid; i < BATCH * D; i += NTHR) { const int b = i >> 10, k = i & 1023; const float cv = in_c[i]; sl[k * 8 + b] = cv * sigmoidf_(cv); }
        __syncthreads();
        for (int it = blockIdx.x; it < DEPTH * 128; it += F.G) {
            const int l = it / 128, cl_ = F.lane < 48 ? F.lane : 47, col = (it % 128) * 48 + cl_;
            const float* W = in_wada + (size_t)l * D * 6144 + col;
            float a[8];
#pragma unroll
            for (int b = 0; b < 8; ++b) a[b] = 0.f;
            const int kb = F.wave * 128;
#pragma unroll 32
            for (int k = 0; k < 128; ++k) { const float w = W[(size_t)(kb + k) * 6144]; const f32x4 s0 = *(const LAS f32x4*)(sl + (kb + k) * 8), s1 = *(const LAS f32x4*)(sl + (kb + k) * 8 + 4);
                a[0] += s0[0] * w; a[1] += s0[1] * w; a[2] += s0[2] * w; a[3] += s0[3] * w; a[4] += s1[0] * w; a[5] += s1[1] * w; a[6] += s1[2] * w; a[7] += s1[3] * w; }
#pragma unroll
            for (int b = 0; b < 8; ++b) red[(F.wave * 8 + b) * 64 + F.lane] = a[b];
            __syncthreads();
            { const int b = F.wave; float s = 0.f;
#pragma unroll
              for (int w = 0; w < 8; ++w) s += red[(w * 8 + b) * 64 + F.lane];
              if (F.lane < 48) MOD[((size_t)l * BATCH + b) * 6144 + col] = s + in_bada[l * 6144 + col]; }
            __syncthreads();
        }
        __syncthreads();
    }
    const int gw = F.vcu * NWAVES + F.wave, NGW = F.G * NWAVES;
    const int gt = F.vcu * NTHR + F.tid, NGT = F.G * NTHR;
    {
        float* RC = (float*)(ws + WS_ROPEC); float* RS = (float*)(ws + WS_ROPES);
        for (int i = gt; i < NTOK * 32; i += NGT) { const int row = i >> 5, f = i & 31;
            const float invf = (float)exp(-(double)f * (9.210340371976184 / 32.0));
            const float ang = (float)in_pos[row] * invf;
            const double x = (double)ang; const double k = rint(x * 0.15915494309189535); const float r = (float)(x - k * 6.283185307179586);
            RC[i] = __cosf(r); RS[i] = __sinf(r); }
    }
    {
        bf16* WRH = (bf16*)(ws + WS_WRH); bf16* WRL = (bf16*)(ws + WS_WRL);
        for (int i = gt; i < DEPTH * NE * D; i += NGT) { const int l = i / (NE * D), e = (i / D) % NE, d = i % D; const float w = in_wr[((size_t)l * D + d) * NE + e];
            const unsigned h = pk2(w, 0.f) & 0xffffu; const float lo = w - bf2f((bf16)h); WRH[i] = (bf16)h; WRL[i] = (bf16)(pk2(lo, 0.f) & 0xffffu); }
        bf16* WSB = (bf16*)(ws + WS_WSB);
        for (int i = gt; i < DEPTH * 4 * 128 * 128; i += NGT) { const int t = (i >> 7) & 127, s = i & 127; WSB[i] = (s <= t) ? (bf16)(pk2(in_ws[i], 0.f) & 0xffffu) : (bf16)0; }
        float* B1P = (float*)(ws + WS_B1P);
        for (int i = gt; i < DEPTH * NE * 2048; i += NGT) { const int n = i & 2047; B1P[(i & ~2047) + dest_row<2>(n)] = in_b1[i]; }
    }
    {
        LAS float* scr = (LAS float*)(F.lds + F.wave * 16640);
        const float* in_win = inp(F, IN_WIN); const float* in_wpa = inp(F, IN_WPA); const float* in_wpg = inp(F, IN_WPG); const float* in_wo = inp(F, IN_WO); const float* in_w1 = inp(F, IN_W1); const float* in_w2 = inp(F, IN_W2);
        constexpr int I_IN = (MK_P2F8 ? 8 : 16) * 84, I_PA = 4 * 16, I_PG = 8 * 16, I_O = 16 * 16, I_1 = 8 * 32, I_2 = 8 * 16;
        constexpr int N_IN = DEPTH * I_IN, N_PA = DEPTH * I_PA, N_PG = DEPTH * I_PG, N_O = DEPTH * I_O, N_1 = (MK_TAILCVT ? 1 : DEPTH) * NE * I_1, N_2 = (MK_TAILCVT ? 1 : DEPTH) * NE * I_2;
        constexpr int NITEMS = N_IN + N_PA + N_PG + N_O;
        for (int it = gw; it < NITEMS; it += NGW) {
            int r = it;
            if (r < N_IN) { const int m = r / I_IN; if (MK_P2F8) cvt_item8<1>(in_win + (size_t)m * D * INW, D, INW, (unsigned char*)(ws + WS_WTIN) + (size_t)m * INW * D, (LAS unsigned char*)scr, r % I_IN, F.lane); else cvt_item<1>(in_win + (size_t)m * D * INW, D, INW, (bf16*)(ws + WS_WTIN) + (size_t)m * INW * D, scr, r % I_IN, F.lane); continue; } r -= N_IN;
            if (r < N_PA) { const int m = r / I_PA; cvt_item<0>(in_wpa + (size_t)m * AO * D, AO, D, (bf16*)(ws + WS_WTPA) + (size_t)m * D * AW, scr, r % I_PA, F.lane, AW, 0); continue; } r -= N_PA;
            if (r < N_PG) { const int m = r / I_PG; cvt_item<0>(in_wpg + (size_t)m * GW * D, GW, D, (bf16*)(ws + WS_WTPA) + (size_t)m * D * AW, scr, r % I_PG, F.lane, AW, AO); continue; } r -= N_PG;
            if (r < N_O) { const int m = r / I_O; cvt_item<0>(in_wo + (size_t)m * D * D, D, D, (bf16*)(ws + WS_WTO) + (size_t)m * D * D, scr, r % I_O, F.lane); continue; } r -= N_O;
        }
        cvt_seq(ws, in_w1, in_w2, (LAS unsigned char*)scr, 0, gw, NGW, NQ, F.lane);
        if (!MK_TAILCVT) cvt_seq(ws, in_w1, in_w2, (LAS unsigned char*)scr, 1, gw, NGW, NQ, F.lane);
    }
}

__device__ __forceinline__ int tail_idle_cnt(int nwg, int G) { const int rem = nwg % G; return rem > 0 ? G - rem : 0; }
__device__ __forceinline__ int tail_ipw(int k) { return k == 2 ? MK_TAILIPW_P9 : MK_TAILIPW; }
__device__ __forceinline__ int tail_base(int k, int nM0, int G) {
    int b = 0;
    if (k > 0) b += tail_idle_cnt((NTOK / 256) * (INW / 256), G) * NWAVES * tail_ipw(0);
    if (k > 1) b += tail_idle_cnt(nM0 * (2048 / 256), G) * NWAVES * tail_ipw(1);
    if (k > 2) b += tail_idle_cnt(nM0 * (D / 256), G) * NWAVES * tail_ipw(2);
    if (k > 3) b += tail_idle_cnt((NTOK / 256) * (INW / 256), G) * NWAVES * tail_ipw(3);
    return b;
}
__device__ __forceinline__ void cvt_tail(const Frame& F0, int k, int nwg) {
    if (k < 4) { const int rem0 = nwg % F0.G; if (rem0 == 0 || (int)blockIdx.x < rem0) return; }
    const Frame F = opaque_frame(F0);
    unsigned char* ws = ws_of(F);
    const float* in_w1 = inp(F, IN_W1); const float* in_w2 = inp(F, IN_W2);
    LAS unsigned char* scr = F.lds + F.wave * 16640;
    const int nM0 = k > 0 ? __builtin_amdgcn_readfirstlane(((const int*)(ws + WS_ETAB))[128]) : 0;
    if (k < 4) {
        const int rem = nwg % F.G, idle = F.G - rem, ii = (int)blockIdx.x - rem, base = tail_base(k, nM0, F.G);
        cvt_seq(ws, in_w1, in_w2, scr, 1, base + ii * NWAVES + F.wave, idle * NWAVES, tail_ipw(k), F.lane);
    } else {
        const int gw = F.vcu * NWAVES + F.wave, NGW = F.G * NWAVES;
        cvt_seq(ws, in_w1, in_w2, scr, 1, tail_base(4, nM0, F.G) + gw, NGW, NQ, F.lane);
    }
}

__device__ __forceinline__ void phase_pr1(const Frame& F0) {
    const Frame F = opaque_frame(F0);
    const int gw = F.vcu * NWAVES + F.wave, NGW = F.G * NWAVES;
    unsigned char* ws = ws_of(F);
    const float* MOD = (const float*)(ws + WS_MOD); bf16* AIN = (bf16*)(ws + WS_AIN);
    const float* in_x = inp(F, IN_X); const float* in_n1g = inp(F, IN_N1G);
    f32x4 vn[4];
    if (gw < NTOK) {
#pragma unroll
        for (int j = 0; j < 4; ++j) vn[j] = *(const f32x4*)(in_x + (size_t)gw * D + 4 * F.lane + 256 * j); }
    for (int t = gw; t < NTOK; t += NGW) { const int b = t / SEQ; const float* mp = MOD + (size_t)b * 6144;
        f32x4 v[4];
#pragma unroll
        for (int j = 0; j < 4; ++j) v[j] = vn[j];
        if (t + NGW < NTOK) {
#pragma unroll
            for (int j = 0; j < 4; ++j) vn[j] = *(const f32x4*)(in_x + (size_t)(t + NGW) * D + 4 * F.lane + 256 * j); }
        modnorm_store(v, in_n1g, mp + 1024, mp, MK_P2F8 ? (bf16*)((unsigned char*)AIN + (size_t)t * D) : AIN + (size_t)t * D, F.lane); }
}

__device__ __forceinline__ int crow(int r, int hi) { return (r & 3) + 8 * (r >> 2) + 4 * hi; }
constexpr int VSTR = 192;
__device__ __forceinline__ s16x4 tr_read(const LAS unsigned char* p) { typedef short v4i16_t __attribute__((ext_vector_type(4))); return __builtin_bit_cast(s16x4, __builtin_amdgcn_ds_read_tr16_b64_v4i16((LAS v4i16_t*)p)); }
__device__ __forceinline__ float half_swap_max(float m) { auto rr = __builtin_amdgcn_permlane32_swap(__float_as_uint(m), __float_as_uint(m), false, false); return fmaxf(__uint_as_float(rr[0]), __uint_as_float(rr[1])); }
__device__ __forceinline__ float half_swap_sum(float m) { auto rr = __builtin_amdgcn_permlane32_swap(__float_as_uint(m), __float_as_uint(m), false, false); return __uint_as_float(rr[0]) + __uint_as_float(rr[1]); }

__device__ __forceinline__ void attn_block(const Frame& F, const bf16* Qb, const bf16* Kb, const bf16* Vb, bf16* OGg, float* LSEg, int b, int r, int j, int n, int g) {
    const int lane = F.lane, w = F.wave, q = lane & 31, hh = lane >> 5;
    const unsigned lds0 = (unsigned)(__UINTPTR_TYPE__)F.lds;
    const int gi = (lane >> 4) & 1, q4 = (lane & 15) >> 2, p4 = lane & 3;
#pragma unroll 1
    for (int hp = 0; hp < 2; ++hp) {
        { const int rowin = lane >> 3, c = (lane & 7) ^ rowin;
#pragma unroll
          for (int i = 0; i < 8; ++i) { const int rg = w * 8 + i, hl = rg >> 5, rgi = rg & 31;
              if (n > 0 || rgi >= 16) {
                  const int row = 8 * rgi + rowin;
                  const unsigned voff = (unsigned)(((size_t)b * SEQ + (size_t)((n - 1) * 128 + row) * r + j) * AW + g * 256 + (2 * hp + hl) * 64 + 8 * c) * 2u;
                  glds16((unsigned long long)Kb, voff, lds0 + hl * 32768 + rgi * 1024);
                  glds16((unsigned long long)Vb, voff, lds0 + 65536 + hl * 32768 + rgi * 1024); } } }
        const int hl = w >> 2, I = w & 3, h = 2 * hp + hl;
        const size_t rowq = (size_t)b * SEQ + (size_t)(n * 128 + 32 * I + q) * r + j;
        bf16x8 qf[4];
#pragma unroll
        for (int s = 0; s < 4; ++s) qf[s] = *(const bf16x8*)(Qb + rowq * AW + g * 256 + h * 64 + 16 * s + 8 * hh);
        asm volatile("s_waitcnt vmcnt(0)" ::: "memory");
        __syncthreads();
        const LAS unsigned char* Kimg = F.lds + hl * 32768; const LAS unsigned char* Vimg = F.lds + 65536 + hl * 32768;
        f32x16 o0, o1;
#pragma unroll
        for (int i = 0; i < 16; ++i) { o0[i] = 0.f; o1[i] = 0.f; }
        float mrun = -1e30f, lrun = 0.f;
        const int Jlo = (n == 0 && I < 4) ? 4 : I, Jhi = I + 4;
#pragma unroll 1
        for (int J = Jlo; J <= Jhi; ++J) {
            f32x16 st;
#pragma unroll
            for (int i = 0; i < 16; ++i) st[i] = 0.f;
            { const int row = 32 * J + q; const LAS unsigned char* kr = Kimg + row * 128;
#pragma unroll
              for (int s = 0; s < 4; ++s) { const bf16x8 kf = *(const LAS bf16x8*)(kr + (((2 * s + hh) ^ (row & 7)) << 4)); st = __builtin_amdgcn_mfma_f32_32x32x16_bf16(kf, qf[s], st, 0, 0, 0); } }
            if (J == I) {
#pragma unroll
                for (int i = 0; i < 16; ++i) if (crow(i, hh) < q) st[i] = -1e30f;
            }
            if (J == I + 4) {
#pragma unroll
                for (int i = 0; i < 16; ++i) if (crow(i, hh) > q) st[i] = -1e30f;
            }
            float mx = st[0];
#pragma unroll
            for (int i = 1; i < 16; ++i) mx = fmaxf(mx, st[i]);
            mx = half_swap_max(mx);
            const float mnew = fmaxf(mrun, mx), alpha = fast_exp2(mrun - mnew);
            float rs = 0.f;
#pragma unroll
            for (int i = 0; i < 16; ++i) { st[i] = fast_exp2(st[i] - mnew); rs += st[i]; }
            rs = half_swap_sum(rs);
            lrun = lrun * alpha + rs; mrun = mnew;
#pragma unroll
            for (int i = 0; i < 16; ++i) { o0[i] *= alpha; o1[i] *= alpha; }
            bf16x8 pf[2];
#pragma unroll
            for (int s = 0; s < 2; ++s) { u32x4 wv; wv.x = pk2(st[8 * s + 0], st[8 * s + 1]); wv.y = pk2(st[8 * s + 2], st[8 * s + 3]); wv.z = pk2(st[8 * s + 4], st[8 * s + 5]); wv.w = pk2(st[8 * s + 6], st[8 * s + 7]); pf[s] = __builtin_bit_cast(bf16x8, wv); }
            { const int sw = 4 * hh + q4; const LAS unsigned char* vr = Vimg + (32 * J + 4 * hh + q4) * 128 + 8 * (p4 & 1);
              const int c0 = ((2 * gi + (p4 >> 1)) ^ sw) << 4, c1 = ((4 + 2 * gi + (p4 >> 1)) ^ sw) << 4;
#pragma unroll
              for (int s = 0; s < 2; ++s) {
                  const s16x4 a0 = tr_read(vr + (16 * s) * 128 + c0), a1 = tr_read(vr + (16 * s + 8) * 128 + c0);
                  const s16x4 e0 = tr_read(vr + (16 * s) * 128 + c1), e1 = tr_read(vr + (16 * s + 8) * 128 + c1);
                  const bf16x8 v0 = (bf16x8){a0[0], a0[1], a0[2], a0[3], a1[0], a1[1], a1[2], a1[3]}, v1 = (bf16x8){e0[0], e0[1], e0[2], e0[3], e1[0], e1[1], e1[2], e1[3]};
                  o0 = __builtin_amdgcn_mfma_f32_32x32x16_bf16(v0, pf[s], o0, 0, 0, 0);
                  o1 = __builtin_amdgcn_mfma_f32_32x32x16_bf16(v1, pf[s], o1, 0, 0, 0); } }
        }
        const float inv = 1.0f / lrun;
        bf16* op = OGg + rowq * AO + h * 64 + 4 * hh;
#pragma unroll
        for (int rq = 0; rq < 4; ++rq) {
            u32x2 w0, w1;
            w0.x = pk2(o0[4 * rq] * inv, o0[4 * rq + 1] * inv); w0.y = pk2(o0[4 * rq + 2] * inv, o0[4 * rq + 3] * inv);
            w1.x = pk2(o1[4 * rq] * inv, o1[4 * rq + 1] * inv); w1.y = pk2(o1[4 * rq + 2] * inv, o1[4 * rq + 3] * inv);
            *(u32x2*)(op + 8 * rq) = w0; *(u32x2*)(op + 32 + 8 * rq) = w1; }
        if (hh == 0) LSEg[rowq * 4 + h] = (mrun + __log2f(lrun)) * LN2;
        __syncthreads();
    }
}

__device__ __forceinline__ void phase_attn(const Frame& F0) {
    const Frame F = opaque_frame(F0);
    unsigned char* ws = ws_of(F);
    const bf16* Qb = (const bf16*)(ws + WS_QB); const bf16* Kb = (const bf16*)(ws + WS_KB); const bf16* Vb = (const bf16*)(ws + WS_VB);
    bf16* OG = (bf16*)(ws + WS_OG); float* LSE = (float*)(ws + WS_LSE);
    __syncthreads();
    for (int b0 = blockIdx.x * 3; b0 < 768; b0 += F.G * 3)
#pragma unroll 1
        for (int blk = b0; blk < b0 + 3 && blk < 768; ++blk) {
            const int g = blk >> 8, rem = blk & 255, b = rem >> 5, jn = rem & 31;
            const int r = (g == 0) ? 1 : (g == 1 ? 4 : 16), nb = 32 / r, j = jn / nb, n = jn % nb;
            attn_block(F, Qb, Kb, Vb, OG + (size_t)g * NTOK * AO, LSE + (size_t)g * NTOK * 4, b, r, j, n, g);
        }
}

constexpr int ISTR = 320;
__device__ __forceinline__ void phase_gmlp(const Frame& F0, int l) {
    const Frame F = opaque_frame(F0);
    unsigned char* ws = ws_of(F);
    const bf16* VG = (const bf16*)(ws + WS_VGB); const bf16* U = (const bf16*)(ws + WS_UB); bf16* GM = (bf16*)(ws + WS_ATT) + AO;
    const bf16* WSB = (const bf16*)(ws + WS_WSB) + (size_t)l * 4 * 128 * 128;
    const float* lng = inp(F, IN_LNG) + l * GW; const float* lnb = inp(F, IN_LNB) + l * GW; const float* bs = inp(F, IN_BS) + l * 4 * 128;
    LAS unsigned char* img = F.lds; LAS f32x2* ST = (LAS f32x2*)(F.lds + 128 * ISTR);
    const int lane = F.lane, q = lane & 31, hh = lane >> 5, gi = (lane >> 4) & 1, q4 = (lane & 15) >> 2, p4 = lane & 3;
    for (int un = blockIdx.x; un < NTILE128; un += F.G) {
        const size_t R0 = (size_t)un * 128;
        __syncthreads();
        u32x4 rowv[16];
#pragma unroll
        for (int i = 0; i < 16; ++i) rowv[i] = *(const u32x4*)(VG + (R0 + F.wave * 16 + i) * GW + 8 * lane);
#pragma unroll
        for (int i = 0; i < 16; ++i) { const int tk = F.wave * 16 + i; f32x4 a, b2; pg8::unpack8(rowv[i], a, b2);
            const float s = wave_sum((a[0] + a[1]) + (a[2] + a[3]) + (b2[0] + b2[1]) + (b2[2] + b2[3])); const float mean = s * (1.0f / GW);
            const f32x4 da = a - mean, db = b2 - mean; const float ss = wave_sum((da[0] * da[0] + da[1] * da[1]) + (da[2] * da[2] + da[3] * da[3]) + (db[0] * db[0] + db[1] * db[1]) + (db[2] * db[2] + db[3] * db[3]));
            if (lane == 0) ST[tk] = (f32x2){mean, 1.0f / sqrtf(ss * (1.0f / GW) + LN_EPS)}; }
        __syncthreads();
        const int ch = lane & 15, tt = F.wave >> 1;
        u32x4 sl[4];
#pragma unroll
        for (int i = 0; i < 4; ++i) sl[i] = *(const u32x4*)(VG + (R0 + F.wave * 16 + ((lane + 64 * i) >> 4)) * GW + 8 * ch);
#pragma unroll 1
        for (int g = 0; g < 4; ++g) {
            bf16x8 bw[8];
            const bf16* wrow = WSB + ((size_t)g * 128 + 32 * tt + q) * 128 + 8 * hh;
#pragma unroll
            for (int ks = 0; ks < 8; ++ks) if (ks < 2 * (tt + 1)) bw[ks] = *(const bf16x8*)(wrow + 16 * ks);
            const size_t orow = R0 + 32 * tt + q;
            u32x2 uw[2][4];
#pragma unroll
            for (int cc = 0; cc < 2; ++cc)
#pragma unroll
                for (int rq = 0; rq < 4; ++rq) uw[cc][rq] = *(const u32x2*)(U + orow * GW + g * 128 + 32 * (2 * (F.wave & 1) + cc) + 8 * rq + 4 * hh);
            const float bias = bs[g * 128 + 32 * tt + q];
            { f32x4 ga, gb, ba, bb;
              ga = *(const f32x4*)(lng + g * 128 + 8 * ch); gb = *(const f32x4*)(lng + g * 128 + 8 * ch + 4); ba = *(const f32x4*)(lnb + g * 128 + 8 * ch); bb = *(const f32x4*)(lnb + g * 128 + 8 * ch + 4);
#pragma unroll
              for (int i = 0; i < 4; ++i) { const int tk = F.wave * 16 + ((lane + 64 * i) >> 4); f32x4 a, b2; pg8::unpack8(sl[i], a, b2);
                  const f32x2 st = ST[tk]; a = (a - st.x) * st.y * ga + ba; b2 = (b2 - st.x) * st.y * gb + bb;
                  *(LAS u32x4*)(img + tk * ISTR + ch * 16) = pg8::pack8(a, b2); } }
            if (g < 3) {
#pragma unroll
                for (int i = 0; i < 4; ++i) sl[i] = *(const u32x4*)(VG + (R0 + F.wave * 16 + ((lane + 64 * i) >> 4)) * GW + (g + 1) * 128 + 8 * ch); }
            __syncthreads();
            f32x16 acc[2];
#pragma unroll
            for (int i = 0; i < 16; ++i) { acc[0][i] = 0.f; acc[1][i] = 0.f; }
#pragma unroll
            for (int ks = 0; ks < 8; ++ks) if (ks < 2 * (tt + 1)) {
#pragma unroll
                for (int cc = 0; cc < 2; ++cc) { const int ct = 2 * (F.wave & 1) + cc;
                    const LAS unsigned char* tb = img + (16 * ks + 8 * hh + q4) * ISTR + (32 * ct + 16 * gi + 4 * p4) * 2;
                    const s16x4 a0 = tr_read(tb), a1 = tr_read(tb + 4 * ISTR);
                    const bf16x8 af = (bf16x8){a0[0], a0[1], a0[2], a0[3], a1[0], a1[1], a1[2], a1[3]};
                    acc[cc] = __builtin_amdgcn_mfma_f32_32x32x16_bf16(af, bw[ks], acc[cc], 0, 0, 0); }
            }
#pragma unroll
            for (int cc = 0; cc < 2; ++cc) { const int ct = 2 * (F.wave & 1) + cc;
#pragma unroll
                for (int rq = 0; rq < 4; ++rq) { const int c0 = g * 128 + 32 * ct + 8 * rq + 4 * hh; const u32x2 u2 = uw[cc][rq];
                    u32x2 w; w.x = pk2((acc[cc][4 * rq] + bias) * bf_lo(u2.x), (acc[cc][4 * rq + 1] + bias) * bf_hi(u2.x)); w.y = pk2((acc[cc][4 * rq + 2] + bias) * bf_lo(u2.y), (acc[cc][4 * rq + 3] + bias) * bf_hi(u2.y));
                    *(u32x2*)(GM + orow * AW + c0) = w; } }
            __syncthreads();
        }
    }
}

__device__ __forceinline__ void phase_merge(const Frame& F0) {
    const Frame F = opaque_frame(F0);
    const int gw = F.vcu * NWAVES + F.wave, NGW = F.G * NWAVES;
    unsigned char* ws = ws_of(F);
    const bf16* OG = (const bf16*)(ws + WS_OG); const float* LSE = (const float*)(ws + WS_LSE); bf16* ATT = (bf16*)(ws + WS_ATT);
    const int lane = F.lane, h = lane >> 4;
    for (int t0 = gw; t0 < NTOK; t0 += 4 * NGW) {
        float l0[4], l1[4], l2[4]; u32x2 a[4], b[4], c[4];
#pragma unroll
        for (int u = 0; u < 4; ++u) { const int t = t0 + u * NGW; if (t < NTOK) {
            l0[u] = LSE[(size_t)t * 4 + h]; l1[u] = LSE[((size_t)NTOK + t) * 4 + h]; l2[u] = LSE[((size_t)2 * NTOK + t) * 4 + h];
            a[u] = *(const u32x2*)(OG + (size_t)t * AO + 4 * lane); b[u] = *(const u32x2*)(OG + ((size_t)NTOK + t) * AO + 4 * lane); c[u] = *(const u32x2*)(OG + ((size_t)2 * NTOK + t) * AO + 4 * lane); } }
#pragma unroll
        for (int u = 0; u < 4; ++u) { const int t = t0 + u * NGW; if (t < NTOK) {
            const float mx = fmaxf(l0[u], fmaxf(l1[u], l2[u])); float w0 = fast_exp2((l0[u] - mx) * LOG2E), w1 = fast_exp2((l1[u] - mx) * LOG2E), w2 = fast_exp2((l2[u] - mx) * LOG2E);
            const float inv = 1.0f / (w0 + w1 + w2); w0 *= inv; w1 *= inv; w2 *= inv;
            u32x2 w; w.x = pk2(w0 * bf_lo(a[u].x) + w1 * bf_lo(b[u].x) + w2 * bf_lo(c[u].x), w0 * bf_hi(a[u].x) + w1 * bf_hi(b[u].x) + w2 * bf_hi(c[u].x));
            w.y = pk2(w0 * bf_lo(a[u].y) + w1 * bf_lo(b[u].y) + w2 * bf_lo(c[u].y), w0 * bf_hi(a[u].y) + w1 * bf_hi(b[u].y) + w2 * bf_hi(c[u].y));
            *(u32x2*)(ATT + (size_t)t * AW + 4 * lane) = w; } }
    }
}

__device__ __forceinline__ void phase_router(const Frame& F0, int l) {
    const Frame F = opaque_frame(F0);
    unsigned char* ws = ws_of(F);
    const bf16* H = (const bf16*)(ws + WS_HB1); unsigned char* FB = (unsigned char*)(ws + WS_AIN);
    const float* MOD = (const float*)(ws + WS_MOD) + (size_t)l * BATCH * 6144;
    const bf16* WRH = (const bf16*)(ws + WS_WRH) + (size_t)l * NE * D; const bf16* WRL = (const bf16*)(ws + WS_WRL) + (size_t)l * NE * D;
    int* TOPI = (int*)(ws + WS_TOPI); float* TOPG = (float*)(ws + WS_TOPG); int* WGH = (int*)(ws + WS_WGH);
    const float* n2g = inp(F, IN_N2G) + l * D; const float* br = inp(F, IN_BR) + l * NE;
    LAS float* LG = (LAS float*)(F.lds + F.wave * 2048);
    LAS int* EX = (LAS int*)(F.lds + 16384);
    LAS int* HIST = (LAS int*)(F.lds + 16384 + 2048);
    LAS float* SC = (LAS float*)(F.lds + 20480); LAS float* SH = SC + D;
    const int lane = F.lane, tl = lane & 15, kq = lane >> 4;
    for (int tile = blockIdx.x; tile < NTILE128; tile += F.G) {
        __syncthreads();
        if (F.tid < 32) HIST[F.tid] = 0;
        const int T = tile * 128 + F.wave * 16 + tl, b = (tile * 128) / SEQ;
        const bf16* hrow = H + (size_t)T * D + 8 * kq;
#pragma unroll
        for (int i = 0; i < 8; ++i) { const int pi = F.wave * 8 + i, e = pi >> 1, hf = pi & 1, c = (64 * hf + lane) ^ (e & 15);
            glds16((unsigned long long)WRH, (unsigned)(e * 2048 + c * 16), (unsigned)(__UINTPTR_TYPE__)F.lds + 32768 + pi * 1024); }
        u32x4 hq[32];
#pragma unroll
        for (int ks = 0; ks < 32; ++ks) hq[ks] = *(const u32x4*)(hrow + 32 * ks);
        { const float* sc2 = MOD + (size_t)b * 6144 + 4 * 1024; const float* sh2 = MOD + (size_t)b * 6144 + 3 * 1024;
          for (int i = F.tid; i < D; i += NTHR) { SC[i] = n2g[i] * (1.0f + sc2[i]); SH[i] = sh2[i]; } }
        float ss = 0.f;
#pragma unroll
        for (int ks = 0; ks < 32; ++ks) { f32x4 a, c; pg8::unpack8(hq[ks], a, c);
            ss += (a[0] * a[0] + a[1] * a[1]) + (a[2] * a[2] + a[3] * a[3]) + (c[0] * c[0] + c[1] * c[1]) + (c[2] * c[2] + c[3] * c[3]); }
        ss += __shfl_xor(ss, 16); ss += __shfl_xor(ss, 32);
        const float rstd = 1.0f / sqrtf(ss * (1.0f / D) + RMS_EPS);
        __syncthreads();
        f32x4 acc0 = {0.f, 0.f, 0.f, 0.f}, acc1 = {0.f, 0.f, 0.f, 0.f};
        const LAS unsigned char* wimg0 = F.lds + 32768 + tl * 2048; const LAS unsigned char* wimg1 = wimg0 + 16 * 2048;
#pragma unroll
        for (int ks = 0; ks < 32; ++ks) {
            { const int c0 = 32 * ks + 8 * kq;
                u32x4 hraw = hq[ks]; asm volatile("" : "+v"(hraw));
                f32x4 a, c; pg8::unpack8(hraw, a, c);
                const f32x4 s0 = *(const LAS f32x4*)(SC + c0), s1 = *(const LAS f32x4*)(SC + c0 + 4), h0 = *(const LAS f32x4*)(SH + c0), h1 = *(const LAS f32x4*)(SH + c0 + 4);
                a = a * rstd * s0 + h0; c = c * rstd * s1 + h1;
                const u32x4 hi = pg8::pack8(a, c); f32x4 ah, ch; pg8::unpack8(hi, ah, ch); const u32x4 lo = pg8::pack8(a - ah, c - ch);
                { u32x2 w8; w8.x = pk4_fp8(a[0] * F8_XSCALE, a[1] * F8_XSCALE, a[2] * F8_XSCALE, a[3] * F8_XSCALE); w8.y = pk4_fp8(c[0] * F8_XSCALE, c[1] * F8_XSCALE, c[2] * F8_XSCALE, c[3] * F8_XSCALE); *(u32x2*)(FB + (size_t)T * D + c0) = w8; }
                const bf16x8 fh = __builtin_bit_cast(bf16x8, hi), fl = __builtin_bit_cast(bf16x8, lo);
                const int wo = (((4 * ks + kq) ^ tl) << 4);
                const bf16x8 wh0 = *(const LAS bf16x8*)(wimg0 + wo), wh1 = *(const LAS bf16x8*)(wimg1 + wo);
                acc0 = __builtin_amdgcn_mfma_f32_16x16x32_bf16(fh, wh0, acc0, 0, 0, 0); acc0 = __builtin_amdgcn_mfma_f32_16x16x32_bf16(fl, wh0, acc0, 0, 0, 0);
                acc1 = __builtin_amdgcn_mfma_f32_16x16x32_bf16(fh, wh1, acc1, 0, 0, 0); acc1 = __builtin_amdgcn_mfma_f32_16x16x32_bf16(fl, wh1, acc1, 0, 0, 0); }
            if ((ks & 3) == 3) __builtin_amdgcn_sched_barrier(0);
        }
        { const float b0 = br[tl], b1 = br[16 + tl];
#pragma unroll
          for (int rg = 0; rg < 4; ++rg) { LG[(4 * kq + rg) * 32 + tl] = acc0[rg] + b0; LG[(4 * kq + rg) * 32 + 16 + tl] = acc1[rg] + b1; } }
        LDS_WAIT();
        if (lane < 16) {
            float v[32];
#pragma unroll
            for (int i = 0; i < 8; ++i) { const f32x4 x = *(const LAS f32x4*)(LG + lane * 32 + 4 * i); v[4 * i] = x[0]; v[4 * i + 1] = x[1]; v[4 * i + 2] = x[2]; v[4 * i + 3] = x[3]; }
            int ti[4]; float tv[4];
#pragma unroll
            for (int k = 0; k < 4; ++k) { float best = -3.0e38f; int bi = 0;
#pragma unroll
                for (int e = 0; e < 32; ++e) { const bool taken = (k > 0 && ti[0] == e) || (k > 1 && ti[1] == e) || (k > 2 && ti[2] == e); if (!taken && v[e] > best) { best = v[e]; bi = e; } }
                ti[k] = bi; tv[k] = best; }
            const float e1 = fast_exp2((tv[1] - tv[0]) * LOG2E), e2 = fast_exp2((tv[2] - tv[0]) * LOG2E), e3 = fast_exp2((tv[3] - tv[0]) * LOG2E); const float inv = 1.0f / (1.0f + e1 + e2 + e3);
            const int Tt = tile * 128 + F.wave * 16 + lane;
            *(i32x4*)(TOPI + (size_t)Tt * 4) = (i32x4){ti[0], ti[1], ti[2], ti[3]}; *(f32x4*)(TOPG + (size_t)Tt * 4) = (f32x4){inv, e1 * inv, e2 * inv, e3 * inv};
            *(LAS i32x4*)(EX + (F.wave * 16 + lane) * 4) = (i32x4){ti[0], ti[1], ti[2], ti[3]};
        }
        __syncthreads();
        __hip_atomic_fetch_add(&HIST[EX[F.tid]], 1, __ATOMIC_RELAXED, __HIP_MEMORY_SCOPE_WORKGROUP);
        __syncthreads();
        if (F.tid < 32) WGH[tile * 32 + F.tid] = HIST[F.tid];
    }
}

__device__ __forceinline__ void phase_positions(const Frame& F0, int l) {
    const Frame F = opaque_frame(F0);
    unsigned char* ws = ws_of(F);
    const int* WGH = (const int*)(ws + WS_WGH); const int* TOPI = (const int*)(ws + WS_TOPI);
    int* POS = (int*)(ws + WS_POS); int* SORT = (int*)(ws + WS_SORT); int* ETAB = (int*)(ws + WS_ETAB);
    LAS int* PT = (LAS int*)F.lds;
    LAS int* PB = PT + 512;
    LAS int* CNT = PB + 512;
    LAS int* BASE = CNT + 32;
    LAS int* WC = BASE + 32;
    const int lane = F.lane;
    for (int tile = blockIdx.x; tile < NTILE128; tile += F.G) {
        __syncthreads();
        const int e = TOPI[(size_t)(tile * 128 + (F.tid >> 2)) * 4 + (F.tid & 3)];
        { const int eh = F.tid & 31, part = F.tid >> 5; int cv[16];
#pragma unroll
          for (int i = 0; i < 16; ++i) cv[i] = WGH[(part * 16 + i) * 32 + eh];
          int tot = 0, bef = 0;
#pragma unroll
          for (int i = 0; i < 16; ++i) { tot += cv[i]; bef += (part * 16 + i < tile) ? cv[i] : 0; }
          PT[part * 32 + eh] = tot; PB[part * 32 + eh] = bef; }
        __syncthreads();
        if (F.tid < 64) {
            const int ex = lane & 31; int tot = 0, bef = 0;
#pragma unroll
            for (int p = 0; p < 16; ++p) { tot += PT[p * 32 + ex]; bef += PB[p * 32 + ex]; }
            int incl = tot, tinc = (tot + 255) >> 8;
#pragma unroll
            for (int o = 1; o < 32; o <<= 1) { const int a = __shfl_up(incl, o), b2 = __shfl_up(tinc, o); if ((lane & 31) >= o) { incl += a; tinc += b2; } }
            const int off = incl - tot, ts = tinc - ((tot + 255) >> 8);
            if (lane < 32) { BASE[ex] = bef + off;
                if (tile == 0) { ETAB[ex] = tot; ETAB[32 + ex] = off; ETAB[64 + ex] = ts; if (ex == 31) { ETAB[96] = tinc; ETAB[128 + l] = tinc; } } } }
        if (tile == 0 && F.tid < 256) SORT[NASG + F.tid] = 0;
        const int tok = tile * 128 + (F.tid >> 2), k = F.tid & 3;
        int rnk = 0, mycnt = 0;
#pragma unroll 1
        for (int E = 0; E < 32; ++E) { const unsigned long long m = __ballot(e == E); if (e == E) rnk = __popcll(m & ((1ull << lane) - 1ull)); if (lane == E) mycnt = __popcll(m); }
        if (lane < 32) WC[F.wave * 32 + lane] = mycnt;
        __syncthreads();
        int wo = 0;
        for (int w = 0; w < F.wave; ++w) wo += WC[w * 32 + e];
        const int pos = BASE[e] + wo + rnk;
        SORT[pos] = tok; POS[(size_t)tok * 4 + k] = pos;
    }
}

__device__ __forceinline__ void phase_loadtab(const Frame& F0) {
    const Frame F = opaque_frame(F0);
    unsigned char* ws = ws_of(F);
    LAS int* tab = (LAS int*)(F.lds + TAB_OFF);
    __syncthreads();
    if (F.tid < 97) tab[F.tid] = ((const int*)(ws + WS_ETAB))[F.tid];
    __syncthreads();
}

struct CbRows { u32x2 y[2][4]; u32x4 h[2]; };
__device__ __forceinline__ void cb_load(CbRows& R, const unsigned char* Y, const bf16* H1, int t, const i32x4& pp, int lane) {
#pragma unroll
    for (int j = 0; j < 2; ++j) { const int c = 8 * lane + 512 * j;
        R.y[j][0] = *(const u32x2*)(Y + (size_t)pp[0] * D + c); R.y[j][1] = *(const u32x2*)(Y + (size_t)pp[1] * D + c); R.y[j][2] = *(const u32x2*)(Y + (size_t)pp[2] * D + c); R.y[j][3] = *(const u32x2*)(Y + (size_t)pp[3] * D + c);
        R.h[j] = *(const u32x4*)(H1 + (size_t)t * D + c); }
}
__device__ __forceinline__ void phase_combine(const Frame& F0, int l) {
    const Frame F = opaque_frame(F0);
    const int gw = F.vcu * NWAVES + F.wave, NGW = F.G * NWAVES;
    unsigned char* ws = ws_of(F);
    const float* in_n1g = inp(F, IN_N1G) + (l + 1 < DEPTH ? (l + 1) * D : 0); const float* in_fg = inp(F, IN_FG); float* outp = (float*)inp(F, IN_OUT);
    const bf16* H1 = (const bf16*)(ws + WS_HB1); bf16* H2 = (bf16*)(ws + WS_HB2); const unsigned char* Y = (const unsigned char*)(ws + WS_Y);
    const int* POS = (const int*)(ws + WS_POS); const float* TOPG = (const float*)(ws + WS_TOPG);
    const float* MOD = (const float*)(ws + WS_MOD); bf16* AIN = (bf16*)(ws + WS_AIN);
    const int lane = F.lane;
    CbRows RA, RB; i32x4 pq[3]; f32x4 gq[4];
#define CB_ROUTE(tt, P, G) do { if ((tt) < NTOK) { P = *(const i32x4*)(POS + (size_t)(tt) * 4); G = *(const f32x4*)(TOPG + (size_t)(tt) * 4); } else { P = (i32x4){0, 0, 0, 0}; G = (f32x4){0.f, 0.f, 0.f, 0.f}; } } while (0)
    { i32x4 p0, p1; CB_ROUTE(gw, p0, gq[0]); CB_ROUTE(gw + NGW, p1, gq[1]); CB_ROUTE(gw + 2 * NGW, pq[0], gq[2]);
      if (gw < NTOK) cb_load(RA, Y, H1, gw, p0, lane);
      if (gw + NGW < NTOK) cb_load(RB, Y, H1, gw + NGW, p1, lane); }
#define CB_STEP(R, t) do { \
        const int b = (t) / SEQ; const float* g2 = MOD + ((size_t)l * BATCH + b) * 6144 + 5 * 1024; \
        const f32x4 gc = gq[0] * (1.0f / F8_YSCALE); \
        float v[2][8]; \
        _Pragma("unroll") for (int j = 0; j < 2; ++j) { const int c = 8 * lane + 512 * j; \
            f32x4 h0, h1; pg8::unpack8(R.h[j], h0, h1); \
            const f32x4 ga = *(const f32x4*)(g2 + c), gb = *(const f32x4*)(g2 + c + 4); \
            float a0[8], a1[8], a2[8], a3[8]; \
            unpk4_fp8(R.y[j][0].x, a0[0], a0[1], a0[2], a0[3]); unpk4_fp8(R.y[j][0].y, a0[4], a0[5], a0[6], a0[7]); \
            unpk4_fp8(R.y[j][1].x, a1[0], a1[1], a1[2], a1[3]); unpk4_fp8(R.y[j][1].y, a1[4], a1[5], a1[6], a1[7]); \
            unpk4_fp8(R.y[j][2].x, a2[0], a2[1], a2[2], a2[3]); unpk4_fp8(R.y[j][2].y, a2[4], a2[5], a2[6], a2[7]); \
            unpk4_fp8(R.y[j][3].x, a3[0], a3[1], a3[2], a3[3]); unpk4_fp8(R.y[j][3].y, a3[4], a3[5], a3[6], a3[7]); \
            _Pragma("unroll") for (int e = 0; e < 8; ++e) { const float sm = gc[0] * a0[e] + gc[1] * a1[e] + gc[2] * a2[e] + gc[3] * a3[e]; \
                v[j][e] = (e < 4 ? h0[e] : h1[e - 4]) + (e < 4 ? ga[e] : gb[e - 4]) * sm; } } \
          \
        { const int t2 = (t) + 2 * NGW; if (t2 < NTOK) cb_load(R, Y, H1, t2, pq[0], lane); \
          gq[0] = gq[1]; gq[1] = gq[2]; CB_ROUTE((t) + 3 * NGW, pq[0], gq[2]); } \
        float sq = 0.f; \
        _Pragma("unroll") for (int j = 0; j < 2; ++j) _Pragma("unroll") for (int e = 0; e < 8; ++e) sq += v[j][e] * v[j][e]; \
        const float rstd = 1.0f / sqrtf(wave_sum(sq) * (1.0f / D) + RMS_EPS); \
        if (l + 1 < DEPTH) { \
            const float* mp = MOD + ((size_t)(l + 1) * BATCH + b) * 6144; \
            _Pragma("unroll") for (int j = 0; j < 2; ++j) { const int c = 8 * lane + 512 * j; \
                u32x4 hw; hw.x = pk2(v[j][0], v[j][1]); hw.y = pk2(v[j][2], v[j][3]); hw.z = pk2(v[j][4], v[j][5]); hw.w = pk2(v[j][6], v[j][7]); \
                *(u32x4*)(H2 + (size_t)(t) * D + c) = hw; \
                float y[8]; \
                _Pragma("unroll") for (int q = 0; q < 2; ++q) { const f32x4 gv = *(const f32x4*)(in_n1g + c + 4 * q), sv = *(const f32x4*)(mp + 1024 + c + 4 * q), hx = *(const f32x4*)(mp + c + 4 * q); \
                    _Pragma("unroll") for (int e = 0; e < 4; ++e) y[4 * q + e] = v[j][4 * q + e] * rstd * gv[e] * (sv[e] + 1.0f) + hx[e]; } \
                if (MK_P2F8) { u32x2 aw; aw.x = pk4_fp8(y[0] * F8_XSCALE, y[1] * F8_XSCALE, y[2] * F8_XSCALE, y[3] * F8_XSCALE); aw.y = pk4_fp8(y[4] * F8_XSCALE, y[5] * F8_XSCALE, y[6] * F8_XSCALE, y[7] * F8_XSCALE); \
                    *(u32x2*)((unsigned char*)AIN + (size_t)(t) * D + c) = aw; } \
                else { u32x4 aw; aw.x = pk2(y[0], y[1]); aw.y = pk2(y[2], y[3]); aw.z = pk2(y[4], y[5]); aw.w = pk2(y[6], y[7]); \
                    *(u32x4*)(AIN + (size_t)(t) * D + c) = aw; } } \
        } else { \
            _Pragma("unroll") for (int j = 0; j < 2; ++j) { const int c = 8 * lane + 512 * j; \
                _Pragma("unroll") for (int q = 0; q < 2; ++q) { const f32x4 gv = *(const f32x4*)(in_fg + c + 4 * q); f32x4 o; \
                    _Pragma("unroll") for (int e = 0; e < 4; ++e) o[e] = v[j][4 * q + e] * rstd * gv[e]; \
                    *(f32x4*)(outp + (size_t)(t) * D + c + 4 * q) = o; } } \
        } } while (0)
    for (int t = gw; t < NTOK; t += 2 * NGW) {
        CB_STEP(RA, t);
        if (t + NGW < NTOK) CB_STEP(RB, t + NGW);
    }
#undef CB_STEP
#undef CB_ROUTE
}

constexpr int PH_PR0 = 0, PH_PR1 = 1, PH_L0 = 2, PH_PER_LAYER = 10, PH_TOTAL = PH_L0 + DEPTH * PH_PER_LAYER;

template <int VARK> __global__ void __launch_bounds__(NTHR, 2) mk_fwd_t(Args args) {
    extern __shared__ __attribute__((aligned(16))) unsigned char lds_raw[];
    Frame F;
    F.lds = (LAS unsigned char*)lds_raw;
    F.MISC = (volatile LAS unsigned*)(F.lds + MISC_OFF);
    F.tid = threadIdx.x; F.lane = F.tid & 63; F.wave = __builtin_amdgcn_readfirstlane(F.tid >> 6);
    F.G = gridDim.x; { const int bx = blockIdx.x; F.vcu = (F.G % 8 == 0) ? (bx % 8) * (F.G / 8) + bx / 8 : bx; }
    F.ws_ = args.ws; F.ctl = (gu32*)(args.ws + WS_CTL);
    for (int u = F.tid; u < (LDS_BYTES - MISC_OFF) / 4; u += NTHR) ((LAS unsigned*)(F.lds + MISC_OFF))[u] = 0u;
    __syncthreads();
    if (F.tid == 0) {
        LAS unsigned long long* pt = (LAS unsigned long long*)(F.lds + MISC_OFF + 64);
#define PT_(i) pt[i] = (unsigned long long)args.in[i]
        PT_(0); PT_(1); PT_(2); PT_(3); PT_(4); PT_(5); PT_(6); PT_(7); PT_(8); PT_(9); PT_(10); PT_(11); PT_(12); PT_(13); PT_(14); PT_(15); PT_(16); PT_(17); PT_(18); PT_(19); PT_(20); PT_(21);
#undef PT_
        pt[IN_POS] = (unsigned long long)args.positions; pt[IN_OUT] = (unsigned long long)args.out;
    }
    __syncthreads();
    XcdBarrier bar; bar.bar = (unsigned*)(F.ctl + CW_BAR); bar.x = 0; bar.st = nullptr;
#if !MK_PER_PHASE
    bar = xcd_barrier_post((unsigned*)(F.ctl + CW_BAR), F.MISC + 8);
#endif
    const int lo = args.ph_lo, hi = args.ph_hi;
    constexpr int VAR = VARK;
#ifndef MK_EN
#define MK_EN 0x1FFF
#endif
#ifndef MK_VAR_EN
#define MK_VAR_EN 0x1FFF
#endif
#define EN(j) (VARK ? (((MK_VAR_EN) >> (j)) & 1) : (((MK_EN) >> (j)) & 1))
#ifndef MK_REP
#define MK_REP 0
#endif
#define RP(j) _Pragma("unroll 1") for (int rr_ = 0; rr_ <= (((MK_REP) >> (j)) & 1) * MK_REPN; ++rr_)
#ifndef MK_REPN
#define MK_REPN 1
#endif
#define IN(k) (lo <= (k) && (k) < hi)
#if MK_PER_PHASE
#define SEAM(k) do { } while (0)
#else
#define SEAM(k) do { if (IN(k) && IN((k) + 1)) xcd_barrier(bar); } while (0)
#endif
    if (EN(0) && IN(PH_PR0)) RP(0) { phase_pr0(F); } SEAM(PH_PR0);
    if (EN(1) && IN(PH_PR1)) RP(1) { phase_pr1(F); } SEAM(PH_PR1);
#define LAYER_BODY(l) do { \
        const int P = PH_L0 + l * PH_PER_LAYER; \
        if (EN(2) && IN(P + 0)) RP(2) { unsigned char* ws = ws_of(F); \
            pg8::PlainSched S; S.T.init(NTOK / 256, INW / 256, F.G, (int)blockIdx.x); S.A = (const char*)(ws + WS_AIN); S.B = (const char*)(ws + WS_WTIN) + (size_t)l * INW * D * (MK_P2F8 ? 1 : 2); S.K = MK_P2F8 ? D / 2 : D; \
            pg8::EpiIn E{(bf16*)(ws + WS_QB), (bf16*)(ws + WS_KB), (bf16*)(ws + WS_VB), (bf16*)(ws + WS_UB), (bf16*)(ws + WS_VGB), (bf16*)(ws + WS_GB), (const float*)(ws + WS_ROPEC), (const float*)(ws + WS_ROPES)}; \
            pg8::gemm_phase<pg8::EpiIn, pg8::PlainSched, false, MK_P2F8 != 0>(F.lds, MK_P2F8 ? D / 2 : D, S, E, nullptr, nullptr, VAR); \
            if (MK_TAILCVT) cvt_tail(F, l == 0 ? 0 : 3, (NTOK / 256) * (INW / 256)); \
        } \
        SEAM(P + 0); \
        if (EN(3) && IN(P + 1)) RP(3) { phase_attn(F); } \
        SEAM(P + 1); \
        if (EN(4) && IN(P + 2)) RP(4) { phase_gmlp(F, l); } \
        if (EN(5) && IN(P + 2)) RP(5) { phase_merge(F); } \
        SEAM(P + 2); \
        if (EN(6) && IN(P + 3)) RP(6) { unsigned char* ws = ws_of(F); \
            pg8::PlainSched S; S.T.init(NTOK / 256, D / 256, F.G, (int)blockIdx.x); S.A = (const char*)(ws + WS_ATT); S.B = (const char*)(ws + WS_WTPA) + (size_t)l * D * AW * 2; S.K = AW; \
            pg8::EpiMrg E{(const bf16*)(ws + WS_GB), (bf16*)(ws + WS_MRG)}; \
            pg8::gemm_phase<pg8::EpiMrg, pg8::PlainSched, false, false, AO / 64>(F.lds, AW, S, E, nullptr, nullptr, VAR); \
        } \
        SEAM(P + 3); \
        if (EN(7) && IN(P + 4)) RP(7) { unsigned char* ws = ws_of(F); const float* MODl = (const float*)(ws + WS_MOD) + (size_t)l * BATCH * 6144; \
            pg8::PlainSched S; S.T.init(NTOK / 256, D / 256, F.G, (int)blockIdx.x); S.A = (const char*)(ws + WS_MRG); S.B = (const char*)(ws + WS_WTO) + (size_t)l * D * D * 2; S.K = D; \
            pg8::EpiRes E{inp(F, IN_X), l == 0 ? (const bf16*)nullptr : (const bf16*)(ws + WS_HB2), (bf16*)(ws + WS_HB1), MODl + 2 * 1024}; \
            pg8::gemm_phase<pg8::EpiRes, pg8::PlainSched, false>(F.lds, D, S, E, nullptr, nullptr, VAR); \
        } \
        SEAM(P + 4); \
        if (EN(8) && IN(P + 5)) RP(8) { phase_router(F, l); } \
        SEAM(P + 5); \
        if (EN(9) && IN(P + 6)) RP(9) { phase_positions(F, l); } \
        if (MK_TAILCVT && l == 1 && IN(P + 6)) cvt_tail(F, 4, 0);         \
        SEAM(P + 6); \
        if (IN(P + 7) || IN(P + 8)) phase_loadtab(F); \
        if (EN(10) && IN(P + 7)) RP(10) { unsigned char* ws = ws_of(F); \
            LAS int* tab = (LAS int*)(F.lds + TAB_OFF); \
            pg8::MoeSched S; S.T.init(tab[96], 2048 / 256, F.G, (int)blockIdx.x); S.A = (const char*)(ws + WS_AIN); S.B = (const char*)(ws + WS_W1T) + (size_t)l * NE * 2048 * D; S.K = D / 2; S.bstride = (size_t)2048 * D; S.tab = tab; S.gather = true; \
            pg8::EpiSwiglu E{(const float*)(ws + WS_B1P) + (size_t)l * NE * 2048, (unsigned char*)(ws + WS_ACT)}; \
            pg8::gemm_phase<pg8::EpiSwiglu, pg8::MoeSched, true, true>(F.lds, D / 2, S, E, (const int*)(ws + WS_SORT), (LAS int*)(F.lds + IDX_OFF), VAR); \
            if (MK_TAILCVT && l == 0) cvt_tail(F, 1, tab[96] * (2048 / 256)); \
        } \
        SEAM(P + 7); \
        if (EN(11) && IN(P + 8)) RP(11) { unsigned char* ws = ws_of(F); \
            LAS int* tab = (LAS int*)(F.lds + TAB_OFF); \
            pg8::MoeSched S; S.T.init(tab[96], D / 256, F.G, (int)blockIdx.x); S.A = (const char*)(ws + WS_ACT); S.B = (const char*)(ws + WS_W2T) + (size_t)l * NE * D * DFF; S.K = DFF / 2; S.bstride = (size_t)D * DFF; S.tab = tab; S.gather = false; \
            pg8::EpiY E{inp(F, IN_B2) + (size_t)l * NE * D, (unsigned char*)(ws + WS_Y)}; \
            pg8::gemm_phase<pg8::EpiY, pg8::MoeSched, false, true>(F.lds, DFF / 2, S, E, nullptr, nullptr, VAR); \
            if (MK_TAILCVT && l == 0) cvt_tail(F, 2, tab[96] * (D / 256)); \
        } \
        SEAM(P + 8); \
        if (EN(12) && IN(P + 9)) RP(12) { phase_combine(F, l); } \
        if (l + 1 < DEPTH) SEAM(P + 9); \
    } while (0)
    LAYER_BODY(0);
    LAYER_BODY(1);
#undef LAYER_BODY
#undef IN
#undef SEAM
}

#define mk_fwd mk_fwd_t<0>
extern "C" void kernel_launch(void* const* d_in, const int* in_sizes, int n_in, void* d_out, int out_size, void* d_ws, size_t ws_size, hipStream_t stream) {
    static int grid = 0;
    if (grid == 0) {
        if (n_in != 22 || in_sizes[0] != NTOK * D || out_size != NTOK * D || ws_size < WS_END) { fprintf(stderr, "kernel_launch: unexpected shapes (n_in %d, in0 %d, out %d, ws %zu)\n", n_in, n_in > 0 ? in_sizes[0] : -1, out_size, ws_size); grid = -1; return; }
        int dev = 0, cus = 0, per_cu = 0;
        if (hipGetDevice(&dev) != hipSuccess || hipDeviceGetAttribute(&cus, hipDeviceAttributeMultiprocessorCount, dev) != hipSuccess) { grid = -1; return; }
#ifdef MK_VARIANT
        (void)hipFuncSetAttribute((const void*)mk_fwd_t<MK_VARIANT>, hipFuncAttributeMaxDynamicSharedMemorySize, LDS_BYTES);
#endif
        if (hipFuncSetAttribute((const void*)mk_fwd, hipFuncAttributeMaxDynamicSharedMemorySize, LDS_BYTES) != hipSuccess) { fprintf(stderr, "kernel_launch: hipFuncSetAttribute failed\n"); grid = -1; return; }
        if (hipOccupancyMaxActiveBlocksPerMultiprocessor(&per_cu, (const void*)mk_fwd, NTHR, LDS_BYTES) != hipSuccess || per_cu < 1) fprintf(stderr, "kernel_launch: occupancy query reports %d\n", per_cu);
        (void)hipGetLastError();
        grid = cus;
    }
    if (grid < 0) return;
    if (hipMemsetAsync((char*)d_ws + WS_CTL, 0, CTL_ZERO_BYTES, stream) != hipSuccess) return;
    Args a{};
    for (int i = 0; i < 22; ++i) a.in[i] = (const float*)d_in[i];
    a.positions = (const int*)d_in[IN_POS]; a.out = (float*)d_out; a.ws = (unsigned char*)d_ws;
#if MK_PER_PHASE
    for (int p = 0; p < PH_TOTAL; ++p) { a.ph_lo = p; a.ph_hi = p + 1; hipLaunchKernelGGL(mk_fwd, dim3(grid), dim3(NTHR), LDS_BYTES, stream, a);
#ifdef MK_HREP
        { const int ty = p < 2 ? p : 2 + (p - 2) % PH_PER_LAYER; if (ty == MK_HREP) {

#ifdef MK_VARIANT
            hipLaunchKernelGGL(mk_fwd_t<MK_VARIANT>, dim3(grid), dim3(NTHR), LDS_BYTES, stream, a);
#else
            hipLaunchKernelGGL(mk_fwd, dim3(grid), dim3(NTHR), LDS_BYTES, stream, a);
#endif
        } }
#endif
    }
#else
    a.ph_lo = 0; a.ph_hi = PH_TOTAL; hipLaunchKernelGGL(mk_fwd, dim3(grid), dim3(NTHR), LDS_BYTES, stream, a);
#endif
}
```

```cpp
#include <hip/hip_runtime.h>
#include <cstdio>
#include <cstdint>

#ifndef MK_PER_PHASE
#define MK_PER_PHASE 0
#endif
#ifndef MK_RELAX
#define MK_TAILIPW 3
#define MK_TAILIPW_P9 2
#define MK_TAILCVT 1
#define MK_RELAX 1
#endif
#ifndef MK_F8SCALED
#define MK_F8SCALED 1
#endif
#ifndef MK_CHECKS
#define MK_CHECKS 0
#endif

constexpr int D = 1024, BATCH = 8, SEQ = 4096, NTOK = BATCH * SEQ, DEPTH = 2;
constexpr int AW = 768, AO = 256, GW = 512, INW = 5376, NE = 32, TOPK = 4, NASG = NTOK * TOPK, DFF = 1024;
constexpr float RMS_EPS = 1e-5f, LN_EPS = 1e-5f;
constexpr int NWAVES = 8, NTHR = 512;
constexpr int NTILE128 = NTOK / 128;
constexpr float LOG2E = 1.4426950408889634f, LN2 = 0.6931471805599453f;
constexpr float QSCALE = 0.125f * LOG2E;
constexpr float F8_WSCALE = 64.0f, F8_XSCALE = 4.0f, F8_YSCALE = 8.0f;
constexpr int F8_WS_E8M0 = 0x79797979, F8_XS_E8M0 = 0x7d7d7d7d;

constexpr size_t MiB = 1u << 20;
constexpr size_t WS_CTL = 0, CTL_ZERO_BYTES = 1 * MiB;
constexpr size_t WS_MOD = 1 * MiB;
constexpr size_t WS_ROPEC = 2 * MiB;
constexpr size_t WS_ROPES = 6 * MiB;
constexpr size_t WS_WRH = 10 * MiB;
constexpr size_t WS_WRL = 10 * MiB + 512 * 1024;
constexpr size_t WS_WSB = 11 * MiB;
constexpr size_t WS_B1P = 12 * MiB;
constexpr size_t WS_WTIN = 13 * MiB;
constexpr size_t WS_WTPA = 34 * MiB;
constexpr size_t WS_WTPG = 35 * MiB;
constexpr size_t WS_WTO = 37 * MiB;
constexpr size_t WS_W1T = 41 * MiB;
constexpr size_t WS_W2T = 297 * MiB;
constexpr size_t WS_HB1 = 425 * MiB;
constexpr size_t WS_HB2 = 553 * MiB;
constexpr size_t WS_AIN = 681 * MiB;
constexpr size_t WS_QB = 745 * MiB, WS_KB = 793 * MiB, WS_VB = 841 * MiB;
constexpr size_t WS_UB = 889 * MiB, WS_VGB = 921 * MiB;
constexpr size_t WS_GB = 953 * MiB;
constexpr size_t WS_OG = 1081 * MiB;
constexpr size_t WS_LSE = 1129 * MiB;
constexpr size_t WS_ATT = 1131 * MiB;
constexpr size_t WS_GM = 1147 * MiB;
constexpr size_t WS_TMP = 1179 * MiB;
constexpr size_t WS_MRG = 1243 * MiB;
constexpr size_t WS_TOPI = 1307 * MiB;
constexpr size_t WS_TOPG = 1307 * MiB + 512 * 1024;
constexpr size_t WS_POS = 1308 * MiB;
constexpr size_t WS_WGH = 1308 * MiB + 512 * 1024;
constexpr size_t WS_ETAB = 1308 * MiB + 640 * 1024;
constexpr size_t WS_SORT = 1309 * MiB;
constexpr size_t WS_ACT = 1310 * MiB;
constexpr size_t WS_Y = 1567 * MiB;
constexpr size_t WS_END = 1824 * MiB;
static_assert(WS_ACT + (size_t)(NASG + 256) * 1024 * 2 <= WS_Y && WS_Y + (size_t)(NASG + 256) * 1024 * 2 <= WS_END, "ws map");

constexpr int CW_TMO = 0, CW_CODE = 1, CW_BAR = 4096, CW_ERR = 16384;

constexpr int RING_BYTES = 131072;
constexpr int BIAS_OFF = 131072;
constexpr int IDX_OFF = 139264;
constexpr int TAB_OFF = 141312;
constexpr int MISC_OFF = 141824;
constexpr int LDS_BYTES = 147456;

#define GAS __attribute__((address_space(1)))
#define LAS __attribute__((address_space(3)))
typedef unsigned short bf16;
typedef float f32x2 __attribute__((ext_vector_type(2)));
typedef float f32x4 __attribute__((ext_vector_type(4)));
typedef float f32x16 __attribute__((ext_vector_type(16)));
typedef short bf16x8 __attribute__((ext_vector_type(8)));
typedef short s16x4 __attribute__((ext_vector_type(4)));
typedef unsigned u32x2 __attribute__((ext_vector_type(2)));
typedef unsigned u32x4 __attribute__((ext_vector_type(4)));
typedef int i32x4 __attribute__((ext_vector_type(4)));
typedef __bf16 bf16x2_t __attribute__((ext_vector_type(2)));
typedef GAS unsigned gu32;
#define RLX_AGENT __ATOMIC_RELAXED, __HIP_MEMORY_SCOPE_AGENT
#define LDS_WAIT() asm volatile("s_waitcnt lgkmcnt(0)" ::: "memory")
#define VM_WAIT() asm volatile("s_waitcnt vmcnt(0)" ::: "memory")

__device__ __forceinline__ unsigned pk2(float lo, float hi) { f32x2 v = {lo, hi}; bf16x2_t b = __builtin_convertvector(v, bf16x2_t); return __builtin_bit_cast(unsigned, b); }
__device__ __forceinline__ float clamp448(float x) { return fminf(fmaxf(x, -448.0f), 448.0f); }
__device__ __forceinline__ unsigned pk4_fp8(float a, float b, float c, float d) {
    unsigned t = 0; t = __builtin_amdgcn_cvt_pk_fp8_f32(clamp448(a), clamp448(b), t, false); t = __builtin_amdgcn_cvt_pk_fp8_f32(clamp448(c), clamp448(d), t, true); return t; }
__device__ __forceinline__ unsigned pk4_fp8_nc(float a, float b, float c, float d) {
    unsigned t = 0; t = __builtin_amdgcn_cvt_pk_fp8_f32(a, b, t, false); t = __builtin_amdgcn_cvt_pk_fp8_f32(c, d, t, true); return t; }
__device__ __forceinline__ void unpk4_fp8(unsigned w, float& a, float& b, float& c, float& d) { const f32x2 lo = __builtin_amdgcn_cvt_pk_f32_fp8((int)w, false), hi = __builtin_amdgcn_cvt_pk_f32_fp8((int)w, true); a = lo[0]; b = lo[1]; c = hi[0]; d = hi[1]; }
__device__ __forceinline__ void unpk8_fp8(u32x2 w, f32x4& a, f32x4& b) { const f32x2 p0 = __builtin_amdgcn_cvt_pk_f32_fp8((int)w.x, false), p1 = __builtin_amdgcn_cvt_pk_f32_fp8((int)w.x, true), p2 = __builtin_amdgcn_cvt_pk_f32_fp8((int)w.y, false), p3 = __builtin_amdgcn_cvt_pk_f32_fp8((int)w.y, true);
    a = (f32x4){p0[0], p0[1], p1[0], p1[1]}; b = (f32x4){p2[0], p2[1], p3[0], p3[1]}; }
__device__ __forceinline__ float bf_lo(unsigned w) { return __uint_as_float(w << 16); }
__device__ __forceinline__ float bf_hi(unsigned w) { return __uint_as_float(w & 0xffff0000u); }
__device__ __forceinline__ float bf2f(bf16 b) { return __uint_as_float(((unsigned)b) << 16); }
__device__ __forceinline__ float wave_sum(float v) {
#pragma unroll
    for (int o = 1; o < 64; o <<= 1) v += __shfl_xor(v, o);
    return v;
}
__device__ __forceinline__ float fast_exp2(float x) { return __builtin_amdgcn_exp2f(x); }
__device__ __forceinline__ float fast_rcp(float x) { return __builtin_amdgcn_rcpf(x); }
__device__ __forceinline__ float sigmoidf_(float x) { return fast_rcp(1.0f + fast_exp2(-LOG2E * x)); }
__device__ __forceinline__ float gelu_tanh(float x) {
    const float u = x + 0.044715f * x * x * x;
    return x * fast_rcp(1.0f + fast_exp2(-2.0f * 0.7978845608028654f * LOG2E * u));
}

__device__ __forceinline__ void glds16(unsigned long long sbase, unsigned voff, unsigned ldsaddr) {
    unsigned keep; asm volatile("s_mov_b32 %0, m0\n\ts_mov_b32 m0, %3\n\ts_nop 0\n\tglobal_load_lds_dwordx4 %1, %2\n\ts_mov_b32 m0, %0" : "=&s"(keep) : "v"(voff), "s"(sbase), "s"(ldsaddr) : "memory");
}

#define XB_TMO      128
#define XB_XCNT(j)  (256  + 64 * (j))
#define XB_XSUB(j)  (1280 + 64 * (j))
#define XB_XGEN(j)  (2304 + 64 * (j))
#define XB_TOP      3328
#define XB_TOPGEN   3392
#define XCD_BAR_WORDS 3456
#define XB_SPIN_CAP (1u << 18)
__device__ __forceinline__ unsigned xb_ld(unsigned* p)              { return __hip_atomic_load(p, __ATOMIC_RELAXED, __HIP_MEMORY_SCOPE_AGENT); }
__device__ __forceinline__ unsigned xb_add(unsigned* p, unsigned v) { return __hip_atomic_fetch_add(p, v, __ATOMIC_RELAXED, __HIP_MEMORY_SCOPE_AGENT); }
__device__ __forceinline__ unsigned xb_xcc_id() { return (unsigned)__builtin_amdgcn_s_getreg((3 << 11) | 20) & 0xFu; }
#define XB_SPIN(cond, bar) do { unsigned _sp = 0; while (cond) { __builtin_amdgcn_s_sleep(1); \
    if ((++_sp & 255u) == 0u) { if (xb_ld(&(bar)[XB_TMO])) break; if (_sp > XB_SPIN_CAP) { atomicAdd(&(bar)[XB_TMO], 1u); break; } } } } while (0)
struct XcdBarrier { unsigned* bar; unsigned x; volatile LAS unsigned* st; };
__device__ __forceinline__ XcdBarrier xcd_barrier_post(unsigned* bar, volatile LAS unsigned* st) {
    XcdBarrier b; b.bar = bar; b.x = xb_xcc_id(); b.st = st;
    if (threadIdx.x == 0) (void)xb_add(&bar[XB_XCNT(b.x)], 1u);
    return b;
}
__device__ __forceinline__ void xcd_barrier_complete(unsigned* bar, unsigned x, unsigned& nloc, unsigned& nx) {
    const unsigned G = gridDim.x * gridDim.y * gridDim.z;
    unsigned sum, cnt, mine, sp = 0u;
    for (;;) {
        sum = 0u; cnt = 0u; mine = 0u;
#pragma unroll
        for (unsigned j = 0; j < 16; ++j) { const unsigned c = xb_ld(&bar[XB_XCNT(j)]); sum += c; cnt += (c > 0u) ? 1u : 0u; mine = (j == x) ? c : mine; }
        if (sum == G) break;
        __builtin_amdgcn_s_sleep(1);
        if ((++sp & 255u) == 0u) { if (xb_ld(&bar[XB_TMO])) break; if (sp > XB_SPIN_CAP) { atomicAdd(&bar[XB_TMO], 1u); break; } }
    }
    nloc = mine > 0u ? mine : 1u; nx = cnt > 0u ? cnt : 1u;
}
__device__ __forceinline__ void xcd_barrier(const XcdBarrier& b) {
    asm volatile("s_waitcnt vmcnt(0)" ::: "memory");
    __syncthreads();
    if (threadIdx.x == 0) {
        unsigned* bar = b.bar;
        __builtin_amdgcn_s_waitcnt(0);
        unsigned nloc = b.st[0], nx = b.st[1];
        if (nloc == 0u) { xcd_barrier_complete(bar, b.x, nloc, nx); b.st[0] = nloc; b.st[1] = nx; }
        const unsigned old = xb_add(&bar[XB_XSUB(b.x)], 1u);
        const unsigned gen = old / nloc;
        if (old + 1u == (gen + 1u) * nloc) {
            __builtin_amdgcn_fence(__ATOMIC_RELEASE, "agent");
            asm volatile("s_waitcnt vmcnt(0)" ::: "memory");
            const unsigned og = xb_add(&bar[XB_TOP], 1u);
            const unsigned tg = og / nx;
            if (og + 1u == (tg + 1u) * nx) {
#pragma unroll
                for (unsigned j = 0; j < 16; ++j) (void)__hip_atomic_fetch_add(&bar[XB_XGEN(j)], 1u, __ATOMIC_RELAXED, __HIP_MEMORY_SCOPE_AGENT);
            }
            XB_SPIN(xb_ld(&bar[XB_XGEN(b.x)]) == gen, bar);
            __builtin_amdgcn_fence(__ATOMIC_ACQUIRE, "agent");
            asm volatile("s_waitcnt vmcnt(0)" ::: "memory");
        } else {
            XB_SPIN(xb_ld(&bar[XB_XGEN(b.x)]) == gen, bar);
            __builtin_amdgcn_fence(__ATOMIC_ACQUIRE, "agent");
            asm volatile("s_waitcnt vmcnt(0)" ::: "memory");
        }
    }
    __syncthreads();
}

namespace pg8 {
constexpr int BM = 256, BK = 64, HALF = 128, HTB = HALF * BK * 2, STAGE_BYTES = 8 * HTB, NXCD = 8, WGM = 8;
__host__ __device__ __forceinline__ int lds_byte(int r, int c) { const int st = (r >> 4) * 2 + (c >> 5), rr = r & 15, cc = c & 31, ob = rr * 64 + cc * 2; return st * 1024 + (ob ^ (((ob >> 9) & 1) << 5)); }
__host__ __device__ __forceinline__ void stage_rc(int b, int& R, int& C) { const int st = b / 1024, sb = b % 1024, swz = sb ^ (((sb >> 9) & 1) << 5); R = (st >> 1) * 16 + swz / 64; C = (st & 1) * 32 + (swz % 64) / 2; }
__host__ __device__ __forceinline__ int perm32(int rho) { const int n = rho >> 4, i = rho & 15; return 8 * (i >> 2) + 4 * n + (i & 3); }

struct Unit { int pm, pn; const char* A; const char* B; int e, rows, row0; };

struct TileOrder {
    int nM, nN, nwg, G, c;
    __device__ __forceinline__ void init(int nM_, int nN_, int G_, int c_) { nM = nM_; nN = nN_; nwg = nM * nN; G = G_; c = c_; }
    __device__ __forceinline__ bool tile(int i, int& pm, int& pn) const {
        const long L = (long)i * G + c; if (L >= nwg) return false;
        int wgid = (int)L; { const int q = nwg / NXCD, r = nwg % NXCD, xcd = wgid % NXCD, off = wgid / NXCD; wgid = (xcd < r ? xcd * (q + 1) : r * (q + 1) + (xcd - r) * q) + off; }
        const int nig = WGM * nN, gid = wgid / nig, fm = gid * WGM, gsz = (nM - fm) < WGM ? (nM - fm) : WGM;
        pm = fm + ((wgid % nig) % gsz); pn = (wgid % nig) / gsz; return true;
    }
};
struct PlainSched {
    TileOrder T; const char* A; const char* B; int K;
    __device__ __forceinline__ bool next(int i, Unit& u) const {
        if (!T.tile(i, u.pm, u.pn)) return false;
        u.A = A + (size_t)u.pm * 256 * K * 2; u.B = B + (size_t)u.pn * 256 * K * 2; u.e = 0; u.rows = 256; u.row0 = u.pm * 256; return true;
    }
};
struct MoeSched {
    TileOrder T; const char* A; const char* B; int K; size_t bstride  ; const LAS int* tab; bool gather;
    __device__ __forceinline__ bool next(int i, Unit& u) const {
        int pmg;
        if (!T.tile(i, pmg, u.pn)) return false;
        const int lane = threadIdx.x & 63;
        const int ts = tab[64 + ((lane < 32) ? lane + 1 : 32)];
        const unsigned long long m = __ballot((lane < 32) && (ts <= pmg));
        const int e = __builtin_amdgcn_readfirstlane(__popcll(m));
        const int t = pmg - __builtin_amdgcn_readfirstlane(tab[64 + e]);
        const int cnt = __builtin_amdgcn_readfirstlane(tab[e]), off = __builtin_amdgcn_readfirstlane(tab[32 + e]);
        u.pm = pmg; u.e = e; u.row0 = off + 256 * t; u.rows = (cnt - 256 * t) < 256 ? (cnt - 256 * t) : 256;
        u.A = gather ? A : A + (size_t)u.row0 * K * 2;
        u.B = B + (size_t)e * bstride + (size_t)u.pn * 256 * K * 2;
        return true;
    }
};

typedef f32x4 Acc[2][2][4][2];

template <class Epi, class Sched, bool GATHER, bool F8 = false, int MIDK = 0>
__device__ __forceinline__ void gemm_phase(LAS unsigned char* lds, const int K, const Sched& S, const Epi& E, const int* gidx, LAS int* idxl, const int variant = 0) {
    int tid_ = threadIdx.x; asm volatile("" : "+v"(tid_));
    const int tid = tid_, wid = __builtin_amdgcn_readfirstlane(tid >> 6), lane = tid & 63, wr = wid >> 2, wc = wid & 3, fr = lane & 15, fq = lane >> 4;
    const int nt = K / BK;
    LAS unsigned char* const lds_top = lds;
    unsigned voffA[2], voffB[2];
#pragma unroll
    for (int i = 0; i < 2; ++i) { int R, C; stage_rc(tid * 16 + i * 8192, R, C); const int Rb = Epi::PERM ? ((R & ~31) + perm32(R & 31)) : R;
        voffA[i] = (unsigned)(R * K + C) * 2u; voffB[i] = (unsigned)(Rb * K + C) * 2u; }
    const size_t kstep = (size_t)(BK * 2);
    const size_t hstep = (size_t)HALF * K * 2;
    const unsigned ldsw = (unsigned)wid * 1024u;
    const int aoff = lds_byte(wr * 64 + fr, fq * 8), boff = lds_byte(wc * 32 + fr, fq * 8);
    unsigned vc00 = 0, vc01 = 0, vc10 = 0, vc11 = 0;
#define PG8_GOFF(ip, pre) do { int R0_, C0_, R1_, C1_; stage_rc(tid * 16, R0_, C0_); stage_rc(tid * 16 + 8192, R1_, C1_); \
        const int i00 = (ip)[R0_], i01 = (ip)[R1_], i10 = (ip)[128 + R0_], i11 = (ip)[128 + R1_]; \
        pre##00 = (unsigned)(i00 * K + C0_) * 2u; pre##01 = (unsigned)(i01 * K + C1_) * 2u; pre##10 = (unsigned)(i10 * K + C0_) * 2u; pre##11 = (unsigned)(i11 * K + C1_) * 2u; } while (0)
#define PG8_SA(b, h) (((b) * 2 + (h)) * HTB)
#define PG8_SB(b, h) ((4 + (b) * 2 + (h)) * HTB)
#define PG8_GL(sbase, voff32, dst) do { if (variant & 4) break; unsigned keep_; asm volatile("s_mov_b32 %0, m0\n\ts_mov_b32 m0, %3\n\ts_nop 0\n\tglobal_load_lds_dwordx4 %1, %2\n\ts_mov_b32 m0, %0" \
        : "=&s"(keep_) : "v"(voff32), "s"(sbase), "s"((unsigned)(__UINTPTR_TYPE__)(dst)) : "memory"); } while (0)
#define PG8_STAGE(bufoff, gbase, voff) do { const unsigned long long _b = (unsigned long long)(gbase); PG8_GL(_b, (voff)[0], lds + (bufoff) + ldsw); PG8_GL(_b, (voff)[1], lds + (bufoff) + ldsw + 8192); } while (0)
#define PG8_STAGE2(bufoff, gbase, v0, v1) do { const unsigned long long _b = (unsigned long long)(gbase); PG8_GL(_b, v0, lds + (bufoff) + ldsw); PG8_GL(_b, v1, lds + (bufoff) + ldsw + 8192); } while (0)
#define PG8_STAGE_A(bufoff, p, h, nx) do { if constexpr (GATHER) { if (h == 0) { if (nx) PG8_STAGE2(bufoff, p, u00, u01); else PG8_STAGE2(bufoff, p, vc00, vc01); } else { if (nx) PG8_STAGE2(bufoff, p, u10, u11); else PG8_STAGE2(bufoff, p, vc10, vc11); } } \
        else PG8_STAGE(bufoff, (p) + (h) * hstep, voffA); } while (0)
#define PG8_LDA(dst, b, h) do { _Pragma("unroll") for (int m = 0; m < 4; ++m) _Pragma("unroll") for (int k = 0; k < 2; ++k) dst[m][k] = *(const LAS bf16x8*)(lds + PG8_SA(b, h) + aoff + m * 2048 + k * 1024); } while (0)
#define PG8_LDB(dst, b, h) do { _Pragma("unroll") for (int n = 0; n < 2; ++n) _Pragma("unroll") for (int k = 0; k < 2; ++k) dst[n][k] = *(const LAS bf16x8*)(lds + PG8_SB(b, h) + boff + n * 2048 + k * 1024); } while (0)
#define PG8_CAT(x0, x1) __builtin_shufflevector(__builtin_bit_cast(i32x4, x0), __builtin_bit_cast(i32x4, x1), 0, 1, 2, 3, 4, 5, 6, 7)
#define PG8_MMA(ai, bj, At, Bt) do { if (variant & 2) break; __builtin_amdgcn_s_setprio(1); \
        if constexpr (F8) { _Pragma("unroll") for (int m = 0; m < 4; ++m) _Pragma("unroll") for (int n = 0; n < 2; ++n) \
            { if (MK_F8SCALED) asm volatile("v_mfma_scale_f32_16x16x128_f8f6f4 %0, %1, %2, %0, %3, %4 op_sel_hi:[0,0,0]" : "+v"(acc[ai][bj][m][n]) : "v"(PG8_CAT(Bt[n][0], Bt[n][1])), "v"(PG8_CAT(At[m][0], At[m][1])), "v"(sc_w), "v"(sc_x)); \
              else asm volatile("v_mfma_f32_16x16x128_f8f6f4 %0, %1, %2, %0" : "+v"(acc[ai][bj][m][n]) : "v"(PG8_CAT(Bt[n][0], Bt[n][1])), "v"(PG8_CAT(At[m][0], At[m][1]))); } } \
        else { _Pragma("unroll") for (int m = 0; m < 4; ++m) _Pragma("unroll") for (int n = 0; n < 2; ++n) _Pragma("unroll") for (int k = 0; k < 2; ++k) \
            asm volatile("v_mfma_f32_16x16x32_bf16 %0, %1, %2, %0" : "+v"(acc[ai][bj][m][n]) : "v"(Bt[n][k]), "v"(At[m][k])); } \
        __builtin_amdgcn_s_setprio(0); } while (0)
#define PG8_WAIT_V(n) asm volatile("s_waitcnt vmcnt(" #n ")" ::: "memory")
#define PG8_WAIT_VR() do { if (fae) asm volatile("s_waitcnt vmcnt(%0)" :: "n"(8 + Epi::NST) : "memory"); else PG8_WAIT_V(8); } while (0)
#define PG8_WAIT_L(n) asm volatile("s_waitcnt lgkmcnt(" #n ")" ::: "memory")
#define PG8_BAR __builtin_amdgcn_s_barrier()
#define PG8_SCHED __builtin_amdgcn_sched_barrier(0)
    const int sc_w = F8_WS_E8M0, sc_x = F8_XS_E8M0;
    Unit cur, nxt; int ui = 0;
    if (!S.next(0, cur)) return;
#if MK_SKEW > 0
    { const unsigned long long t0 = __builtin_amdgcn_s_memrealtime(), dl = (unsigned long long)(((blockIdx.x >> 3) & 3) * MK_SKEW);
      while (__builtin_amdgcn_s_memrealtime() - t0 < dl) __builtin_amdgcn_s_sleep(8); }
#endif
    Acc acc;
#pragma unroll
    for (int a = 0; a < 2; ++a)
#pragma unroll
        for (int b = 0; b < 2; ++b)
#pragma unroll
            for (int m = 0; m < 4; ++m)
#pragma unroll
                for (int n = 0; n < 2; ++n) acc[a][b][m][n] = (f32x4){0.f, 0.f, 0.f, 0.f};
    bf16x8 At[4][2], B0[2][2], B1[2][2];
    const char* cA = cur.A; const char* cB = cur.B;
    if constexpr (GATHER) {
        const int* gp_ = gidx + cur.row0; PG8_GOFF(gp_, vc);
        asm volatile("s_waitcnt vmcnt(0)" ::: "memory");
    }
    unsigned u00 = 0, u01 = 0, u10 = 0, u11 = 0;
    PG8_STAGE(PG8_SB(0, 0), cB, voffB); PG8_STAGE(PG8_SB(0, 1), cB + hstep, voffB); PG8_STAGE_A(PG8_SA(0, 0), cA, 0, false); PG8_STAGE_A(PG8_SA(0, 1), cA, 1, false);
    if (wr == 1) PG8_BAR;
    PG8_WAIT_V(2); PG8_BAR;
    PG8_STAGE(PG8_SB(1, 0), cB + kstep, voffB); PG8_STAGE_A(PG8_SA(1, 0), cA + kstep, 0, false); PG8_STAGE(PG8_SB(1, 1), cB + hstep + kstep, voffB);
    PG8_WAIT_V(6); PG8_BAR;
    for (;;) {
        const bool has_next = S.next(ui + 1, nxt);
        if constexpr (Epi::HAS_VEC) { if (wid == 4) { const unsigned long long vb_ = (unsigned long long)E.vec_ptr(cur); PG8_GL(vb_, (unsigned)(lane * 16), lds_top + BIAS_OFF + (ui & 1) * 1024); } }
        const char* nA = has_next ? nxt.A : cA; const char* nB = has_next ? nxt.B : cB;
        if constexpr (GATHER) {
            if (has_next && wid < 4) __builtin_amdgcn_global_load_lds((const unsigned*)(gidx + nxt.row0 + wid * 64 + lane), (LAS unsigned*)(idxl + ((ui + 1) & 1) * 256 + wid * 64), 4, 0, 0);
        }
#pragma unroll 1
        for (int t = 0; t < nt; t += 2) {
            const bool last = (t == nt - 2);
            const char* a1 = cA + (size_t)(t + 1) * kstep;
            const char* a2 = last ? nA : cA + (size_t)(t + 2) * kstep; const char* b2 = last ? nB : cB + (size_t)(t + 2) * kstep;
            const char* a3 = a2 + kstep; const char* b3 = b2 + kstep;
            const bool fae = MK_RELAX && (t == 0) && (ui > 0);
            if constexpr (GATHER) {
                u00 = vc00; u01 = vc01; u10 = vc10; u11 = vc11;
                if (last && has_next) { const LAS int* ip = idxl + ((ui + 1) & 1) * 256; PG8_GOFF(ip, u); }
            }
            PG8_LDB(B0, 0, 0); PG8_LDB(B1, 0, 1); PG8_SCHED; PG8_LDA(At, 0, 0); if (!fae) PG8_STAGE_A(PG8_SA(1, 1), a1, 1, false);
            PG8_WAIT_VR(); PG8_WAIT_L(0); PG8_BAR; PG8_MMA(0, 0, At, B0); PG8_MMA(0, 1, At, B1); PG8_BAR; PG8_SCHED;
            PG8_LDA(At, 0, 1); PG8_STAGE(PG8_SB(0, 0), b2, voffB); PG8_STAGE(PG8_SB(0, 1), b2 + hstep, voffB); PG8_STAGE_A(PG8_SA(0, 0), a2, 0, true);
            PG8_WAIT_VR(); PG8_WAIT_L(0); PG8_BAR; PG8_MMA(1, 0, At, B0); PG8_MMA(1, 1, At, B1); PG8_BAR; PG8_SCHED;
            PG8_LDB(B0, 1, 0); PG8_LDB(B1, 1, 1); PG8_SCHED; PG8_LDA(At, 1, 0); PG8_STAGE_A(PG8_SA(0, 1), a2, 1, true);
            PG8_WAIT_VR(); PG8_WAIT_L(0); PG8_BAR; PG8_MMA(0, 0, At, B0); PG8_MMA(0, 1, At, B1); PG8_BAR; PG8_SCHED;
            PG8_LDA(At, 1, 1); PG8_STAGE(PG8_SB(1, 0), b3, voffB); PG8_STAGE(PG8_SB(1, 1), b3 + hstep, voffB); PG8_STAGE_A(PG8_SA(1, 0), a3, 0, true);
            PG8_WAIT_V(8); PG8_WAIT_L(0); PG8_BAR; PG8_MMA(1, 0, At, B0); PG8_MMA(1, 1, At, B1); PG8_BAR; PG8_SCHED;
            if constexpr (MIDK > 0) { if (t + 2 == MIDK) { asm volatile("s_nop 15\n\ts_nop 15" ::: "memory"); E.mid(acc, cur, wr, wc, fr, fq); } }
        }
        asm volatile("s_nop 15\n\ts_nop 15" ::: "memory");
        if (wr == 0) PG8_BAR;
        if constexpr (F8 && !MK_F8SCALED) {
#pragma unroll
            for (int a = 0; a < 2; ++a)
#pragma unroll
                for (int b = 0; b < 2; ++b)
#pragma unroll
                    for (int m = 0; m < 4; ++m)
#pragma unroll
                        for (int n = 0; n < 2; ++n) acc[a][b][m][n] *= 1.0f / (F8_WSCALE * F8_XSCALE); }
        if (MK_RELAX && has_next) {
            if constexpr (GATHER) PG8_STAGE2(PG8_SA(1, 1), nA + kstep, u10, u11); else PG8_STAGE(PG8_SA(1, 1), nA + kstep + hstep, voffA); }
        if (variant & 8) cur.rows = 0;
        if (variant & 16) cur.row0 = NASG;
        if (!(variant & 1)) E(acc, cur, wr, wc, fr, fq, (const LAS float*)(lds_top + BIAS_OFF + (ui & 1) * 1024));
        if (!has_next) break;
#pragma unroll
        for (int a = 0; a < 2; ++a)
#pragma unroll
            for (int b = 0; b < 2; ++b)
#pragma unroll
                for (int m = 0; m < 4; ++m)
#pragma unroll
                    for (int n = 0; n < 2; ++n) acc[a][b][m][n] = (f32x4){0.f, 0.f, 0.f, 0.f};
        cur = nxt; cA = nA; cB = nB; ++ui;
        if constexpr (GATHER) { vc00 = u00; vc01 = u01; vc10 = u10; vc11 = u11; }
        if (wr == 1) PG8_BAR;
    }
    PG8_WAIT_V(0);
    PG8_BAR;
#undef PG8_SA
#undef PG8_SB
#undef PG8_GL
#undef PG8_STAGE
#undef PG8_STAGE2
#undef PG8_STAGE_A
#undef PG8_GOFF
#undef PG8_LDA
#undef PG8_LDB
#undef PG8_MMA
#undef PG8_CAT
#undef PG8_WAIT_V
#undef PG8_WAIT_VR
#undef PG8_WAIT_L
#undef PG8_BAR
#undef PG8_SCHED
}

__device__ __forceinline__ u32x4 pack8(f32x4 a, f32x4 b) { u32x4 w; w.x = pk2(a[0], a[1]); w.y = pk2(a[2], a[3]); w.z = pk2(b[0], b[1]); w.w = pk2(b[2], b[3]); return w; }
#ifndef MK_P2F8
#define MK_P2F8 1
#endif
#ifndef MK_NT
#define MK_NT 0
#endif
#ifndef MK_SKEW
#define MK_SKEW 0
#endif
template <class T> __device__ __forceinline__ void st_epi(T* p, T v) { if (MK_NT) __builtin_nontemporal_store(v, p); else *p = v; }

struct EpiIn {
    static constexpr bool PERM = true; static constexpr int NST = 16; static constexpr bool HAS_VEC = false;
    bf16 *Q, *Kb, *V, *U, *VG, *G; const float* ropec; const float* ropes;
    __device__ __forceinline__ void operator()(const Acc& acc, const Unit& u, int wr, int wc, int fr, int fq, const LAS float* lb) const {
        const int pn = u.pn, row0 = u.pm * 256 + wr * 64 + fr, cl = wc * 32 + 8 * fq;
        if (pn < 6) {
            bf16* base = (pn < 3) ? Q : Kb; const int g = (pn < 3) ? pn : pn - 3; const float sc = (pn < 3) ? QSCALE : 1.0f;
            const int i4 = 4 * (4 * (wc & 1) + fq);
#pragma unroll
            for (int ai = 0; ai < 2; ++ai) {
                f32x4 cs[4], sn[4];
#pragma unroll
                for (int m = 0; m < 4; ++m) { const int row = row0 + ai * 128 + m * 16; cs[m] = *(const f32x4*)(ropec + (size_t)row * 32 + i4); sn[m] = *(const f32x4*)(ropes + (size_t)row * 32 + i4); }
#pragma unroll
                for (int m = 0; m < 4; ++m) { const int row = row0 + ai * 128 + m * 16;
#pragma unroll
                    for (int bj = 0; bj < 2; ++bj) { const f32x4 x1 = acc[ai][bj][m][0], x2 = acc[ai][bj][m][1];
                        const f32x4 o1 = (x1 * cs[m] - x2 * sn[m]) * sc, o2 = (x2 * cs[m] + x1 * sn[m]) * sc;
                        st_epi((u32x4*)(base + (size_t)row * AW + g * 256 + bj * 128 + cl), pack8(o1, o2)); } }
                __builtin_amdgcn_sched_barrier(0); }
        } else if (pn < 9) {
            const int cb = (pn - 6) * 256;
#pragma unroll
            for (int ai = 0; ai < 2; ++ai)
#pragma unroll
                for (int m = 0; m < 4; ++m) { const int row = row0 + ai * 128 + m * 16;
#pragma unroll
                    for (int bj = 0; bj < 2; ++bj) st_epi((u32x4*)(V + (size_t)row * AW + cb + bj * 128 + cl), pack8(acc[ai][bj][m][0], acc[ai][bj][m][1]));
                    __builtin_amdgcn_sched_barrier(0); }
        } else if (pn < 13) {
            bf16* base = (pn < 11) ? U : VG; const int cb = ((pn - 9) & 1) * 256;
#pragma unroll
            for (int ai = 0; ai < 2; ++ai)
#pragma unroll
                for (int m = 0; m < 4; ++m) { const int row = row0 + ai * 128 + m * 16;
#pragma unroll
                    for (int bj = 0; bj < 2; ++bj) { f32x4 a = acc[ai][bj][m][0], b = acc[ai][bj][m][1];
#pragma unroll
                        for (int j = 0; j < 4; ++j) { a[j] = gelu_tanh(a[j]); b[j] = gelu_tanh(b[j]); }
                        st_epi((u32x4*)(base + (size_t)row * GW + cb + bj * 128 + cl), pack8(a, b)); }
                    __builtin_amdgcn_sched_barrier(0); }
        } else {
            const int cb = (pn - 13) * 256;
#pragma unroll
            for (int ai = 0; ai < 2; ++ai)
#pragma unroll
                for (int m = 0; m < 4; ++m) { const int row = row0 + ai * 128 + m * 16;
#pragma unroll
                    for (int bj = 0; bj < 2; ++bj) { f32x4 a = acc[ai][bj][m][0], b = acc[ai][bj][m][1];
#pragma unroll
                        for (int j = 0; j < 4; ++j) { a[j] = sigmoidf_(a[j]) * 256.0f; b[j] = sigmoidf_(b[j]) * 256.0f; }
                        u32x2 w8; w8.x = pk4_fp8_nc(a[0], a[1], a[2], a[3]); w8.y = pk4_fp8_nc(b[0], b[1], b[2], b[3]);
                        st_epi((u32x2*)((unsigned char*)G + (size_t)row * 2048 + cb + bj * 128 + cl), w8); }
                    __builtin_amdgcn_sched_barrier(0); }
        }
    }
};
__device__ __forceinline__ void unpack8(u32x4 w, f32x4& a, f32x4& b) { a = (f32x4){bf_lo(w.x), bf_hi(w.x), bf_lo(w.y), bf_hi(w.y)}; b = (f32x4){bf_lo(w.z), bf_hi(w.z), bf_lo(w.w), bf_hi(w.w)}; }
struct EpiMrg {
    static constexpr bool PERM = true; static constexpr int NST = 16; static constexpr bool HAS_VEC = false;
    const bf16* G; bf16* O;
    __device__ __forceinline__ void mid(Acc& acc, const Unit& u, int wr, int wc, int fr, int fq) const {
        const unsigned char* G8 = (const unsigned char*)G;
        const int row0 = u.pm * 256 + wr * 64 + fr, c0 = u.pn * 256 + wc * 32 + 8 * fq;
#pragma unroll
        for (int ai = 0; ai < 2; ++ai) {
            u32x2 wa[4][2], wg[4][2];
#pragma unroll
            for (int m = 0; m < 4; ++m)
#pragma unroll
                for (int bj = 0; bj < 2; ++bj) { const size_t o = (size_t)(row0 + ai * 128 + m * 16) * 2048 + c0 + bj * 128; wa[m][bj] = *(const u32x2*)(G8 + o); wg[m][bj] = *(const u32x2*)(G8 + o + 1024); }
#pragma unroll
            for (int m = 0; m < 4; ++m)
#pragma unroll
                for (int bj = 0; bj < 2; ++bj) { f32x4 a0, a1, g0, g1; unpk8_fp8(wa[m][bj], a0, a1); unpk8_fp8(wg[m][bj], g0, g1);
#pragma unroll
                    for (int j = 0; j < 4; ++j) { acc[ai][bj][m][0][j] *= a0[j] * fast_rcp(fmaxf(g0[j], 1e-30f)); acc[ai][bj][m][1][j] *= a1[j] * fast_rcp(fmaxf(g1[j], 1e-30f)); } }
            asm volatile("" ::: "memory"); __builtin_amdgcn_sched_barrier(0); }
    }
    __device__ __forceinline__ void operator()(const Acc& acc, const Unit& u, int wr, int wc, int fr, int fq, const LAS float* lb) const {
        const unsigned char* G8 = (const unsigned char*)G;
        const int row0 = u.pm * 256 + wr * 64 + fr, c0 = u.pn * 256 + wc * 32 + 8 * fq;
#pragma unroll
        for (int ai = 0; ai < 2; ++ai) {
            u32x2 wg[4][2];
#pragma unroll
            for (int m = 0; m < 4; ++m)
#pragma unroll
                for (int bj = 0; bj < 2; ++bj) wg[m][bj] = *(const u32x2*)(G8 + (size_t)(row0 + ai * 128 + m * 16) * 2048 + 1024 + c0 + bj * 128);
#pragma unroll
            for (int m = 0; m < 4; ++m) { const int row = row0 + ai * 128 + m * 16;
#pragma unroll
                for (int bj = 0; bj < 2; ++bj) { f32x4 g0, g1; unpk8_fp8(wg[m][bj], g0, g1);
                    st_epi((u32x4*)(O + (size_t)row * D + c0 + bj * 128), pack8(acc[ai][bj][m][0] * g0 * (1.0f / 256.0f), acc[ai][bj][m][1] * g1 * (1.0f / 256.0f))); } }
            asm volatile("" ::: "memory"); __builtin_amdgcn_sched_barrier(0); }
    }
};
struct EpiRes {
    static constexpr bool PERM = true; static constexpr int NST = 16; static constexpr bool HAS_VEC = false;
    const float* Hf; const bf16* Hb; bf16* Hout; const float* g1;
    __device__ __forceinline__ void operator()(const Acc& acc, const Unit& u, int wr, int wc, int fr, int fq, const LAS float* lb) const {
        const int row0 = u.pm * 256 + wr * 64 + fr, c0 = u.pn * 256 + wc * 32 + 8 * fq;
        const float* gp = g1 + (size_t)((u.pm * 256) / SEQ) * 6144;
        f32x4 gv[2][2];
#pragma unroll
        for (int bj = 0; bj < 2; ++bj) { gv[bj][0] = *(const f32x4*)(gp + c0 + bj * 128); gv[bj][1] = *(const f32x4*)(gp + c0 + bj * 128 + 4); }
        if (Hb) {
#pragma unroll
            for (int ai = 0; ai < 2; ++ai) {
                u32x4 hw[4][2];
#pragma unroll
                for (int m = 0; m < 4; ++m)
#pragma unroll
                    for (int bj = 0; bj < 2; ++bj) hw[m][bj] = *(const u32x4*)(Hb + (size_t)(row0 + ai * 128 + m * 16) * D + c0 + bj * 128);
#pragma unroll
                for (int m = 0; m < 4; ++m)
#pragma unroll
                    for (int bj = 0; bj < 2; ++bj) { const size_t o = (size_t)(row0 + ai * 128 + m * 16) * D + c0 + bj * 128; f32x4 h0, h1; unpack8(hw[m][bj], h0, h1);
                        st_epi((u32x4*)(Hout + o), pack8(h0 + gv[bj][0] * acc[ai][bj][m][0], h1 + gv[bj][1] * acc[ai][bj][m][1])); }
                asm volatile("" ::: "memory"); __builtin_amdgcn_sched_barrier(0); }
        } else {
#pragma unroll
            for (int ai = 0; ai < 2; ++ai)
#pragma unroll
                for (int mp = 0; mp < 2; ++mp) {
                    f32x4 hx[2][2][2];
#pragma unroll
                    for (int mm = 0; mm < 2; ++mm)
#pragma unroll
                        for (int bj = 0; bj < 2; ++bj) { const size_t o = (size_t)(row0 + ai * 128 + (2 * mp + mm) * 16) * D + c0 + bj * 128; hx[mm][bj][0] = *(const f32x4*)(Hf + o); hx[mm][bj][1] = *(const f32x4*)(Hf + o + 4); }
#pragma unroll
                    for (int mm = 0; mm < 2; ++mm)
#pragma unroll
                        for (int bj = 0; bj < 2; ++bj) { const int m = 2 * mp + mm; const size_t o = (size_t)(row0 + ai * 128 + m * 16) * D + c0 + bj * 128;
                            st_epi((u32x4*)(Hout + o), pack8(hx[mm][bj][0] + gv[bj][0] * acc[ai][bj][m][0], hx[mm][bj][1] + gv[bj][1] * acc[ai][bj][m][1])); }
                    asm volatile("" ::: "memory"); __builtin_amdgcn_sched_barrier(0); }
        }
    }
};
struct EpiSwiglu {
    static constexpr bool PERM = true; static constexpr int NST = 8; static constexpr bool HAS_VEC = true;
    const float* b1p; unsigned char* ACT;
    __device__ __forceinline__ const float* vec_ptr(const Unit& u) const { return b1p + (size_t)u.e * 2048 + u.pn * 256; }
    __device__ __forceinline__ void operator()(const Acc& acc, const Unit& u, int wr, int wc, int fr, int fq, const LAS float* lb) const {
        const LAS float* bp = lb + wc * 32 + 8 * fq;
        f32x4 bv[2][2];
#pragma unroll
        for (int bj = 0; bj < 2; ++bj) { bv[bj][0] = *(const LAS f32x4*)(bp + bj * 128); bv[bj][1] = *(const LAS f32x4*)(bp + bj * 128 + 4); }
        const int ac0 = u.pn * 128 + 8 * (4 * wc + fq);
#pragma unroll
        for (int ai = 0; ai < 2; ++ai)
#pragma unroll
            for (int m = 0; m < 4; ++m) { const int rl = ai * 128 + wr * 64 + m * 16 + fr;
                f32x4 o[2];
#pragma unroll
                for (int bj = 0; bj < 2; ++bj) { const f32x4 gl = acc[ai][bj][m][0] + bv[bj][0], li = acc[ai][bj][m][1] + bv[bj][1];
#pragma unroll
                    for (int j = 0; j < 4; ++j) { const float xg = fminf(gl[j], 7.0f), xl = fminf(fmaxf(li[j], -7.0f), 7.0f); o[bj][j] = xg * sigmoidf_(1.702f * xg) * (xl * F8_XSCALE + F8_XSCALE); } }
                { u32x2 w; w.x = pk4_fp8_nc(o[0][0], o[0][1], o[0][2], o[0][3]); w.y = pk4_fp8_nc(o[1][0], o[1][1], o[1][2], o[1][3]);
                    const int rr = (rl < u.rows) ? (u.row0 + rl) : (NASG + rl);
                    st_epi((u32x2*)(ACT + (size_t)rr * DFF + ac0), w); }
                __builtin_amdgcn_sched_barrier(0); }
    }
};
struct EpiY {
    static constexpr bool PERM = true; static constexpr int NST = 8; static constexpr bool HAS_VEC = true;
    const float* b2; unsigned char* Y;
    __device__ __forceinline__ const float* vec_ptr(const Unit& u) const { return b2 + (size_t)u.e * 1024 + u.pn * 256; }
    __device__ __forceinline__ void operator()(const Acc& acc, const Unit& u, int wr, int wc, int fr, int fq, const LAS float* lb) const {
        const int cl = 64 * wc + 16 * fq, c0 = u.pn * 256 + cl;
        f32x4 bv[2][2];
#pragma unroll
        for (int bj = 0; bj < 2; ++bj) { bv[bj][0] = *(const LAS f32x4*)(lb + cl + 8 * bj); bv[bj][1] = *(const LAS f32x4*)(lb + cl + 8 * bj + 4); }
#pragma unroll
        for (int ai = 0; ai < 2; ++ai)
#pragma unroll
            for (int m = 0; m < 4; ++m) { const int rl = ai * 128 + wr * 64 + m * 16 + fr;
                const int rr = (rl < u.rows) ? (u.row0 + rl) : (NASG + rl);
                u32x4 w;
#pragma unroll
                for (int bj = 0; bj < 2; ++bj) { const f32x4 y0 = (acc[ai][bj][m][0] + bv[bj][0]) * F8_YSCALE, y1 = (acc[ai][bj][m][1] + bv[bj][1]) * F8_YSCALE;
                    w[2 * bj] = pk4_fp8(y0[0], y0[1], y0[2], y0[3]); w[2 * bj + 1] = pk4_fp8(y1[0], y1[1], y1[2], y1[3]); }
                st_epi((u32x4*)(Y + (size_t)rr * D + c0), w);
                __builtin_amdgcn_sched_barrier(0); }
    }
};
}

enum { IN_X = 0, IN_C, IN_POS, IN_WADA, IN_BADA, IN_N1G, IN_WIN, IN_WS, IN_BS, IN_LNG, IN_LNB, IN_WPA, IN_WPG, IN_WO, IN_N2G, IN_WR, IN_BR, IN_W1, IN_B1, IN_W2, IN_B2, IN_FG, IN_OUT };
struct Args { const float* in[22]; const int* positions; float* out; unsigned char* ws; int ph_lo, ph_hi; int variant, pad; };
struct Frame {
    LAS unsigned char* lds; volatile LAS unsigned* MISC; gu32* ctl;
    int tid, lane, wave, vcu, G;
    unsigned char* ws_;
};
__device__ __forceinline__ unsigned char* ws_of(const Frame& F) { unsigned long long p = (unsigned long long)F.ws_; asm volatile("" : "+s"(p)); return (unsigned char*)(GAS unsigned char*)p; }
__device__ __forceinline__ Frame opaque_frame(const Frame& F0) { Frame F = F0; asm volatile("" : "+v"(F.tid)); F.lane = F.tid & 63; asm volatile("" : "+s"(F.wave), "+s"(F.vcu), "+s"(F.G)); return F; }
__device__ __forceinline__ const float* inp(const Frame& F, int i) {
    const volatile LAS unsigned* t = F.MISC + 16 + 2 * i; const unsigned lo = __builtin_amdgcn_readfirstlane(t[0]), hi = __builtin_amdgcn_readfirstlane(t[1]);
    return (const float*)(const GAS float*)(((unsigned long long)hi << 32) | lo); }

template <int MODE> __device__ __forceinline__ int dest_row(int n) {
    if (MODE == 1) {
        if (n < 2 * AW) { const int hb = n & ~63, d = n & 63, half = d >> 5, f = d & 31; return hb + 8 * (f >> 2) + 4 * half + (f & 3); }
        return n;
    } else if (MODE == 2) {
        const int ac = n >> 1, typ = n & 1, pn = ac >> 7, al = ac & 127, q8 = al >> 3, bj = (al >> 2) & 1, j = al & 3, wc = q8 >> 2, fq = q8 & 3;
        return 256 * pn + 128 * bj + 32 * wc + 8 * fq + 4 * typ + j;
    }
    if (MODE == 3) {
        const int l = n & 255; return (n & ~255) + 128 * ((l >> 3) & 1) + 32 * (l >> 6) + 8 * ((l >> 4) & 3) + (l & 7); }
    return n;
}
template <int MODE> __device__ __forceinline__ void cvt_item(const float* W, int K, int N, bf16* WT, LAS float* scr, int item, int lane, int ldk = 0, int koff = 0) {
    if (ldk == 0) ldk = K;
    const int nblk = N / 64, kb = item / nblk, nb = item % nblk, k0 = kb * 64, n0 = nb * 64;
    const int lr = lane >> 4, lc = (lane & 15) * 4;
    f32x4 v[16];
#pragma unroll
    for (int i = 0; i < 16; ++i) v[i] = *(const f32x4*)(W + (size_t)(k0 + 4 * i + lr) * N + n0 + lc);
#pragma unroll
    for (int i = 0; i < 16; ++i) { LAS float* s = scr + (4 * i + lr) * 65 + lc; s[0] = v[i][0]; s[1] = v[i][1]; s[2] = v[i][2]; s[3] = v[i][3]; }
    LDS_WAIT(); asm volatile("" ::: "memory");
    const int kc = lane & 7;
#pragma unroll
    for (int jj = 0; jj < 8; ++jj) { const int n = (lane >> 3) + 8 * jj; const LAS float* s = scr + (8 * kc) * 65 + n;
        u32x4 o; o.x = pk2(s[0], s[65]); o.y = pk2(s[2 * 65], s[3 * 65]); o.z = pk2(s[4 * 65], s[5 * 65]); o.w = pk2(s[6 * 65], s[7 * 65]);
        *(u32x4*)(WT + (size_t)dest_row<MODE>(n0 + n) * ldk + koff + k0 + 8 * kc) = o; }
    LDS_WAIT(); asm volatile("" ::: "memory");
}

template <int MODE> __device__ __forceinline__ void cvt_item8(const float* W, int K, int N, unsigned char* WT, LAS unsigned char* scr, int item, int lane) {
    const int nblk = N / 64, kb = item / nblk, nb = item % nblk, k0 = kb * 128, n0 = nb * 64;
    const int lr = lane >> 4, lc = (lane & 15) * 4;
    f32x4 v[2][16];
#pragma unroll
    for (int hf = 0; hf < 2; ++hf)
#pragma unroll
        for (int i = 0; i < 16; ++i) v[hf][i] = __builtin_nontemporal_load((const f32x4*)(W + (size_t)(k0 + 64 * hf + 16 * lr + i) * N + n0 + lc));
#pragma unroll
    for (int hf = 0; hf < 2; ++hf) {
#pragma unroll
        for (int c = 0; c < 4; ++c) { u32x4 w;
#pragma unroll
            for (int d = 0; d < 4; ++d) w[d] = pk4_fp8(v[hf][4 * d][c] * F8_WSCALE, v[hf][4 * d + 1][c] * F8_WSCALE, v[hf][4 * d + 2][c] * F8_WSCALE, v[hf][4 * d + 3][c] * F8_WSCALE);
            *(LAS u32x4*)(scr + (lc + c) * 144 + 64 * hf + 16 * lr) = w; }
    }
    LDS_WAIT(); asm volatile("" ::: "memory");
    const int ch = lane & 7;
#pragma unroll
    for (int jj = 0; jj < 8; ++jj) { const int n = (lane >> 3) + 8 * jj;
        const u32x4 o = *(const LAS u32x4*)(scr + n * 144 + 16 * ch); u32x4* dp = (u32x4*)(WT + (size_t)dest_row<MODE>(n0 + n) * K + k0 + 16 * ch);
        if (MODE >= 2) __builtin_nontemporal_store(o, dp); else *dp = o; }
    LDS_WAIT(); asm volatile("" ::: "memory");
}

__device__ __forceinline__ void modnorm_store(const f32x4 (&v)[4], const float* g, const float* sc, const float* sh, bf16* orow, int lane) {
    float s = 0.f;
#pragma unroll
    for (int j = 0; j < 4; ++j) s += (v[j][0] * v[j][0] + v[j][1] * v[j][1]) + (v[j][2] * v[j][2] + v[j][3] * v[j][3]);
    const float rstd = 1.0f / sqrtf(wave_sum(s) * (1.0f / D) + RMS_EPS);
#pragma unroll
    for (int j = 0; j < 4; ++j) { const int c = 4 * lane + 256 * j; const f32x4 gv = *(const f32x4*)(g + c), sv = *(const f32x4*)(sc + c), hv = *(const f32x4*)(sh + c);
        const f32x4 y = v[j] * rstd * gv * (sv + 1.0f) + hv;
        if (MK_P2F8) *(unsigned*)((unsigned char*)orow + c) = pk4_fp8(y[0] * F8_XSCALE, y[1] * F8_XSCALE, y[2] * F8_XSCALE, y[3] * F8_XSCALE);
        else { u32x2 w; w.x = pk2(y[0], y[1]); w.y = pk2(y[2], y[3]); *(u32x2*)(orow + c) = w; } }
}

__device__ __forceinline__ void phase_pr0(const Frame& F0) {
    const Frame F = opaque_frame(F0);
    unsigned char* ws = ws_of(F);
    const float* in_c = inp(F, IN_C); const float* in_wada = inp(F, IN_WADA); const float* in_bada = inp(F, IN_BADA); const int* in_pos = (const int*)inp(F, IN_POS);
    const float* in_wr = inp(F, IN_WR); const float* in_ws = inp(F, IN_WS); const float* in_b1 = inp(F, IN_B1);
    {
        LAS float* sl = (LAS float*)F.lds;
        LAS float* red = (LAS float*)(F.lds + 32768);
        float* MOD = (float*)(ws + WS_MOD);
        for (int i = F.tid; i < BATCH * D; i += NTHR) { const int b = i >> 10, k = i & 1023; const float cv = in_c[i]; sl[k * 8 + b] = cv * sigmoidf_(cv); }
        __syncthreads();
        for (int it = blockIdx.x; it < DEPTH * 128; it += F.G) {
            const int l = it / 128, cl_ = F.lane < 48 ? F.lane : 47, col = (it % 128) * 48 + cl_;
            const float* W = in_wada + (size_t)l * D * 6144 + col;
            float a[8];
#pragma unroll
            for (int b = 0; b < 8; ++b) a[b] = 0.f;
            const int kb = F.wave * 128;
#pragma unroll 32
            for (int k = 0; k < 128; ++k) { const float w = W[(size_t)(kb + k) * 6144]; const f32x4 s0 = *(const LAS f32x4*)(sl + (kb + k) * 8), s1 = *(const LAS f32x4*)(sl + (kb + k) * 8 + 4);
                a[0] += s0[0] * w; a[1] += s0[1] * w; a[2] += s0[2] * w; a[3] += s0[3] * w; a[4] += s1[0] * w; a[5] += s1[1] * w; a[6] += s1[2] * w; a[7] += s1[3] * w; }
#pragma unroll
            for (int b = 0; b < 8; ++b) red[(F.wave * 8 + b) * 64 + F.lane] = a[b];
            __syncthreads();
            { const int b = F.wave; float s = 0.f;
#pragma unroll
              for (int w = 0; w < 8; ++w) s += red[(w * 8 + b) * 64 + F.lane];
              if (F.lane < 48) MOD[((size_t)l * BATCH + b) * 6144 + col] = s + in_bada[l * 6144 + col]; }
            __syncthreads();
        }
        __syncthreads();
    }
    const int gw = F.vcu * NWAVES + F.wave, NGW = F.G * NWAVES;
    const int gt = F.vcu * NTHR + F.tid, NGT = F.G * NTHR;
    {
        float* RC = (float*)(ws + WS_ROPEC); float* RS = (float*)(ws + WS_ROPES);
        for (int i = gt; i < NTOK * 32; i += NGT) { const int row = i >> 5, f = i & 31;
            const float invf = (float)exp(-(double)f * (9.210340371976184 / 32.0));
            const float ang = (float)in_pos[row] * invf;
            const double x = (double)ang; const double k = rint(x * 0.15915494309189535); const float r = (float)(x - k * 6.283185307179586);
            RC[i] = __cosf(r); RS[i] = __sinf(r); }
    }
    {
        bf16* WRH = (bf16*)(ws + WS_WRH); bf16* WRL = (bf16*)(ws + WS_WRL);
        for (int i = gt; i < DEPTH * NE * D; i += NGT) { const int l = i / (NE * D), e = (i / D) % NE, d = i % D; const float w = in_wr[((size_t)l * D + d) * NE + e];
            const unsigned h = pk2(w, 0.f) & 0xffffu; const float lo = w - bf2f((bf16)h); WRH[i] = (bf16)h; WRL[i] = (bf16)(pk2(lo, 0.f) & 0xffffu); }
        bf16* WSB = (bf16*)(ws + WS_WSB);
        for (int i = gt; i < DEPTH * 4 * 128 * 128; i += NGT) { const int t = (i >> 7) & 127, s = i & 127; WSB[i] = (s <= t) ? (bf16)(pk2(in_ws[i], 0.f) & 0xffffu) : (bf16)0; }
        float* B1P = (float*)(ws + WS_B1P);
        for (int i = gt; i < DEPTH * NE * 2048; i += NGT) { const int n = i & 2047; B1P[(i & ~2047) + dest_row<2>(n)] = in_b1[i]; }
    }
    {
        LAS float* scr = (LAS float*)(F.lds + F.wave * 16640);
        const float* in_win = inp(F, IN_WIN); const float* in_wpa = inp(F, IN_WPA); const float* in_wpg = inp(F, IN_WPG); const float* in_wo = inp(F, IN_WO); const float* in_w1 = inp(F, IN_W1); const float* in_w2 = inp(F, IN_W2);
        constexpr int I_IN = (MK_P2F8 ? 8 : 16) * 84, I_PA = 4 * 16, I_PG = 8 * 16, I_O = 16 * 16, I_1 = 8 * 32, I_2 = 8 * 16;
        constexpr int N_IN = DEPTH * I_IN, N_PA = DEPTH * I_PA, N_PG = DEPTH * I_PG, N_O = DEPTH * I_O, N_1 = (MK_TAILCVT ? 1 : DEPTH) * NE * I_1, N_2 = (MK_TAILCVT ? 1 : DEPTH) * NE * I_2;
        constexpr int NITEMS = N_IN + N_PA + N_PG + N_O + N_1 + N_2;
        for (int it = gw; it < NITEMS; it += NGW) {
            int r = it;
            if (r < N_IN) { const int m = r / I_IN; if (MK_P2F8) cvt_item8<1>(in_win + (size_t)m * D * INW, D, INW, (unsigned char*)(ws + WS_WTIN) + (size_t)m * INW * D, (LAS unsigned char*)scr, r % I_IN, F.lane); else cvt_item<1>(in_win + (size_t)m * D * INW, D, INW, (bf16*)(ws + WS_WTIN) + (size_t)m * INW * D, scr, r % I_IN, F.lane); continue; } r -= N_IN;
            if (r < N_PA) { const int m = r / I_PA; cvt_item<0>(in_wpa + (size_t)m * AO * D, AO, D, (bf16*)(ws + WS_WTPA) + (size_t)m * D * AW, scr, r % I_PA, F.lane, AW, 0); continue; } r -= N_PA;
            if (r < N_PG) { const int m = r / I_PG; cvt_item<0>(in_wpg + (size_t)m * GW * D, GW, D, (bf16*)(ws + WS_WTPA) + (size_t)m * D * AW, scr, r % I_PG, F.lane, AW, AO); continue; } r -= N_PG;
            if (r < N_O) { const int m = r / I_O; cvt_item<0>(in_wo + (size_t)m * D * D, D, D, (bf16*)(ws + WS_WTO) + (size_t)m * D * D, scr, r % I_O, F.lane); continue; } r -= N_O;
            if (r < N_1) { const int m = r / I_1; cvt_item8<2>(in_w1 + (size_t)m * D * 2048, D, 2048, (unsigned char*)(ws + WS_W1T) + (size_t)m * 2048 * D, (LAS unsigned char*)scr, r % I_1, F.lane); continue; } r -= N_1;
            { const int m = r / I_2; cvt_item8<3>(in_w2 + (size_t)m * DFF * D, DFF, D, (unsigned char*)(ws + WS_W2T) + (size_t)m * D * DFF, (LAS unsigned char*)scr, r % I_2, F.lane); }
        }
    }
}

constexpr int Q_I1 = 8 * 32, Q_I2 = 8 * 16, NQ = NE * (Q_I1 + Q_I2);
__device__ __forceinline__ int tail_idle_cnt(int nwg, int G) { const int rem = nwg % G; return rem > 0 ? G - rem : 0; }
__device__ __forceinline__ int tail_ipw(int k) { return k == 2 ? MK_TAILIPW_P9 : MK_TAILIPW; }
__device__ __forceinline__ int tail_base(int k, int nM0, int G) {
    int b = 0;
    if (k > 0) b += tail_idle_cnt((NTOK / 256) * (INW / 256), G) * NWAVES * tail_ipw(0);
    if (k > 1) b += tail_idle_cnt(nM0 * (2048 / 256), G) * NWAVES * tail_ipw(1);
    if (k > 2) b += tail_idle_cnt(nM0 * (D / 256), G) * NWAVES * tail_ipw(2);
    if (k > 3) b += tail_idle_cnt((NTOK / 256) * (INW / 256), G) * NWAVES * tail_ipw(3);
    return b;
}
__device__ __forceinline__ void cvt_qitem(const Frame& F, unsigned char* ws, const float* in_w1, const float* in_w2, LAS unsigned char* scr, int q) {
    if (q < NE * Q_I1) { const int m = NE + q / Q_I1; cvt_item8<2>(in_w1 + (size_t)m * D * 2048, D, 2048, (unsigned char*)(ws + WS_W1T) + (size_t)m * 2048 * D, scr, q % Q_I1, F.lane); }
    else { const int r = q - NE * Q_I1, m = NE + r / Q_I2; cvt_item8<3>(in_w2 + (size_t)m * DFF * D, DFF, D, (unsigned char*)(ws + WS_W2T) + (size_t)m * D * DFF, scr, r % Q_I2, F.lane); }
}
__device__ __forceinline__ void cvt_tail(const Frame& F0, int k, int nwg) {
    if (k < 4) { const int rem0 = nwg % F0.G; if (rem0 == 0 || (int)blockIdx.x < rem0) return; }
    const Frame F = opaque_frame(F0);
    unsigned char* ws = ws_of(F);
    const float* in_w1 = inp(F, IN_W1); const float* in_w2 = inp(F, IN_W2);
    LAS unsigned char* scr = F.lds + F.wave * 16640;
    const int nM0 = k > 0 ? __builtin_amdgcn_readfirstlane(((const int*)(ws + WS_ETAB))[128]) : 0;
    if (k < 4) {
        const int rem = nwg % F.G, idle = F.G - rem, ii = (int)blockIdx.x - rem, base = tail_base(k, nM0, F.G);
#pragma unroll 1
        for (int j = 0; j < tail_ipw(k); ++j) { const int q = base + j * idle * NWAVES + ii * NWAVES + F.wave; if (q < NQ) cvt_qitem(F, ws, in_w1, in_w2, scr, q); }
    } else {
        const int gw = F.vcu * NWAVES + F.wave, NGW = F.G * NWAVES;
#pragma unroll 1
        for (int q = tail_base(4, nM0, F.G) + gw; q < NQ; q += NGW) cvt_qitem(F, ws, in_w1, in_w2, scr, q);
    }
}

__device__ __forceinline__ void phase_pr1(const Frame& F0) {
    const Frame F = opaque_frame(F0);
    const int gw = F.vcu * NWAVES + F.wave, NGW = F.G * NWAVES;
    unsigned char* ws = ws_of(F);
    const float* MOD = (const float*)(ws + WS_MOD); bf16* AIN = (bf16*)(ws + WS_AIN);
    const float* in_x = inp(F, IN_X); const float* in_n1g = inp(F, IN_N1G);
    f32x4 vn[4];
    if (gw < NTOK) {
#pragma unroll
        for (int j = 0; j < 4; ++j) vn[j] = *(const f32x4*)(in_x + (size_t)gw * D + 4 * F.lane + 256 * j); }
    for (int t = gw; t < NTOK; t += NGW) { const int b = t / SEQ; const float* mp = MOD + (size_t)b * 6144;
        f32x4 v[4];
#pragma unroll
        for (int j = 0; j < 4; ++j) v[j] = vn[j];
        if (t + NGW < NTOK) {
#pragma unroll
            for (int j = 0; j < 4; ++j) vn[j] = *(const f32x4*)(in_x + (size_t)(t + NGW) * D + 4 * F.lane + 256 * j); }
        modnorm_store(v, in_n1g, mp + 1024, mp, MK_P2F8 ? (bf16*)((unsigned char*)AIN + (size_t)t * D) : AIN + (size_t)t * D, F.lane); }
}

__device__ __forceinline__ int crow(int r, int hi) { return (r & 3) + 8 * (r >> 2) + 4 * hi; }
constexpr int VSTR = 192;
__device__ __forceinline__ s16x4 tr_read(const LAS unsigned char* p) { typedef short v4i16_t __attribute__((ext_vector_type(4))); return __builtin_bit_cast(s16x4, __builtin_amdgcn_ds_read_tr16_b64_v4i16((LAS v4i16_t*)p)); }
__device__ __forceinline__ float half_swap_max(float m) { auto rr = __builtin_amdgcn_permlane32_swap(__float_as_uint(m), __float_as_uint(m), false, false); return fmaxf(__uint_as_float(rr[0]), __uint_as_float(rr[1])); }
__device__ __forceinline__ float half_swap_sum(float m) { auto rr = __builtin_amdgcn_permlane32_swap(__float_as_uint(m), __float_as_uint(m), false, false); return __uint_as_float(rr[0]) + __uint_as_float(rr[1]); }

__device__ __forceinline__ void attn_block(const Frame& F, const bf16* Qb, const bf16* Kb, const bf16* Vb, bf16* OGg, float* LSEg, int b, int r, int j, int n, int g) {
    const int lane = F.lane, w = F.wave, q = lane & 31, hh = lane >> 5;
    const unsigned lds0 = (unsigned)(__UINTPTR_TYPE__)F.lds;
    const int gi = (lane >> 4) & 1, q4 = (lane & 15) >> 2, p4 = lane & 3;
#pragma unroll 1
    for (int hp = 0; hp < 2; ++hp) {
        { const int rowin = lane >> 3, c = (lane & 7) ^ rowin;
#pragma unroll
          for (int i = 0; i < 8; ++i) { const int rg = w * 8 + i, hl = rg >> 5, rgi = rg & 31;
              if (n > 0 || rgi >= 16) {
                  const int row = 8 * rgi + rowin;
                  const unsigned voff = (unsigned)(((size_t)b * SEQ + (size_t)((n - 1) * 128 + row) * r + j) * AW + g * 256 + (2 * hp + hl) * 64 + 8 * c) * 2u;
                  glds16((unsigned long long)Kb, voff, lds0 + hl * 32768 + rgi * 1024);
                  glds16((unsigned long long)Vb, voff, lds0 + 65536 + hl * 32768 + rgi * 1024); } } }
        const int hl = w >> 2, I = w & 3, h = 2 * hp + hl;
        const size_t rowq = (size_t)b * SEQ + (size_t)(n * 128 + 32 * I + q) * r + j;
        bf16x8 qf[4];
#pragma unroll
        for (int s = 0; s < 4; ++s) qf[s] = *(const bf16x8*)(Qb + rowq * AW + g * 256 + h * 64 + 16 * s + 8 * hh);
        asm volatile("s_waitcnt vmcnt(0)" ::: "memory");
        __syncthreads();
        const LAS unsigned char* Kimg = F.lds + hl * 32768; const LAS unsigned char* Vimg = F.lds + 65536 + hl * 32768;
        f32x16 o0, o1;
#pragma unroll
        for (int i = 0; i < 16; ++i) { o0[i] = 0.f; o1[i] = 0.f; }
        float mrun = -1e30f, lrun = 0.f;
        const int Jlo = (n == 0 && I < 4) ? 4 : I, Jhi = I + 4;
#pragma unroll 1
        for (int J = Jlo; J <= Jhi; ++J) {
            f32x16 st;
#pragma unroll
            for (int i = 0; i < 16; ++i) st[i] = 0.f;
            { const int row = 32 * J + q; const LAS unsigned char* kr = Kimg + row * 128;
#pragma unroll
              for (int s = 0; s < 4; ++s) { const bf16x8 kf = *(const LAS bf16x8*)(kr + (((2 * s + hh) ^ (row & 7)) << 4)); st = __builtin_amdgcn_mfma_f32_32x32x16_bf16(kf, qf[s], st, 0, 0, 0); } }
            if (J == I) {
#pragma unroll
                for (int i = 0; i < 16; ++i) if (crow(i, hh) < q) st[i] = -1e30f;
            }
            if (J == I + 4) {
#pragma unroll
                for (int i = 0; i < 16; ++i) if (crow(i, hh) > q) st[i] = -1e30f;
            }
            float mx = st[0];
#pragma unroll
            for (int i = 1; i < 16; ++i) mx = fmaxf(mx, st[i]);
            mx = half_swap_max(mx);
            const float mnew = fmaxf(mrun, mx), alpha = fast_exp2(mrun - mnew);
            float rs = 0.f;
#pragma unroll
            for (int i = 0; i < 16; ++i) { st[i] = fast_exp2(st[i] - mnew); rs += st[i]; }
            rs = half_swap_sum(rs);
            lrun = lrun * alpha + rs; mrun = mnew;
#pragma unroll
            for (int i = 0; i < 16; ++i) { o0[i] *= alpha; o1[i] *= alpha; }
            bf16x8 pf[2];
#pragma unroll
            for (int s = 0; s < 2; ++s) { u32x4 wv; wv.x = pk2(st[8 * s + 0], st[8 * s + 1]); wv.y = pk2(st[8 * s + 2], st[8 * s + 3]); wv.z = pk2(st[8 * s + 4], st[8 * s + 5]); wv.w = pk2(st[8 * s + 6], st[8 * s + 7]); pf[s] = __builtin_bit_cast(bf16x8, wv); }
            { const int sw = 4 * hh + q4; const LAS unsigned char* vr = Vimg + (32 * J + 4 * hh + q4) * 128 + 8 * (p4 & 1);
              const int c0 = ((2 * gi + (p4 >> 1)) ^ sw) << 4, c1 = ((4 + 2 * gi + (p4 >> 1)) ^ sw) << 4;
#pragma unroll
              for (int s = 0; s < 2; ++s) {
                  const s16x4 a0 = tr_read(vr + (16 * s) * 128 + c0), a1 = tr_read(vr + (16 * s + 8) * 128 + c0);
                  const s16x4 e0 = tr_read(vr + (16 * s) * 128 + c1), e1 = tr_read(vr + (16 * s + 8) * 128 + c1);
                  const bf16x8 v0 = (bf16x8){a0[0], a0[1], a0[2], a0[3], a1[0], a1[1], a1[2], a1[3]}, v1 = (bf16x8){e0[0], e0[1], e0[2], e0[3], e1[0], e1[1], e1[2], e1[3]};
                  o0 = __builtin_amdgcn_mfma_f32_32x32x16_bf16(v0, pf[s], o0, 0, 0, 0);
                  o1 = __builtin_amdgcn_mfma_f32_32x32x16_bf16(v1, pf[s], o1, 0, 0, 0); } }
        }
        const float inv = 1.0f / lrun;
        bf16* op = OGg + rowq * AO + h * 64 + 4 * hh;
#pragma unroll
        for (int rq = 0; rq < 4; ++rq) {
            u32x2 w0, w1;
            w0.x = pk2(o0[4 * rq] * inv, o0[4 * rq + 1] * inv); w0.y = pk2(o0[4 * rq + 2] * inv, o0[4 * rq + 3] * inv);
            w1.x = pk2(o1[4 * rq] * inv, o1[4 * rq + 1] * inv); w1.y = pk2(o1[4 * rq + 2] * inv, o1[4 * rq + 3] * inv);
            *(u32x2*)(op + 8 * rq) = w0; *(u32x2*)(op + 32 + 8 * rq) = w1; }
        if (hh == 0) LSEg[rowq * 4 + h] = (mrun + __log2f(lrun)) * LN2;
        __syncthreads();
    }
}

__device__ __forceinline__ void phase_attn(const Frame& F0) {
    const Frame F = opaque_frame(F0);
    unsigned char* ws = ws_of(F);
    const bf16* Qb = (const bf16*)(ws + WS_QB); const bf16* Kb = (const bf16*)(ws + WS_KB); const bf16* Vb = (const bf16*)(ws + WS_VB);
    bf16* OG = (bf16*)(ws + WS_OG); float* LSE = (float*)(ws + WS_LSE);
    __syncthreads();
    for (int b0 = blockIdx.x * 3; b0 < 768; b0 += F.G * 3)
#pragma unroll 1
        for (int blk = b0; blk < b0 + 3 && blk < 768; ++blk) {
            const int g = blk >> 8, rem = blk & 255, b = rem >> 5, jn = rem & 31;
            const int r = (g == 0) ? 1 : (g == 1 ? 4 : 16), nb = 32 / r, j = jn / nb, n = jn % nb;
            attn_block(F, Qb, Kb, Vb, OG + (size_t)g * NTOK * AO, LSE + (size_t)g * NTOK * 4, b, r, j, n, g);
        }
}

constexpr int ISTR = 320;
__device__ __forceinline__ void phase_gmlp(const Frame& F0, int l) {
    const Frame F = opaque_frame(F0);
    unsigned char* ws = ws_of(F);
    const bf16* VG = (const bf16*)(ws + WS_VGB); const bf16* U = (const bf16*)(ws + WS_UB); bf16* GM = (bf16*)(ws + WS_ATT) + AO;
    const bf16* WSB = (const bf16*)(ws + WS_WSB) + (size_t)l * 4 * 128 * 128;
    const float* lng = inp(F, IN_LNG) + l * GW; const float* lnb = inp(F, IN_LNB) + l * GW; const float* bs = inp(F, IN_BS) + l * 4 * 128;
    LAS unsigned char* img = F.lds; LAS f32x2* ST = (LAS f32x2*)(F.lds + 128 * ISTR);
    const int lane = F.lane, q = lane & 31, hh = lane >> 5, gi = (lane >> 4) & 1, q4 = (lane & 15) >> 2, p4 = lane & 3;
    for (int un = blockIdx.x; un < NTILE128; un += F.G) {
        const size_t R0 = (size_t)un * 128;
        __syncthreads();
        u32x4 rowv[16];
#pragma unroll
        for (int i = 0; i < 16; ++i) rowv[i] = *(const u32x4*)(VG + (R0 + F.wave * 16 + i) * GW + 8 * lane);
#pragma unroll
        for (int i = 0; i < 16; ++i) { const int tk = F.wave * 16 + i; f32x4 a, b2; pg8::unpack8(rowv[i], a, b2);
            const float s = wave_sum((a[0] + a[1]) + (a[2] + a[3]) + (b2[0] + b2[1]) + (b2[2] + b2[3])); const float mean = s * (1.0f / GW);
            const f32x4 da = a - mean, db = b2 - mean; const float ss = wave_sum((da[0] * da[0] + da[1] * da[1]) + (da[2] * da[2] + da[3] * da[3]) + (db[0] * db[0] + db[1] * db[1]) + (db[2] * db[2] + db[3] * db[3]));
            if (lane == 0) ST[tk] = (f32x2){mean, 1.0f / sqrtf(ss * (1.0f / GW) + LN_EPS)}; }
        __syncthreads();
        const int ch = lane & 15, tt = F.wave >> 1;
        u32x4 sl[4];
#pragma unroll
        for (int i = 0; i < 4; ++i) sl[i] = *(const u32x4*)(VG + (R0 + F.wave * 16 + ((lane + 64 * i) >> 4)) * GW + 8 * ch);
#pragma unroll 1
        for (int g = 0; g < 4; ++g) {
            bf16x8 bw[8];
            const bf16* wrow = WSB + ((size_t)g * 128 + 32 * tt + q) * 128 + 8 * hh;
#pragma unroll
            for (int ks = 0; ks < 8; ++ks) if (ks < 2 * (tt + 1)) bw[ks] = *(const bf16x8*)(wrow + 16 * ks);
            const size_t orow = R0 + 32 * tt + q;
            u32x2 uw[2][4];
#pragma unroll
            for (int cc = 0; cc < 2; ++cc)
#pragma unroll
                for (int rq = 0; rq < 4; ++rq) uw[cc][rq] = *(const u32x2*)(U + orow * GW + g * 128 + 32 * (2 * (F.wave & 1) + cc) + 8 * rq + 4 * hh);
            const float bias = bs[g * 128 + 32 * tt + q];
            { f32x4 ga, gb, ba, bb;
              ga = *(const f32x4*)(lng + g * 128 + 8 * ch); gb = *(const f32x4*)(lng + g * 128 + 8 * ch + 4); ba = *(const f32x4*)(lnb + g * 128 + 8 * ch); bb = *(const f32x4*)(lnb + g * 128 + 8 * ch + 4);
#pragma unroll
              for (int i = 0; i < 4; ++i) { const int tk = F.wave * 16 + ((lane + 64 * i) >> 4); f32x4 a, b2; pg8::unpack8(sl[i], a, b2);
                  const f32x2 st = ST[tk]; a = (a - st.x) * st.y * ga + ba; b2 = (b2 - st.x) * st.y * gb + bb;
                  *(LAS u32x4*)(img + tk * ISTR + ch * 16) = pg8::pack8(a, b2); } }
            if (g < 3) {
#pragma unroll
                for (int i = 0; i < 4; ++i) sl[i] = *(const u32x4*)(VG + (R0 + F.wave * 16 + ((lane + 64 * i) >> 4)) * GW + (g + 1) * 128 + 8 * ch); }
            __syncthreads();
            f32x16 acc[2];
#pragma unroll
            for (int i = 0; i < 16; ++i) { acc[0][i] = 0.f; acc[1][i] = 0.f; }
#pragma unroll
            for (int ks = 0; ks < 8; ++ks) if (ks < 2 * (tt + 1)) {
#pragma unroll
                for (int cc = 0; cc < 2; ++cc) { const int ct = 2 * (F.wave & 1) + cc;
                    const LAS unsigned char* tb = img + (16 * ks + 8 * hh + q4) * ISTR + (32 * ct + 16 * gi + 4 * p4) * 2;
                    const s16x4 a0 = tr_read(tb), a1 = tr_read(tb + 4 * ISTR);
                    const bf16x8 af = (bf16x8){a0[0], a0[1], a0[2], a0[3], a1[0], a1[1], a1[2], a1[3]};
                    acc[cc] = __builtin_amdgcn_mfma_f32_32x32x16_bf16(af, bw[ks], acc[cc], 0, 0, 0); }
            }
#pragma unroll
            for (int cc = 0; cc < 2; ++cc) { const int ct = 2 * (F.wave & 1) + cc;
#pragma unroll
                for (int rq = 0; rq < 4; ++rq) { const int c0 = g * 128 + 32 * ct + 8 * rq + 4 * hh; const u32x2 u2 = uw[cc][rq];
                    u32x2 w; w.x = pk2((acc[cc][4 * rq] + bias) * bf_lo(u2.x), (acc[cc][4 * rq + 1] + bias) * bf_hi(u2.x)); w.y = pk2((acc[cc][4 * rq + 2] + bias) * bf_lo(u2.y), (acc[cc][4 * rq + 3] + bias) * bf_hi(u2.y));
                    *(u32x2*)(GM + orow * AW + c0) = w; } }
            __syncthreads();
        }
    }
}

__device__ __forceinline__ void phase_merge(const Frame& F0) {
    const Frame F = opaque_frame(F0);
    const int gw = F.vcu * NWAVES + F.wave, NGW = F.G * NWAVES;
    unsigned char* ws = ws_of(F);
    const bf16* OG = (const bf16*)(ws + WS_OG); const float* LSE = (const float*)(ws + WS_LSE); bf16* ATT = (bf16*)(ws + WS_ATT);
    const int lane = F.lane, h = lane >> 4;
    for (int t0 = gw; t0 < NTOK; t0 += 4 * NGW) {
        float l0[4], l1[4], l2[4]; u32x2 a[4], b[4], c[4];
#pragma unroll
        for (int u = 0; u < 4; ++u) { const int t = t0 + u * NGW; if (t < NTOK) {
            l0[u] = LSE[(size_t)t * 4 + h]; l1[u] = LSE[((size_t)NTOK + t) * 4 + h]; l2[u] = LSE[((size_t)2 * NTOK + t) * 4 + h];
            a[u] = *(const u32x2*)(OG + (size_t)t * AO + 4 * lane); b[u] = *(const u32x2*)(OG + ((size_t)NTOK + t) * AO + 4 * lane); c[u] = *(const u32x2*)(OG + ((size_t)2 * NTOK + t) * AO + 4 * lane); } }
#pragma unroll
        for (int u = 0; u < 4; ++u) { const int t = t0 + u * NGW; if (t < NTOK) {
            const float mx = fmaxf(l0[u], fmaxf(l1[u], l2[u])); float w0 = fast_exp2((l0[u] - mx) * LOG2E), w1 = fast_exp2((l1[u] - mx) * LOG2E), w2 = fast_exp2((l2[u] - mx) * LOG2E);
            const float inv = 1.0f / (w0 + w1 + w2); w0 *= inv; w1 *= inv; w2 *= inv;
            u32x2 w; w.x = pk2(w0 * bf_lo(a[u].x) + w1 * bf_lo(b[u].x) + w2 * bf_lo(c[u].x), w0 * bf_hi(a[u].x) + w1 * bf_hi(b[u].x) + w2 * bf_hi(c[u].x));
            w.y = pk2(w0 * bf_lo(a[u].y) + w1 * bf_lo(b[u].y) + w2 * bf_lo(c[u].y), w0 * bf_hi(a[u].y) + w1 * bf_hi(b[u].y) + w2 * bf_hi(c[u].y));
            *(u32x2*)(ATT + (size_t)t * AW + 4 * lane) = w; } }
    }
}

__device__ __forceinline__ void phase_router(const Frame& F0, int l) {
    const Frame F = opaque_frame(F0);
    unsigned char* ws = ws_of(F);
    const bf16* H = (const bf16*)(ws + WS_HB1); unsigned char* FB = (unsigned char*)(ws + WS_AIN);
    const float* MOD = (const float*)(ws + WS_MOD) + (size_t)l * BATCH * 6144;
    const bf16* WRH = (const bf16*)(ws + WS_WRH) + (size_t)l * NE * D; const bf16* WRL = (const bf16*)(ws + WS_WRL) + (size_t)l * NE * D;
    int* TOPI = (int*)(ws + WS_TOPI); float* TOPG = (float*)(ws + WS_TOPG); int* WGH = (int*)(ws + WS_WGH);
    const float* n2g = inp(F, IN_N2G) + l * D; const float* br = inp(F, IN_BR) + l * NE;
    LAS float* LG = (LAS float*)(F.lds + F.wave * 2048);
    LAS int* EX = (LAS int*)(F.lds + 16384);
    LAS int* HIST = (LAS int*)(F.lds + 16384 + 2048);
    LAS float* SC = (LAS float*)(F.lds + 20480); LAS float* SH = SC + D;
    const int lane = F.lane, tl = lane & 15, kq = lane >> 4;
    for (int tile = blockIdx.x; tile < NTILE128; tile += F.G) {
        __syncthreads();
        if (F.tid < 32) HIST[F.tid] = 0;
        const int T = tile * 128 + F.wave * 16 + tl, b = (tile * 128) / SEQ;
        const bf16* hrow = H + (size_t)T * D + 8 * kq;
#pragma unroll
        for (int i = 0; i < 8; ++i) { const int pi = F.wave * 8 + i, e = pi >> 1, hf = pi & 1, c = (64 * hf + lane) ^ (e & 15);
            glds16((unsigned long long)WRH, (unsigned)(e * 2048 + c * 16), (unsigned)(__UINTPTR_TYPE__)F.lds + 32768 + pi * 1024); }
        u32x4 hq[32];
#pragma unroll
        for (int ks = 0; ks < 32; ++ks) hq[ks] = *(const u32x4*)(hrow + 32 * ks);
        { const float* sc2 = MOD + (size_t)b * 6144 + 4 * 1024; const float* sh2 = MOD + (size_t)b * 6144 + 3 * 1024;
          for (int i = F.tid; i < D; i += NTHR) { SC[i] = n2g[i] * (1.0f + sc2[i]); SH[i] = sh2[i]; } }
        float ss = 0.f;
#pragma unroll
        for (int ks = 0; ks < 32; ++ks) { f32x4 a, c; pg8::unpack8(hq[ks], a, c);
            ss += (a[0] * a[0] + a[1] * a[1]) + (a[2] * a[2] + a[3] * a[3]) + (c[0] * c[0] + c[1] * c[1]) + (c[2] * c[2] + c[3] * c[3]); }
        ss += __shfl_xor(ss, 16); ss += __shfl_xor(ss, 32);
        const float rstd = 1.0f / sqrtf(ss * (1.0f / D) + RMS_EPS);
        __syncthreads();
        f32x4 acc0 = {0.f, 0.f, 0.f, 0.f}, acc1 = {0.f, 0.f, 0.f, 0.f};
        const LAS unsigned char* wimg0 = F.lds + 32768 + tl * 2048; const LAS unsigned char* wimg1 = wimg0 + 16 * 2048;
#pragma unroll
        for (int ks = 0; ks < 32; ++ks) {
            { const int c0 = 32 * ks + 8 * kq;
                u32x4 hraw = hq[ks]; asm volatile("" : "+v"(hraw));
                f32x4 a, c; pg8::unpack8(hraw, a, c);
                const f32x4 s0 = *(const LAS f32x4*)(SC + c0), s1 = *(const LAS f32x4*)(SC + c0 + 4), h0 = *(const LAS f32x4*)(SH + c0), h1 = *(const LAS f32x4*)(SH + c0 + 4);
                a = a * rstd * s0 + h0; c = c * rstd * s1 + h1;
                const u32x4 hi = pg8::pack8(a, c); f32x4 ah, ch; pg8::unpack8(hi, ah, ch); const u32x4 lo = pg8::pack8(a - ah, c - ch);
                { u32x2 w8; w8.x = pk4_fp8(a[0] * F8_XSCALE, a[1] * F8_XSCALE, a[2] * F8_XSCALE, a[3] * F8_XSCALE); w8.y = pk4_fp8(c[0] * F8_XSCALE, c[1] * F8_XSCALE, c[2] * F8_XSCALE, c[3] * F8_XSCALE); *(u32x2*)(FB + (size_t)T * D + c0) = w8; }
                const bf16x8 fh = __builtin_bit_cast(bf16x8, hi), fl = __builtin_bit_cast(bf16x8, lo);
                const int wo = (((4 * ks + kq) ^ tl) << 4);
                const bf16x8 wh0 = *(const LAS bf16x8*)(wimg0 + wo), wh1 = *(const LAS bf16x8*)(wimg1 + wo);
                acc0 = __builtin_amdgcn_mfma_f32_16x16x32_bf16(fh, wh0, acc0, 0, 0, 0); acc0 = __builtin_amdgcn_mfma_f32_16x16x32_bf16(fl, wh0, acc0, 0, 0, 0);
                acc1 = __builtin_amdgcn_mfma_f32_16x16x32_bf16(fh, wh1, acc1, 0, 0, 0); acc1 = __builtin_amdgcn_mfma_f32_16x16x32_bf16(fl, wh1, acc1, 0, 0, 0); }
            if ((ks & 3) == 3) __builtin_amdgcn_sched_barrier(0);
        }
        { const float b0 = br[tl], b1 = br[16 + tl];
#pragma unroll
          for (int rg = 0; rg < 4; ++rg) { LG[(4 * kq + rg) * 32 + tl] = acc0[rg] + b0; LG[(4 * kq + rg) * 32 + 16 + tl] = acc1[rg] + b1; } }
        LDS_WAIT();
        if (lane < 16) {
            float v[32];
#pragma unroll
            for (int i = 0; i < 8; ++i) { const f32x4 x = *(const LAS f32x4*)(LG + lane * 32 + 4 * i); v[4 * i] = x[0]; v[4 * i + 1] = x[1]; v[4 * i + 2] = x[2]; v[4 * i + 3] = x[3]; }
            int ti[4]; float tv[4];
#pragma unroll
            for (int k = 0; k < 4; ++k) { float best = -3.0e38f; int bi = 0;
#pragma unroll
                for (int e = 0; e < 32; ++e) { const bool taken = (k > 0 && ti[0] == e) || (k > 1 && ti[1] == e) || (k > 2 && ti[2] == e); if (!taken && v[e] > best) { best = v[e]; bi = e; } }
                ti[k] = bi; tv[k] = best; }
            const float e1 = fast_exp2((tv[1] - tv[0]) * LOG2E), e2 = fast_exp2((tv[2] - tv[0]) * LOG2E), e3 = fast_exp2((tv[3] - tv[0]) * LOG2E); const float inv = 1.0f / (1.0f + e1 + e2 + e3);
            const int Tt = tile * 128 + F.wave * 16 + lane;
            *(i32x4*)(TOPI + (size_t)Tt * 4) = (i32x4){ti[0], ti[1], ti[2], ti[3]}; *(f32x4*)(TOPG + (size_t)Tt * 4) = (f32x4){inv, e1 * inv, e2 * inv, e3 * inv};
            *(LAS i32x4*)(EX + (F.wave * 16 + lane) * 4) = (i32x4){ti[0], ti[1], ti[2], ti[3]};
        }
        __syncthreads();
        __hip_atomic_fetch_add(&HIST[EX[F.tid]], 1, __ATOMIC_RELAXED, __HIP_MEMORY_SCOPE_WORKGROUP);
        __syncthreads();
        if (F.tid < 32) WGH[tile * 32 + F.tid] = HIST[F.tid];
    }
}

__device__ __forceinline__ void phase_positions(const Frame& F0, int l) {
    const Frame F = opaque_frame(F0);
    unsigned char* ws = ws_of(F);
    const int* WGH = (const int*)(ws + WS_WGH); const int* TOPI = (const int*)(ws + WS_TOPI);
    int* POS = (int*)(ws + WS_POS); int* SORT = (int*)(ws + WS_SORT); int* ETAB = (int*)(ws + WS_ETAB);
    LAS int* PT = (LAS int*)F.lds;
    LAS int* PB = PT + 512;
    LAS int* CNT = PB + 512;
    LAS int* BASE = CNT + 32;
    LAS int* WC = BASE + 32;
    const int lane = F.lane;
    for (int tile = blockIdx.x; tile < NTILE128; tile += F.G) {
        __syncthreads();
        const int e = TOPI[(size_t)(tile * 128 + (F.tid >> 2)) * 4 + (F.tid & 3)];
        { const int eh = F.tid & 31, part = F.tid >> 5; int cv[16];
#pragma unroll
          for (int i = 0; i < 16; ++i) cv[i] = WGH[(part * 16 + i) * 32 + eh];
          int tot = 0, bef = 0;
#pragma unroll
          for (int i = 0; i < 16; ++i) { tot += cv[i]; bef += (part * 16 + i < tile) ? cv[i] : 0; }
          PT[part * 32 + eh] = tot; PB[part * 32 + eh] = bef; }
        __syncthreads();
        if (F.tid < 64) {
            const int ex = lane & 31; int tot = 0, bef = 0;
#pragma unroll
            for (int p = 0; p < 16; ++p) { tot += PT[p * 32 + ex]; bef += PB[p * 32 + ex]; }
            int incl = tot, tinc = (tot + 255) >> 8;
#pragma unroll
            for (int o = 1; o < 32; o <<= 1) { const int a = __shfl_up(incl, o), b2 = __shfl_up(tinc, o); if ((lane & 31) >= o) { incl += a; tinc += b2; } }
            const int off = incl - tot, ts = tinc - ((tot + 255) >> 8);
            if (lane < 32) { BASE[ex] = bef + off;
                if (tile == 0) { ETAB[ex] = tot; ETAB[32 + ex] = off; ETAB[64 + ex] = ts; if (ex == 31) { ETAB[96] = tinc; ETAB[128 + l] = tinc; } } } }
        if (tile == 0 && F.tid < 256) SORT[NASG + F.tid] = 0;
        const int tok = tile * 128 + (F.tid >> 2), k = F.tid & 3;
        int rnk = 0, mycnt = 0;
#pragma unroll 1
        for (int E = 0; E < 32; ++E) { const unsigned long long m = __ballot(e == E); if (e == E) rnk = __popcll(m & ((1ull << lane) - 1ull)); if (lane == E) mycnt = __popcll(m); }
        if (lane < 32) WC[F.wave * 32 + lane] = mycnt;
        __syncthreads();
        int wo = 0;
        for (int w = 0; w < F.wave; ++w) wo += WC[w * 32 + e];
        const int pos = BASE[e] + wo + rnk;
        SORT[pos] = tok; POS[(size_t)tok * 4 + k] = pos;
    }
}

__device__ __forceinline__ void phase_loadtab(const Frame& F0) {
    const Frame F = opaque_frame(F0);
    unsigned char* ws = ws_of(F);
    LAS int* tab = (LAS int*)(F.lds + TAB_OFF);
    __syncthreads();
    if (F.tid < 97) tab[F.tid] = ((const int*)(ws + WS_ETAB))[F.tid];
    __syncthreads();
}

struct CbRows { u32x2 y[2][4]; u32x4 h[2]; };
__device__ __forceinline__ void cb_load(CbRows& R, const unsigned char* Y, const bf16* H1, int t, const i32x4& pp, int lane) {
#pragma unroll
    for (int j = 0; j < 2; ++j) { const int c = 8 * lane + 512 * j;
        R.y[j][0] = *(const u32x2*)(Y + (size_t)pp[0] * D + c); R.y[j][1] = *(const u32x2*)(Y + (size_t)pp[1] * D + c); R.y[j][2] = *(const u32x2*)(Y + (size_t)pp[2] * D + c); R.y[j][3] = *(const u32x2*)(Y + (size_t)pp[3] * D + c);
        R.h[j] = *(const u32x4*)(H1 + (size_t)t * D + c); }
}
__device__ __forceinline__ void phase_combine(const Frame& F0, int l) {
    const Frame F = opaque_frame(F0);
    const int gw = F.vcu * NWAVES + F.wave, NGW = F.G * NWAVES;
    unsigned char* ws = ws_of(F);
    const float* in_n1g = inp(F, IN_N1G) + (l + 1 < DEPTH ? (l + 1) * D : 0); const float* in_fg = inp(F, IN_FG); float* outp = (float*)inp(F, IN_OUT);
    const bf16* H1 = (const bf16*)(ws + WS_HB1); bf16* H2 = (bf16*)(ws + WS_HB2); const unsigned char* Y = (const unsigned char*)(ws + WS_Y);
    const int* POS = (const int*)(ws + WS_POS); const float* TOPG = (const float*)(ws + WS_TOPG);
    const float* MOD = (const float*)(ws + WS_MOD); bf16* AIN = (bf16*)(ws + WS_AIN);
    const int lane = F.lane;
    CbRows RA, RB; i32x4 pq[3]; f32x4 gq[4];
#define CB_ROUTE(tt, P, G) do { if ((tt) < NTOK) { P = *(const i32x4*)(POS + (size_t)(tt) * 4); G = *(const f32x4*)(TOPG + (size_t)(tt) * 4); } else { P = (i32x4){0, 0, 0, 0}; G = (f32x4){0.f, 0.f, 0.f, 0.f}; } } while (0)
    { i32x4 p0, p1; CB_ROUTE(gw, p0, gq[0]); CB_ROUTE(gw + NGW, p1, gq[1]); CB_ROUTE(gw + 2 * NGW, pq[0], gq[2]);
      if (gw < NTOK) cb_load(RA, Y, H1, gw, p0, lane);
      if (gw + NGW < NTOK) cb_load(RB, Y, H1, gw + NGW, p1, lane); }
#define CB_STEP(R, t) do { \
        const int b = (t) / SEQ; const float* g2 = MOD + ((size_t)l * BATCH + b) * 6144 + 5 * 1024; \
        const f32x4 gc = gq[0] * (1.0f / F8_YSCALE); \
        float v[2][8]; \
        _Pragma("unroll") for (int j = 0; j < 2; ++j) { const int c = 8 * lane + 512 * j; \
            f32x4 h0, h1; pg8::unpack8(R.h[j], h0, h1); \
            const f32x4 ga = *(const f32x4*)(g2 + c), gb = *(const f32x4*)(g2 + c + 4); \
            float a0[8], a1[8], a2[8], a3[8]; \
            unpk4_fp8(R.y[j][0].x, a0[0], a0[1], a0[2], a0[3]); unpk4_fp8(R.y[j][0].y, a0[4], a0[5], a0[6], a0[7]); \
            unpk4_fp8(R.y[j][1].x, a1[0], a1[1], a1[2], a1[3]); unpk4_fp8(R.y[j][1].y, a1[4], a1[5], a1[6], a1[7]); \
            unpk4_fp8(R.y[j][2].x, a2[0], a2[1], a2[2], a2[3]); unpk4_fp8(R.y[j][2].y, a2[4], a2[5], a2[6], a2[7]); \
            unpk4_fp8(R.y[j][3].x, a3[0], a3[1], a3[2], a3[3]); unpk4_fp8(R.y[j][3].y, a3[4], a3[5], a3[6], a3[7]); \
            _Pragma("unroll") for (int e = 0; e < 8; ++e) { const float sm = gc[0] * a0[e] + gc[1] * a1[e] + gc[2] * a2[e] + gc[3] * a3[e]; \
                v[j][e] = (e < 4 ? h0[e] : h1[e - 4]) + (e < 4 ? ga[e] : gb[e - 4]) * sm; } } \
          \
        { const int t2 = (t) + 2 * NGW; if (t2 < NTOK) cb_load(R, Y, H1, t2, pq[0], lane); \
          gq[0] = gq[1]; gq[1] = gq[2]; CB_ROUTE((t) + 3 * NGW, pq[0], gq[2]); } \
        float sq = 0.f; \
        _Pragma("unroll") for (int j = 0; j < 2; ++j) _Pragma("unroll") for (int e = 0; e < 8; ++e) sq += v[j][e] * v[j][e]; \
        const float rstd = 1.0f / sqrtf(wave_sum(sq) * (1.0f / D) + RMS_EPS); \
        if (l + 1 < DEPTH) { \
            const float* mp = MOD + ((size_t)(l + 1) * BATCH + b) * 6144; \
            _Pragma("unroll") for (int j = 0; j < 2; ++j) { const int c = 8 * lane + 512 * j; \
                u32x4 hw; hw.x = pk2(v[j][0], v[j][1]); hw.y = pk2(v[j][2], v[j][3]); hw.z = pk2(v[j][4], v[j][5]); hw.w = pk2(v[j][6], v[j][7]); \
                *(u32x4*)(H2 + (size_t)(t) * D + c) = hw; \
                float y[8]; \
                _Pragma("unroll") for (int q = 0; q < 2; ++q) { const f32x4 gv = *(const f32x4*)(in_n1g + c + 4 * q), sv = *(const f32x4*)(mp + 1024 + c + 4 * q), hx = *(const f32x4*)(mp + c + 4 * q); \
                    _Pragma("unroll") for (int e = 0; e < 4; ++e) y[4 * q + e] = v[j][4 * q + e] * rstd * gv[e] * (sv[e] + 1.0f) + hx[e]; } \
                if (MK_P2F8) { u32x2 aw; aw.x = pk4_fp8(y[0] * F8_XSCALE, y[1] * F8_XSCALE, y[2] * F8_XSCALE, y[3] * F8_XSCALE); aw.y = pk4_fp8(y[4] * F8_XSCALE, y[5] * F8_XSCALE, y[6] * F8_XSCALE, y[7] * F8_XSCALE); \
                    *(u32x2*)((unsigned char*)AIN + (size_t)(t) * D + c) = aw; } \
                else { u32x4 aw; aw.x = pk2(y[0], y[1]); aw.y = pk2(y[2], y[3]); aw.z = pk2(y[4], y[5]); aw.w = pk2(y[6], y[7]); \
                    *(u32x4*)(AIN + (size_t)(t) * D + c) = aw; } } \
        } else { \
            _Pragma("unroll") for (int j = 0; j < 2; ++j) { const int c = 8 * lane + 512 * j; \
                _Pragma("unroll") for (int q = 0; q < 2; ++q) { const f32x4 gv = *(const f32x4*)(in_fg + c + 4 * q); f32x4 o; \
                    _Pragma("unroll") for (int e = 0; e < 4; ++e) o[e] = v[j][4 * q + e] * rstd * gv[e]; \
                    *(f32x4*)(outp + (size_t)(t) * D + c + 4 * q) = o; } } \
        } } while (0)
    for (int t = gw; t < NTOK; t += 2 * NGW) {
        CB_STEP(RA, t);
        if (t + NGW < NTOK) CB_STEP(RB, t + NGW);
    }
#undef CB_STEP
#undef CB_ROUTE
}

constexpr int PH_PR0 = 0, PH_PR1 = 1, PH_L0 = 2, PH_PER_LAYER = 10, PH_TOTAL = PH_L0 + DEPTH * PH_PER_LAYER;

template <int VARK> __global__ void __launch_bounds__(NTHR, 2) mk_fwd_t(Args args) {
    extern __shared__ __attribute__((aligned(16))) unsigned char lds_raw[];
    Frame F;
    F.lds = (LAS unsigned char*)lds_raw;
    F.MISC = (volatile LAS unsigned*)(F.lds + MISC_OFF);
    F.tid = threadIdx.x; F.lane = F.tid & 63; F.wave = __builtin_amdgcn_readfirstlane(F.tid >> 6);
    F.G = gridDim.x; { const int bx = blockIdx.x; F.vcu = (F.G % 8 == 0) ? (bx % 8) * (F.G / 8) + bx / 8 : bx; }
    F.ws_ = args.ws; F.ctl = (gu32*)(args.ws + WS_CTL);
    for (int u = F.tid; u < (LDS_BYTES - MISC_OFF) / 4; u += NTHR) ((LAS unsigned*)(F.lds + MISC_OFF))[u] = 0u;
    __syncthreads();
    if (F.tid == 0) {
        LAS unsigned long long* pt = (LAS unsigned long long*)(F.lds + MISC_OFF + 64);
#define PT_(i) pt[i] = (unsigned long long)args.in[i]
        PT_(0); PT_(1); PT_(2); PT_(3); PT_(4); PT_(5); PT_(6); PT_(7); PT_(8); PT_(9); PT_(10); PT_(11); PT_(12); PT_(13); PT_(14); PT_(15); PT_(16); PT_(17); PT_(18); PT_(19); PT_(20); PT_(21);
#undef PT_
        pt[IN_POS] = (unsigned long long)args.positions; pt[IN_OUT] = (unsigned long long)args.out;
    }
    __syncthreads();
    XcdBarrier bar; bar.bar = (unsigned*)(F.ctl + CW_BAR); bar.x = 0; bar.st = nullptr;
#if !MK_PER_PHASE
    bar = xcd_barrier_post((unsigned*)(F.ctl + CW_BAR), F.MISC + 8);
#endif
    const int lo = args.ph_lo, hi = args.ph_hi;
    constexpr int VAR = VARK;
#ifndef MK_EN
#define MK_EN 0x1FFF
#endif
#ifndef MK_VAR_EN
#define MK_VAR_EN 0x1FFF
#endif
#define EN(j) (VARK ? (((MK_VAR_EN) >> (j)) & 1) : (((MK_EN) >> (j)) & 1))
#ifndef MK_REP
#define MK_REP 0
#endif
#define RP(j) _Pragma("unroll 1") for (int rr_ = 0; rr_ <= (((MK_REP) >> (j)) & 1) * MK_REPN; ++rr_)
#ifndef MK_REPN
#define MK_REPN 1
#endif
#define IN(k) (lo <= (k) && (k) < hi)
#if MK_PER_PHASE
#define SEAM(k) do { } while (0)
#else
#define SEAM(k) do { if (IN(k) && IN((k) + 1)) xcd_barrier(bar); } while (0)
#endif
    if (EN(0) && IN(PH_PR0)) RP(0) { phase_pr0(F); } SEAM(PH_PR0);
    if (EN(1) && IN(PH_PR1)) RP(1) { phase_pr1(F); } SEAM(PH_PR1);
#define LAYER_BODY(l) do { \
        const int P = PH_L0 + l * PH_PER_LAYER; \
        if (EN(2) && IN(P + 0)) RP(2) { unsigned char* ws = ws_of(F); \
            pg8::PlainSched S; S.T.init(NTOK / 256, INW / 256, F.G, (int)blockIdx.x); S.A = (const char*)(ws + WS_AIN); S.B = (const char*)(ws + WS_WTIN) + (size_t)l * INW * D * (MK_P2F8 ? 1 : 2); S.K = MK_P2F8 ? D / 2 : D; \
            pg8::EpiIn E{(bf16*)(ws + WS_QB), (bf16*)(ws + WS_KB), (bf16*)(ws + WS_VB), (bf16*)(ws + WS_UB), (bf16*)(ws + WS_VGB), (bf16*)(ws + WS_GB), (const float*)(ws + WS_ROPEC), (const float*)(ws + WS_ROPES)}; \
            pg8::gemm_phase<pg8::EpiIn, pg8::PlainSched, false, MK_P2F8 != 0>(F.lds, MK_P2F8 ? D / 2 : D, S, E, nullptr, nullptr, VAR); \
            if (MK_TAILCVT) cvt_tail(F, l == 0 ? 0 : 3, (NTOK / 256) * (INW / 256)); \
        } \
        SEAM(P + 0); \
        if (EN(3) && IN(P + 1)) RP(3) { phase_attn(F); } \
        SEAM(P + 1); \
        if (EN(4) && IN(P + 2)) RP(4) { phase_gmlp(F, l); } \
        if (EN(5) && IN(P + 2)) RP(5) { phase_merge(F); } \
        SEAM(P + 2); \
        if (EN(6) && IN(P + 3)) RP(6) { unsigned char* ws = ws_of(F); \
            pg8::PlainSched S; S.T.init(NTOK / 256, D / 256, F.G, (int)blockIdx.x); S.A = (const char*)(ws + WS_ATT); S.B = (const char*)(ws + WS_WTPA) + (size_t)l * D * AW * 2; S.K = AW; \
            pg8::EpiMrg E{(const bf16*)(ws + WS_GB), (bf16*)(ws + WS_MRG)}; \
            pg8::gemm_phase<pg8::EpiMrg, pg8::PlainSched, false, false, AO / 64>(F.lds, AW, S, E, nullptr, nullptr, VAR); \
        } \
        SEAM(P + 3); \
        if (EN(7) && IN(P + 4)) RP(7) { unsigned char* ws = ws_of(F); const float* MODl = (const float*)(ws + WS_MOD) + (size_t)l * BATCH * 6144; \
            pg8::PlainSched S; S.T.init(NTOK / 256, D / 256, F.G, (int)blockIdx.x); S.A = (const char*)(ws + WS_MRG); S.B = (const char*)(ws + WS_WTO) + (size_t)l * D * D * 2; S.K = D; \
            pg8::EpiRes E{inp(F, IN_X), l == 0 ? (const bf16*)nullptr : (const bf16*)(ws + WS_HB2), (bf16*)(ws + WS_HB1), MODl + 2 * 1024}; \
            pg8::gemm_phase<pg8::EpiRes, pg8::PlainSched, false>(F.lds, D, S, E, nullptr, nullptr, VAR); \
        } \
        SEAM(P + 4); \
        if (EN(8) && IN(P + 5)) RP(8) { phase_router(F, l); } \
        SEAM(P + 5); \
        if (EN(9) && IN(P + 6)) RP(9) { phase_positions(F, l); } \
        if (MK_TAILCVT && l == 1 && IN(P + 6)) cvt_tail(F, 4, 0);         \
        SEAM(P + 6); \
        if (IN(P + 7) || IN(P + 8)) phase_loadtab(F); \
        if (EN(10) && IN(P + 7)) RP(10) { unsigned char* ws = ws_of(F); \
            LAS int* tab = (LAS int*)(F.lds + TAB_OFF); \
            pg8::MoeSched S; S.T.init(tab[96], 2048 / 256, F.G, (int)blockIdx.x); S.A = (const char*)(ws + WS_AIN); S.B = (const char*)(ws + WS_W1T) + (size_t)l * NE * 2048 * D; S.K = D / 2; S.bstride = (size_t)2048 * D; S.tab = tab; S.gather = true; \
            pg8::EpiSwiglu E{(const float*)(ws + WS_B1P) + (size_t)l * NE * 2048, (unsigned char*)(ws + WS_ACT)}; \
            pg8::gemm_phase<pg8::EpiSwiglu, pg8::MoeSched, true, true>(F.lds, D / 2, S, E, (const int*)(ws + WS_SORT), (LAS int*)(F.lds + IDX_OFF), VAR); \
            if (MK_TAILCVT && l == 0) cvt_tail(F, 1, tab[96] * (2048 / 256)); \
        } \
        SEAM(P + 7); \
        if (EN(11) && IN(P + 8)) RP(11) { unsigned char* ws = ws_of(F); \
            LAS int* tab = (LAS int*)(F.lds + TAB_OFF); \
            pg8::MoeSched S; S.T.init(tab[96], D / 256, F.G, (int)blockIdx.x); S.A = (const char*)(ws + WS_ACT); S.B = (const char*)(ws + WS_W2T) + (size_t)l * NE * D * DFF; S.K = DFF / 2; S.bstride = (size_t)D * DFF; S.tab = tab; S.gather = false; \
            pg8::EpiY E{inp(F, IN_B2) + (size_t)l * NE * D, (unsigned char*)(ws + WS_Y)}; \
            pg8::gemm_phase<pg8::EpiY, pg8::MoeSched, false, true>(F.lds, DFF / 2, S, E, nullptr, nullptr, VAR); \
            if (MK_TAILCVT && l == 0) cvt_tail(F, 2, tab[96] * (D / 256)); \
        } \
        SEAM(P + 8); \
        if (EN(12) && IN(P + 9)) RP(12) { phase_combine(F, l); } \
        if (l + 1 < DEPTH) SEAM(P + 9); \
    } while (0)
    LAYER_BODY(0);
    LAYER_BODY(1);
#undef LAYER_BODY
#undef IN
#undef SEAM
}

#define mk_fwd mk_fwd_t<0>
extern "C" void kernel_launch(void* const* d_in, const int* in_sizes, int n_in, void* d_out, int out_size, void* d_ws, size_t ws_size, hipStream_t stream) {
    static int grid = 0;
    if (grid == 0) {
        if (n_in != 22 || in_sizes[0] != NTOK * D || out_size != NTOK * D || ws_size < WS_END) { fprintf(stderr, "kernel_launch: unexpected shapes (n_in %d, in0 %d, out %d, ws %zu)\n", n_in, n_in > 0 ? in_sizes[0] : -1, out_size, ws_size); grid = -1; return; }
        int dev = 0, cus = 0, per_cu = 0;
        if (hipGetDevice(&dev) != hipSuccess || hipDeviceGetAttribute(&cus, hipDeviceAttributeMultiprocessorCount, dev) != hipSuccess) { grid = -1; return; }
#ifdef MK_VARIANT
        (void)hipFuncSetAttribute((const void*)mk_fwd_t<MK_VARIANT>, hipFuncAttributeMaxDynamicSharedMemorySize, LDS_BYTES);
#endif
        if (hipFuncSetAttribute((const void*)mk_fwd, hipFuncAttributeMaxDynamicSharedMemorySize, LDS_BYTES) != hipSuccess) { fprintf(stderr, "kernel_launch: hipFuncSetAttribute failed\n"); grid = -1; return; }
        if (hipOccupancyMaxActiveBlocksPerMultiprocessor(&per_cu, (const void*)mk_fwd, NTHR, LDS_BYTES) != hipSuccess || per_cu < 1) fprintf(stderr, "kernel_launch: occupancy query reports %d\n", per_cu);
        (void)hipGetLastError();
        grid = cus;
    }
    if (grid < 0) return;
    if (hipMemsetAsync((char*)d_ws + WS_CTL, 0, CTL_ZERO_BYTES, stream) != hipSuccess) return;
    Args a{};
    for (int i = 0; i < 22; ++i) a.in[i] = (const float*)d_in[i];
    a.positions = (const int*)d_in[IN_POS]; a.out = (float*)d_out; a.ws = (unsigned char*)d_ws;
#if MK_PER_PHASE
    for (int p = 0; p < PH_TOTAL; ++p) { a.ph_lo = p; a.ph_hi = p + 1; hipLaunchKernelGGL(mk_fwd, dim3(grid), dim3(NTHR), LDS_BYTES, stream, a);
#ifdef MK_HREP
        { const int ty = p < 2 ? p : 2 + (p - 2) % PH_PER_LAYER; if (ty == MK_HREP) {

#ifdef MK_VARIANT
            hipLaunchKernelGGL(mk_fwd_t<MK_VARIANT>, dim3(grid), dim3(NTHR), LDS_BYTES, stream, a);
#else
            hipLaunchKernelGGL(mk_fwd, dim3(grid), dim3(NTHR), LDS_BYTES, stream, a);
#endif
        } }
#endif
    }
#else
    a.ph_lo = 0; a.ph_hi = PH_TOTAL; hipLaunchKernelGGL(mk_fwd, dim3(grid), dim3(NTHR), LDS_BYTES, stream, a);
#endif
}
```

```cpp
#include <hip/hip_runtime.h>
#include <cstdio>
#include <cstdint>

#ifndef MK_PER_PHASE
#define MK_PER_PHASE 0
#endif
#ifndef MK_RELAX
#define MK_TAILIPW 3
#define MK_TAILIPW_P9 2
#define MK_TAILIPW_L1P8 4
#define MK_TAILCVT 1
#define MK_P4F8 1
#define MK_P5F8 1
#define MK_RELAX 1
#endif
#ifndef MK_F8SCALED
#define MK_F8SCALED 1
#endif
#ifndef MK_CHECKS
#define MK_CHECKS 0
#endif

constexpr int D = 1024, BATCH = 8, SEQ = 4096, NTOK = BATCH * SEQ, DEPTH = 2;
constexpr int AW = 768, AO = 256, GW = 512, INW = 5376, NE = 32, TOPK = 4, NASG = NTOK * TOPK, DFF = 1024;
constexpr float RMS_EPS = 1e-5f, LN_EPS = 1e-5f;
constexpr int NWAVES = 8, NTHR = 512;
constexpr int NTILE128 = NTOK / 128;
constexpr float LOG2E = 1.4426950408889634f, LN2 = 0.6931471805599453f;
constexpr float QSCALE = 0.125f * LOG2E;
constexpr float F8_WSCALE = 64.0f, F8_XSCALE = 4.0f, F8_YSCALE = 8.0f;
constexpr int F8_WS_E8M0 = 0x79797979, F8_XS_E8M0 = 0x7d7d7d7d;

constexpr size_t MiB = 1u << 20;
constexpr size_t WS_CTL = 0, CTL_ZERO_BYTES = 64 * 1024;
constexpr size_t WS_MOD = 1 * MiB;
constexpr size_t WS_ROPEC = 2 * MiB;
constexpr size_t WS_ROPES = 6 * MiB;
constexpr size_t WS_WRH = 10 * MiB;
constexpr size_t WS_WRL = 10 * MiB + 512 * 1024;
constexpr size_t WS_WSB = 11 * MiB;
constexpr size_t WS_B1P = 12 * MiB;
constexpr size_t WS_WTIN = 13 * MiB;
constexpr size_t WS_WTPA = 34 * MiB;
constexpr size_t WS_WTPG = 35 * MiB;
constexpr size_t WS_WTO = 37 * MiB;
constexpr size_t WS_W1T = 41 * MiB;
constexpr size_t WS_W2T = 297 * MiB;
constexpr size_t WS_HB1 = 425 * MiB;
constexpr size_t WS_HB2 = 553 * MiB;
constexpr size_t WS_AIN = 681 * MiB;
constexpr size_t WS_QB = 745 * MiB, WS_KB = 793 * MiB, WS_VB = 841 * MiB;
constexpr size_t WS_UB = 889 * MiB, WS_VGB = 921 * MiB;
constexpr size_t WS_GB = 953 * MiB;
constexpr size_t WS_OG = 1081 * MiB;
constexpr size_t WS_LSE = 1129 * MiB;
constexpr size_t WS_ATT = 1131 * MiB;
constexpr size_t WS_GM = 1147 * MiB;
constexpr size_t WS_TMP = 1179 * MiB;
constexpr size_t WS_MRG = 1243 * MiB;
constexpr size_t WS_TOPI = 1307 * MiB;
constexpr size_t WS_TOPG = 1307 * MiB + 512 * 1024;
constexpr size_t WS_POS = 1308 * MiB;
constexpr size_t WS_WGH = 1308 * MiB + 512 * 1024;
constexpr size_t WS_ETAB = 1308 * MiB + 640 * 1024;
constexpr size_t WS_SORT = 1309 * MiB;
constexpr size_t WS_ACT = 1310 * MiB;
constexpr size_t WS_Y = 1567 * MiB;
constexpr size_t WS_END = 1824 * MiB;
static_assert(WS_ACT + (size_t)(NASG + 256) * 1024 * 2 <= WS_Y && WS_Y + (size_t)(NASG + 256) * 1024 * 2 <= WS_END, "ws map");

constexpr int CW_TMO = 0, CW_CODE = 1, CW_BAR = 4096, CW_ERR = 16384;

constexpr int RING_BYTES = 131072;
constexpr int BIAS_OFF = 131072;
constexpr int IDX_OFF = 139264;
constexpr int TAB_OFF = 141312;
constexpr int MISC_OFF = 141824;
constexpr int LDS_BYTES = 147456;

#define GAS __attribute__((address_space(1)))
#define LAS __attribute__((address_space(3)))
typedef unsigned short bf16;
typedef float f32x2 __attribute__((ext_vector_type(2)));
typedef float f32x4 __attribute__((ext_vector_type(4)));
typedef float f32x16 __attribute__((ext_vector_type(16)));
typedef short bf16x8 __attribute__((ext_vector_type(8)));
typedef short s16x4 __attribute__((ext_vector_type(4)));
typedef unsigned u32x2 __attribute__((ext_vector_type(2)));
typedef unsigned u32x4 __attribute__((ext_vector_type(4)));
typedef int i32x4 __attribute__((ext_vector_type(4)));
typedef __bf16 bf16x2_t __attribute__((ext_vector_type(2)));
typedef GAS unsigned gu32;
#define RLX_AGENT __ATOMIC_RELAXED, __HIP_MEMORY_SCOPE_AGENT
#define LDS_WAIT() asm volatile("s_waitcnt lgkmcnt(0)" ::: "memory")
#define LDS_BARRIER() do { asm volatile("s_waitcnt lgkmcnt(0)" ::: "memory"); __builtin_amdgcn_s_barrier(); asm volatile("" ::: "memory"); } while (0)
#define VM_WAIT() asm volatile("s_waitcnt vmcnt(0)" ::: "memory")

__device__ __forceinline__ unsigned pk2(float lo, float hi) { f32x2 v = {lo, hi}; bf16x2_t b = __builtin_convertvector(v, bf16x2_t); return __builtin_bit_cast(unsigned, b); }
__device__ __forceinline__ float clamp448(float x) { return fminf(fmaxf(x, -448.0f), 448.0f); }
__device__ __forceinline__ unsigned pk4_fp8(float a, float b, float c, float d) {
    unsigned t = 0; t = __builtin_amdgcn_cvt_pk_fp8_f32(clamp448(a), clamp448(b), t, false); t = __builtin_amdgcn_cvt_pk_fp8_f32(clamp448(c), clamp448(d), t, true); return t; }
__device__ __forceinline__ unsigned pk4_fp8_nc(float a, float b, float c, float d) {
    unsigned t = 0; t = __builtin_amdgcn_cvt_pk_fp8_f32(a, b, t, false); t = __builtin_amdgcn_cvt_pk_fp8_f32(c, d, t, true); return t; }
__device__ __forceinline__ void unpk4_fp8(unsigned w, float& a, float& b, float& c, float& d) { const f32x2 lo = __builtin_amdgcn_cvt_pk_f32_fp8((int)w, false), hi = __builtin_amdgcn_cvt_pk_f32_fp8((int)w, true); a = lo[0]; b = lo[1]; c = hi[0]; d = hi[1]; }
__device__ __forceinline__ void unpk8_fp8(u32x2 w, f32x4& a, f32x4& b) { const f32x2 p0 = __builtin_amdgcn_cvt_pk_f32_fp8((int)w.x, false), p1 = __builtin_amdgcn_cvt_pk_f32_fp8((int)w.x, true), p2 = __builtin_amdgcn_cvt_pk_f32_fp8((int)w.y, false), p3 = __builtin_amdgcn_cvt_pk_f32_fp8((int)w.y, true);
    a = (f32x4){p0[0], p0[1], p1[0], p1[1]}; b = (f32x4){p2[0], p2[1], p3[0], p3[1]}; }
__device__ __forceinline__ float bf_lo(unsigned w) { return __uint_as_float(w << 16); }
__device__ __forceinline__ float bf_hi(unsigned w) { return __uint_as_float(w & 0xffff0000u); }
__device__ __forceinline__ float bf2f(bf16 b) { return __uint_as_float(((unsigned)b) << 16); }
__device__ __forceinline__ float wave_sum(float v) {
#pragma unroll
    for (int o = 1; o < 64; o <<= 1) v += __shfl_xor(v, o);
    return v;
}
__device__ __forceinline__ float fast_exp2(float x) { return __builtin_amdgcn_exp2f(x); }
__device__ __forceinline__ float fast_rcp(float x) { return __builtin_amdgcn_rcpf(x); }
__device__ __forceinline__ float sigmoidf_(float x) { return fast_rcp(1.0f + fast_exp2(-LOG2E * x)); }
__device__ __forceinline__ float gelu_tanh(float x) {
    constexpr float C1 = -2.0f * 0.7978845608028654f * LOG2E, C3 = C1 * 0.044715f;
    return x * fast_rcp(1.0f + fast_exp2(x * __builtin_fmaf(x * x, C3, C1)));
}

__device__ __forceinline__ void glds16(unsigned long long sbase, unsigned voff, unsigned ldsaddr) {
    unsigned keep; asm volatile("s_mov_b32 %0, m0\n\ts_mov_b32 m0, %3\n\ts_nop 0\n\tglobal_load_lds_dwordx4 %1, %2\n\ts_mov_b32 m0, %0" : "=&s"(keep) : "v"(voff), "s"(sbase), "s"(ldsaddr) : "memory");
}

#define XB_TMO      128
#define XB_XCNT(j)  (256  + 64 * (j))
#define XB_XSUB(j)  (1280 + 64 * (j))
#define XB_XGEN(j)  (2304 + 64 * (j))
#define XB_TOP      3328
#define XB_TOPGEN   3392
#define XCD_BAR_WORDS 3456
#define XB_SPIN_CAP (1u << 18)
__device__ __forceinline__ unsigned xb_ld(unsigned* p)              { return __hip_atomic_load(p, __ATOMIC_RELAXED, __HIP_MEMORY_SCOPE_AGENT); }
__device__ __forceinline__ unsigned xb_add(unsigned* p, unsigned v) { return __hip_atomic_fetch_add(p, v, __ATOMIC_RELAXED, __HIP_MEMORY_SCOPE_AGENT); }
__device__ __forceinline__ unsigned xb_xcc_id() { return (unsigned)__builtin_amdgcn_s_getreg((3 << 11) | 20) & 0xFu; }
#define XB_SPIN(cond, bar) do { unsigned _sp = 0; while (cond) { __builtin_amdgcn_s_sleep(1); \
    if ((++_sp & 255u) == 0u) { if (xb_ld(&(bar)[XB_TMO])) break; if (_sp > XB_SPIN_CAP) { atomicAdd(&(bar)[XB_TMO], 1u); break; } } } } while (0)
__device__ __forceinline__ int lane_id_v() { int l; asm volatile("v_mbcnt_lo_u32_b32 %0, -1, 0\n\tv_mbcnt_hi_u32_b32 %0, -1, %0" : "=v"(l)); return l; }
struct XcdBarrier { unsigned* bar; unsigned x; volatile LAS unsigned* st; int wave; };
__device__ __forceinline__ XcdBarrier xcd_barrier_post(unsigned* bar, volatile LAS unsigned* st, int wave) {
    XcdBarrier b; b.bar = bar; b.x = xb_xcc_id(); b.st = st; b.wave = wave;
    if (wave == 0 && lane_id_v() == 0) (void)xb_add(&bar[XB_XCNT(b.x)], 1u);
    return b;
}
__device__ __forceinline__ void xcd_barrier_complete(unsigned* bar, unsigned x, unsigned& nloc, unsigned& nx) {
    const unsigned G = gridDim.x * gridDim.y * gridDim.z;
    unsigned sum, cnt, mine, sp = 0u;
    for (;;) {
        sum = 0u; cnt = 0u; mine = 0u;
#pragma unroll
        for (unsigned j = 0; j < 16; ++j) { const unsigned c = xb_ld(&bar[XB_XCNT(j)]); sum += c; cnt += (c > 0u) ? 1u : 0u; mine = (j == x) ? c : mine; }
        if (sum == G) break;
        __builtin_amdgcn_s_sleep(1);
        if ((++sp & 255u) == 0u) { if (xb_ld(&bar[XB_TMO])) break; if (sp > XB_SPIN_CAP) { atomicAdd(&bar[XB_TMO], 1u); break; } }
    }
    nloc = mine > 0u ? mine : 1u; nx = cnt > 0u ? cnt : 1u;
}
__device__ __forceinline__ void xcd_barrier(const XcdBarrier& b) {
    asm volatile("s_waitcnt vmcnt(0)" ::: "memory");
    __syncthreads();
    if (b.wave == 0 && lane_id_v() == 0) {
        unsigned* bar = b.bar;
        __builtin_amdgcn_s_waitcnt(0);
        unsigned nloc = b.st[0], nx = b.st[1];
        if (nloc == 0u) { xcd_barrier_complete(bar, b.x, nloc, nx); b.st[0] = nloc; b.st[1] = nx; }
        const unsigned old = xb_add(&bar[XB_XSUB(b.x)], 1u);
        const unsigned gen = old / nloc;
        if (old + 1u == (gen + 1u) * nloc) {
            __builtin_amdgcn_fence(__ATOMIC_RELEASE, "agent");
            asm volatile("s_waitcnt vmcnt(0)" ::: "memory");
            const unsigned og = xb_add(&bar[XB_TOP], 1u);
            const unsigned tg = og / nx;
            if (og + 1u == (tg + 1u) * nx) {
#pragma unroll
                for (unsigned j = 0; j < 16; ++j) (void)__hip_atomic_fetch_add(&bar[XB_XGEN(j)], 1u, __ATOMIC_RELAXED, __HIP_MEMORY_SCOPE_AGENT);
            }
            XB_SPIN(xb_ld(&bar[XB_XGEN(b.x)]) == gen, bar);
            __builtin_amdgcn_fence(__ATOMIC_ACQUIRE, "agent");
            asm volatile("s_waitcnt vmcnt(0)" ::: "memory");
        } else {
            XB_SPIN(xb_ld(&bar[XB_XGEN(b.x)]) == gen, bar);
            __builtin_amdgcn_fence(__ATOMIC_ACQUIRE, "agent");
            asm volatile("s_waitcnt vmcnt(0)" ::: "memory");
        }
    }
    __syncthreads();
}

namespace pg8 {
constexpr int BM = 256, BK = 64, HALF = 128, HTB = HALF * BK * 2, STAGE_BYTES = 8 * HTB, NXCD = 8, WGM = 8;
__host__ __device__ __forceinline__ int lds_byte(int r, int c) { const int st = (r >> 4) * 2 + (c >> 5), rr = r & 15, cc = c & 31, ob = rr * 64 + cc * 2; return st * 1024 + (ob ^ (((ob >> 9) & 1) << 5)); }
__host__ __device__ __forceinline__ void stage_rc(int b, int& R, int& C) { const int st = b / 1024, sb = b % 1024, swz = sb ^ (((sb >> 9) & 1) << 5); R = (st >> 1) * 16 + swz / 64; C = (st & 1) * 32 + (swz % 64) / 2; }
__host__ __device__ __forceinline__ int perm32(int rho) { const int n = rho >> 4, i = rho & 15; return 8 * (i >> 2) + 4 * n + (i & 3); }

struct Unit { int pm, pn; const char* A; const char* B; int e, rows, row0; };

struct TileOrder {
    int nM, nN, nwg, G, c;
    __device__ __forceinline__ void init(int nM_, int nN_, int G_, int c_) { nM = nM_; nN = nN_; nwg = nM * nN; G = G_; c = c_; }
    __device__ __forceinline__ bool tile(int i, int& pm, int& pn) const {
        const long L = (long)i * G + c; if (L >= nwg) return false;
        int wgid = (int)L; { const int q = nwg / NXCD, r = nwg % NXCD, xcd = wgid % NXCD, off = wgid / NXCD; wgid = (xcd < r ? xcd * (q + 1) : r * (q + 1) + (xcd - r) * q) + off; }
        const int nig = WGM * nN, gid = wgid / nig, fm = gid * WGM, gsz = (nM - fm) < WGM ? (nM - fm) : WGM;
        pm = fm + ((wgid % nig) % gsz); pn = (wgid % nig) / gsz; return true;
    }
};
struct PlainSched {
    TileOrder T; const char* A; const char* B; int K;
    __device__ __forceinline__ bool next(int i, Unit& u) const {
        if (!T.tile(i, u.pm, u.pn)) return false;
        u.A = A + (size_t)u.pm * 256 * K * 2; u.B = B + (size_t)u.pn * 256 * K * 2; u.e = 0; u.rows = 256; u.row0 = u.pm * 256; return true;
    }
};
struct MoeSched {
    TileOrder T; const char* A; const char* B; int K; size_t bstride  ; const LAS int* tab; bool gather;
    int tsv, etsv, cntv, offv;
    __device__ __forceinline__ void load() {
        const int lane = lane_id_v(), l31 = lane & 31;
        tsv = (lane < 32) ? tab[64 + lane + 1] : 0x7fffffff; etsv = tab[64 + l31]; cntv = tab[l31]; offv = tab[32 + l31]; }
    __device__ __forceinline__ bool next(int i, Unit& u) const {
        int pmg;
        if (!T.tile(i, pmg, u.pn)) return false;
        const unsigned long long m = __ballot(tsv <= pmg);
        const int e = __builtin_amdgcn_readfirstlane(__popcll(m));
        const int t = pmg - __builtin_amdgcn_readlane(etsv, e);
        const int cnt = __builtin_amdgcn_readlane(cntv, e), off = __builtin_amdgcn_readlane(offv, e);
        u.pm = pmg; u.e = e; u.row0 = off + 256 * t; u.rows = (cnt - 256 * t) < 256 ? (cnt - 256 * t) : 256;
        u.A = gather ? A : A + (size_t)u.row0 * K * 2;
        u.B = B + (size_t)e * bstride + (size_t)u.pn * 256 * K * 2;
        return true;
    }
};

typedef f32x4 Acc[2][2][4][2];

template <class Epi, class Sched, bool GATHER, bool F8 = false, int MIDK = 0>
__device__ __forceinline__ void gemm_phase(LAS unsigned char* lds, const int K, const Sched& S, const Epi& E, const int* gidx, LAS int* idxl, const int wave, const int variant = 0) {
    int tid_ = wave * 64 + lane_id_v(); asm volatile("" : "+v"(tid_));
    const int tid = tid_, wid = __builtin_amdgcn_readfirstlane(tid >> 6), lane = tid & 63, wr = wid >> 2, wc = wid & 3, fr = lane & 15, fq = lane >> 4;
    const int nt = K / BK;
    LAS unsigned char* const lds_top = lds;
    unsigned voffA[2], voffB[2];
#pragma unroll
    for (int i = 0; i < 2; ++i) { int R, C; stage_rc(tid * 16 + i * 8192, R, C); const int Rb = Epi::PERM ? ((R & ~31) + perm32(R & 31)) : R;
        voffA[i] = (unsigned)(R * K + C) * 2u; voffB[i] = (unsigned)(Rb * K + C) * 2u; }
    const size_t kstep = (size_t)(BK * 2);
    const size_t hstep = (size_t)HALF * K * 2;
    const unsigned ldsw = (unsigned)wid * 1024u;
    const int aoff = lds_byte(wr * 64 + fr, fq * 8), boff = lds_byte(wc * 32 + fr, fq * 8);
    unsigned vc00 = 0, vc01 = 0, vc10 = 0, vc11 = 0;
#define PG8_GOFF(ip, pre) do { int R0_, C0_, R1_, C1_; stage_rc(tid * 16, R0_, C0_); stage_rc(tid * 16 + 8192, R1_, C1_); \
        const int i00 = (ip)[R0_], i01 = (ip)[R1_], i10 = (ip)[128 + R0_], i11 = (ip)[128 + R1_]; \
        pre##00 = (unsigned)(i00 * K + C0_) * 2u; pre##01 = (unsigned)(i01 * K + C1_) * 2u; pre##10 = (unsigned)(i10 * K + C0_) * 2u; pre##11 = (unsigned)(i11 * K + C1_) * 2u; } while (0)
#define PG8_SA(b, h) (((b) * 2 + (h)) * HTB)
#define PG8_SB(b, h) ((4 + (b) * 2 + (h)) * HTB)
#define PG8_GL(sbase, voff32, dst) do { if (variant & 4) break; unsigned keep_; asm volatile("s_mov_b32 %0, m0\n\ts_mov_b32 m0, %3\n\ts_nop 0\n\tglobal_load_lds_dwordx4 %1, %2\n\ts_mov_b32 m0, %0" \
        : "=&s"(keep_) : "v"(voff32), "s"(sbase), "s"((unsigned)(__UINTPTR_TYPE__)(dst)) : "memory"); } while (0)
#define PG8_STAGE(bufoff, gbase, voff) do { const unsigned long long _b = (unsigned long long)(gbase); PG8_GL(_b, (voff)[0], lds + (bufoff) + ldsw); PG8_GL(_b, (voff)[1], lds + (bufoff) + ldsw + 8192); } while (0)
#define PG8_STAGE2(bufoff, gbase, v0, v1) do { const unsigned long long _b = (unsigned long long)(gbase); PG8_GL(_b, v0, lds + (bufoff) + ldsw); PG8_GL(_b, v1, lds + (bufoff) + ldsw + 8192); } while (0)
#define PG8_STAGE_A(bufoff, p, h, nx) do { if constexpr (GATHER) { if (h == 0) { if (nx) PG8_STAGE2(bufoff, p, u00, u01); else PG8_STAGE2(bufoff, p, vc00, vc01); } else { if (nx) PG8_STAGE2(bufoff, p, u10, u11); else PG8_STAGE2(bufoff, p, vc10, vc11); } } \
        else PG8_STAGE(bufoff, (p) + (h) * hstep, voffA); } while (0)
#define PG8_LDA(dst, b, h) do { _Pragma("unroll") for (int m = 0; m < 4; ++m) _Pragma("unroll") for (int k = 0; k < 2; ++k) dst[m][k] = *(const LAS bf16x8*)(lds + PG8_SA(b, h) + aoff + m * 2048 + k * 1024); } while (0)
#define PG8_LDB(dst, b, h) do { _Pragma("unroll") for (int n = 0; n < 2; ++n) _Pragma("unroll") for (int k = 0; k < 2; ++k) dst[n][k] = *(const LAS bf16x8*)(lds + PG8_SB(b, h) + boff + n * 2048 + k * 1024); } while (0)
#define PG8_CAT(x0, x1) __builtin_shufflevector(__builtin_bit_cast(i32x4, x0), __builtin_bit_cast(i32x4, x1), 0, 1, 2, 3, 4, 5, 6, 7)
#define PG8_MMA(ai, bj, At, Bt) do { if (variant & 2) break; __builtin_amdgcn_s_setprio(1); \
        if constexpr (F8) { _Pragma("unroll") for (int m = 0; m < 4; ++m) _Pragma("unroll") for (int n = 0; n < 2; ++n) \
            { if (MK_F8SCALED) asm volatile("v_mfma_scale_f32_16x16x128_f8f6f4 %0, %1, %2, %0, %3, %4 op_sel_hi:[0,0,0]" : "+v"(acc[ai][bj][m][n]) : "v"(PG8_CAT(Bt[n][0], Bt[n][1])), "v"(PG8_CAT(At[m][0], At[m][1])), "v"(n == 1 ? sc_w1 : sc_w), "v"(sc_x)); \
              else asm volatile("v_mfma_f32_16x16x128_f8f6f4 %0, %1, %2, %0" : "+v"(acc[ai][bj][m][n]) : "v"(PG8_CAT(Bt[n][0], Bt[n][1])), "v"(PG8_CAT(At[m][0], At[m][1]))); } } \
        else { _Pragma("unroll") for (int m = 0; m < 4; ++m) _Pragma("unroll") for (int n = 0; n < 2; ++n) _Pragma("unroll") for (int k = 0; k < 2; ++k) \
            asm volatile("v_mfma_f32_16x16x32_bf16 %0, %1, %2, %0" : "+v"(acc[ai][bj][m][n]) : "v"(Bt[n][k]), "v"(At[m][k])); } \
        __builtin_amdgcn_s_setprio(0); } while (0)
#define PG8_WAIT_V(n) asm volatile("s_waitcnt vmcnt(" #n ")" ::: "memory")
#define PG8_WAIT_VR() do { if (fae) asm volatile("s_waitcnt vmcnt(%0)" :: "n"(8 + Epi::NST) : "memory"); else PG8_WAIT_V(8); } while (0)
#define PG8_WAIT_L(n) asm volatile("s_waitcnt lgkmcnt(" #n ")" ::: "memory")
#define PG8_BAR __builtin_amdgcn_s_barrier()
#define PG8_SCHED __builtin_amdgcn_sched_barrier(0)
    const int sc_w1 = (int)((unsigned)F8_WS_E8M0 + (unsigned)Epi::N1_EXP * 0x01010101u);
    const int sc_w = F8_WS_E8M0, sc_x = (int)((unsigned)F8_XS_E8M0 + (unsigned)Epi::OUT_EXP * 0x01010101u);
    Unit cur, nxt; int ui = 0;
    if (!S.next(0, cur)) return;
#if MK_SKEW > 0
    { const unsigned long long t0 = __builtin_amdgcn_s_memrealtime(), dl = (unsigned long long)(((blockIdx.x >> 3) & 3) * MK_SKEW);
      while (__builtin_amdgcn_s_memrealtime() - t0 < dl) __builtin_amdgcn_s_sleep(8); }
#endif
    Acc acc;
#define PG8_ACC_INIT(slot) do { if constexpr (Epi::HAS_VEC) { const int li_ = lane_id_v(); E.init(acc, wc, li_ >> 4, (const LAS float*)(lds_top + BIAS_OFF + (slot) * 1024)); } else { \
        _Pragma("unroll") for (int a = 0; a < 2; ++a) _Pragma("unroll") for (int b = 0; b < 2; ++b) _Pragma("unroll") for (int m = 0; m < 4; ++m) _Pragma("unroll") for (int n = 0; n < 2; ++n) acc[a][b][m][n] = (f32x4){0.f, 0.f, 0.f, 0.f}; } } while (0)
    if constexpr (Epi::HAS_VEC) { if (wid == 4) { const unsigned long long vb_ = (unsigned long long)E.vec_ptr(cur); PG8_GL(vb_, (unsigned)(lane * 16), lds_top + BIAS_OFF); } }
    bf16x8 At[4][2], B0[2][2], B1[2][2];
    const char* cA = cur.A; const char* cB = cur.B;
    if constexpr (GATHER) {
        const int* gp_ = gidx + cur.row0; PG8_GOFF(gp_, vc);
        asm volatile("s_waitcnt vmcnt(0)" ::: "memory");
    }
    unsigned u00 = 0, u01 = 0, u10 = 0, u11 = 0;
    PG8_STAGE(PG8_SB(0, 0), cB, voffB); PG8_STAGE(PG8_SB(0, 1), cB + hstep, voffB); PG8_STAGE_A(PG8_SA(0, 0), cA, 0, false); PG8_STAGE_A(PG8_SA(0, 1), cA, 1, false);
    if (wr == 1) PG8_BAR;
    PG8_WAIT_V(2); PG8_BAR;
    PG8_STAGE(PG8_SB(1, 0), cB + kstep, voffB); PG8_STAGE_A(PG8_SA(1, 0), cA + kstep, 0, false); PG8_STAGE(PG8_SB(1, 1), cB + hstep + kstep, voffB);
    PG8_WAIT_V(6); PG8_BAR;
    PG8_ACC_INIT(0);
    for (;;) {
        const bool has_next = S.next(ui + 1, nxt);
        if constexpr (Epi::HAS_VEC) { if (has_next && wid == 4) { const unsigned long long vb_ = (unsigned long long)E.vec_ptr(nxt); PG8_GL(vb_, (unsigned)(lane * 16), lds_top + BIAS_OFF + ((ui + 1) % 3) * 1024); } }
        const char* nA = has_next ? nxt.A : cA; const char* nB = has_next ? nxt.B : cB;
        if constexpr (GATHER) {
            if (has_next && wid < 4) __builtin_amdgcn_global_load_lds((const unsigned*)(gidx + nxt.row0 + wid * 64 + lane), (LAS unsigned*)(idxl + ((ui + 1) & 1) * 256 + wid * 64), 4, 0, 0);
        }
#pragma unroll 1
        for (int t = 0; t < nt; t += 2) {
            const bool last = (t == nt - 2);
            const char* a1 = cA + (size_t)(t + 1) * kstep;
            const char* a2 = last ? nA : cA + (size_t)(t + 2) * kstep; const char* b2 = last ? nB : cB + (size_t)(t + 2) * kstep;
            const char* a3 = a2 + kstep; const char* b3 = b2 + kstep;
            const bool fae = MK_RELAX && (t == 0) && (ui > 0);
            if constexpr (GATHER) {
                u00 = vc00; u01 = vc01; u10 = vc10; u11 = vc11;
                if (last && has_next) { const LAS int* ip = idxl + ((ui + 1) & 1) * 256; PG8_GOFF(ip, u); }
            }
            PG8_LDB(B0, 0, 0); PG8_LDB(B1, 0, 1); PG8_SCHED; PG8_LDA(At, 0, 0); if (!fae) PG8_STAGE_A(PG8_SA(1, 1), a1, 1, false);
            PG8_WAIT_VR(); PG8_WAIT_L(0); PG8_BAR; PG8_MMA(0, 0, At, B0); PG8_MMA(0, 1, At, B1); PG8_BAR; PG8_SCHED;
            PG8_LDA(At, 0, 1); PG8_STAGE(PG8_SB(0, 0), b2, voffB); PG8_STAGE(PG8_SB(0, 1), b2 + hstep, voffB); PG8_STAGE_A(PG8_SA(0, 0), a2, 0, true);
            PG8_WAIT_VR(); PG8_WAIT_L(0); PG8_BAR; PG8_MMA(1, 0, At, B0); PG8_MMA(1, 1, At, B1); PG8_BAR; PG8_SCHED;
            PG8_LDB(B0, 1, 0); PG8_LDB(B1, 1, 1); PG8_SCHED; PG8_LDA(At, 1, 0); PG8_STAGE_A(PG8_SA(0, 1), a2, 1, true);
            PG8_WAIT_VR(); PG8_WAIT_L(0); PG8_BAR; PG8_MMA(0, 0, At, B0); PG8_MMA(0, 1, At, B1); PG8_BAR; PG8_SCHED;
            PG8_LDA(At, 1, 1); PG8_STAGE(PG8_SB(1, 0), b3, voffB); PG8_STAGE(PG8_SB(1, 1), b3 + hstep, voffB); PG8_STAGE_A(PG8_SA(1, 0), a3, 0, true);
            PG8_WAIT_V(8); PG8_WAIT_L(0); PG8_BAR; PG8_MMA(1, 0, At, B0); PG8_MMA(1, 1, At, B1); PG8_BAR; PG8_SCHED;
            if constexpr (MIDK > 0) { if (t + 2 == MIDK) { asm volatile("s_nop 15\n\ts_nop 15" ::: "memory"); const int le_ = lane_id_v(); E.mid(acc, cur, wr, wc, le_ & 15, le_ >> 4); } }
        }
        asm volatile("s_nop 15\n\ts_nop 15" ::: "memory");
        if (wr == 0) PG8_BAR;
        if constexpr (F8 && !MK_F8SCALED) {
#pragma unroll
            for (int a = 0; a < 2; ++a)
#pragma unroll
                for (int b = 0; b < 2; ++b)
#pragma unroll
                    for (int m = 0; m < 4; ++m)
#pragma unroll
                        for (int n = 0; n < 2; ++n) acc[a][b][m][n] *= 1.0f / (F8_WSCALE * F8_XSCALE); }
        if (MK_RELAX && has_next) {
            if constexpr (GATHER) PG8_STAGE2(PG8_SA(1, 1), nA + kstep, u10, u11); else PG8_STAGE(PG8_SA(1, 1), nA + kstep + hstep, voffA); }
        if (variant & 8) cur.rows = 0;
        if (variant & 16) cur.row0 = NASG;
        if (!(variant & 1)) { const int le_ = lane_id_v(); E(acc, cur, wr, wc, le_ & 15, le_ >> 4, (const LAS float*)(lds_top + BIAS_OFF + (ui % 3) * 1024)); }
        if (!has_next) break;
        PG8_ACC_INIT((ui + 1) % 3);
        cur = nxt; cA = nA; cB = nB; ++ui;
        if constexpr (GATHER) { vc00 = u00; vc01 = u01; vc10 = u10; vc11 = u11; }
        if (wr == 1) PG8_BAR;
    }
    PG8_WAIT_V(0);
    PG8_BAR;
#undef PG8_SA
#undef PG8_SB
#undef PG8_GL
#undef PG8_STAGE
#undef PG8_STAGE2
#undef PG8_STAGE_A
#undef PG8_GOFF
#undef PG8_LDA
#undef PG8_LDB
#undef PG8_MMA
#undef PG8_ACC_INIT
#undef PG8_CAT
#undef PG8_WAIT_V
#undef PG8_WAIT_VR
#undef PG8_WAIT_L
#undef PG8_BAR
#undef PG8_SCHED
}

__device__ __forceinline__ u32x4 pack8(f32x4 a, f32x4 b) { u32x4 w; w.x = pk2(a[0], a[1]); w.y = pk2(a[2], a[3]); w.z = pk2(b[0], b[1]); w.w = pk2(b[2], b[3]); return w; }
#ifndef MK_P2F8
#define MK_P2F8 1
#endif
#ifndef MK_NT
#define MK_NT 0
#endif
#ifndef MK_SKEW
#define MK_SKEW 0
#endif
template <class T> __device__ __forceinline__ void st_epi(T* p, T v) { if (MK_NT) __builtin_nontemporal_store(v, p); else *p = v; }

struct EpiIn {
    static constexpr bool PERM = true; static constexpr int NST = 16; static constexpr bool HAS_VEC = false; static constexpr int OUT_EXP = 0; static constexpr int N1_EXP = 0;
    bf16 *Q, *Kb, *V, *U, *VG, *G; const float* ropec; const float* ropes;
    __device__ __forceinline__ void operator()(const Acc& acc, const Unit& u, int wr, int wc, int fr, int fq, const LAS float* lb) const {
        const int pn = u.pn, row0 = u.pm * 256 + wr * 64 + fr, cl = wc * 32 + 8 * fq;
        if (pn < 6) {
            bf16* base = (pn < 3) ? Q : Kb; const int g = (pn < 3) ? pn : pn - 3; const float sc = (pn < 3) ? QSCALE : 1.0f;
            const int i4 = 4 * (4 * (wc & 1) + fq);
            f32x4 cs[2][4], sn[2][4];
#pragma unroll
            for (int ai = 0; ai < 2; ++ai)
#pragma unroll
                for (int m = 0; m < 4; ++m) { const int row = row0 + ai * 128 + m * 16; cs[ai][m] = *(const f32x4*)(ropec + (size_t)row * 32 + i4); sn[ai][m] = *(const f32x4*)(ropes + (size_t)row * 32 + i4); }
#pragma unroll
            for (int ai = 0; ai < 2; ++ai) {
#pragma unroll
                for (int m = 0; m < 4; ++m) { const int row = row0 + ai * 128 + m * 16;
#pragma unroll
                    for (int bj = 0; bj < 2; ++bj) { const f32x4 x1 = acc[ai][bj][m][0], x2 = acc[ai][bj][m][1];
                        const f32x4 o1 = (x1 * cs[ai][m] - x2 * sn[ai][m]) * sc, o2 = (x2 * cs[ai][m] + x1 * sn[ai][m]) * sc;
                        st_epi((u32x4*)(base + (size_t)row * AW + g * 256 + bj * 128 + cl), pack8(o1, o2)); } }
                __builtin_amdgcn_sched_barrier(0); }
        } else if (pn < 9) {
            const int cb = (pn - 6) * 256;
#pragma unroll
            for (int ai = 0; ai < 2; ++ai)
#pragma unroll
                for (int m = 0; m < 4; ++m) { const int row = row0 + ai * 128 + m * 16;
#pragma unroll
                    for (int bj = 0; bj < 2; ++bj) st_epi((u32x4*)(V + (size_t)row * AW + cb + bj * 128 + cl), pack8(acc[ai][bj][m][0], acc[ai][bj][m][1]));
                    __builtin_amdgcn_sched_barrier(0); }
        } else if (pn < 13) {
            bf16* base = (pn < 11) ? U : VG; const int cb = ((pn - 9) & 1) * 256;
#pragma unroll
            for (int ai = 0; ai < 2; ++ai)
#pragma unroll
                for (int m = 0; m < 4; ++m) { const int row = row0 + ai * 128 + m * 16;
#pragma unroll
                    for (int bj = 0; bj < 2; ++bj) { f32x4 a = acc[ai][bj][m][0], b = acc[ai][bj][m][1];
#pragma unroll
                        for (int j = 0; j < 4; ++j) { a[j] = gelu_tanh(a[j]); b[j] = gelu_tanh(b[j]); }
                        st_epi((u32x4*)(base + (size_t)row * GW + cb + bj * 128 + cl), pack8(a, b)); }
                    __builtin_amdgcn_sched_barrier(0); }
        } else {
            const int cb = (pn - 13) * 256;
#pragma unroll
            for (int ai = 0; ai < 2; ++ai)
#pragma unroll
                for (int m = 0; m < 4; ++m) { const int row = row0 + ai * 128 + m * 16;
#pragma unroll
                    for (int bj = 0; bj < 2; ++bj) { f32x4 a = acc[ai][bj][m][0], b = acc[ai][bj][m][1];
#pragma unroll
                        for (int j = 0; j < 4; ++j) { a[j] = fast_rcp(0.00390625f + fast_exp2(__builtin_fmaf(a[j], -LOG2E, -8.0f))); b[j] = fast_rcp(0.00390625f + fast_exp2(__builtin_fmaf(b[j], -LOG2E, -8.0f))); }
                        u32x2 w8; w8.x = pk4_fp8_nc(a[0], a[1], a[2], a[3]); w8.y = pk4_fp8_nc(b[0], b[1], b[2], b[3]);
                        st_epi((u32x2*)((unsigned char*)G + (size_t)row * 2048 + cb + bj * 128 + cl), w8); }
                    __builtin_amdgcn_sched_barrier(0); }
        }
    }
};
__device__ __forceinline__ void unpack8(u32x4 w, f32x4& a, f32x4& b) { a = (f32x4){bf_lo(w.x), bf_hi(w.x), bf_lo(w.y), bf_hi(w.y)}; b = (f32x4){bf_lo(w.z), bf_hi(w.z), bf_lo(w.w), bf_hi(w.w)}; }
struct EpiMrg {
    static constexpr bool PERM = true; static constexpr int NST = 16; static constexpr bool HAS_VEC = false; static constexpr int OUT_EXP = MK_P5F8 ? -6 : 0; static constexpr int N1_EXP = 0;
    const bf16* G; bf16* O;
    __device__ __forceinline__ void mid(Acc& acc, const Unit& u, int wr, int wc, int fr, int fq) const {
        const unsigned char* G8 = (const unsigned char*)G;
        const int row0 = u.pm * 256 + wr * 64 + fr, c0 = u.pn * 256 + wc * 32 + 8 * fq;
        u32x2 wa[2][4][2], wg[2][4][2];
#pragma unroll
        for (int ai = 0; ai < 2; ++ai)
#pragma unroll
            for (int m = 0; m < 4; ++m)
#pragma unroll
                for (int bj = 0; bj < 2; ++bj) { const size_t o = (size_t)(row0 + ai * 128 + m * 16) * 2048 + c0 + bj * 128; wa[ai][m][bj] = *(const u32x2*)(G8 + o); wg[ai][m][bj] = *(const u32x2*)(G8 + o + 1024); }
#pragma unroll
        for (int ai = 0; ai < 2; ++ai) {
#pragma unroll
            for (int m = 0; m < 4; ++m)
#pragma unroll
                for (int bj = 0; bj < 2; ++bj) { f32x4 a0, a1, g0, g1; unpk8_fp8(wa[ai][m][bj], a0, a1); unpk8_fp8(wg[ai][m][bj], g0, g1);
#pragma unroll
                    for (int j = 0; j < 4; ++j) { acc[ai][bj][m][0][j] *= a0[j] * fast_rcp(fmaxf(g0[j], 1e-30f)); acc[ai][bj][m][1][j] *= a1[j] * fast_rcp(fmaxf(g1[j], 1e-30f)); } }
            asm volatile("" ::: "memory"); __builtin_amdgcn_sched_barrier(0); }
    }
    __device__ __forceinline__ void operator()(const Acc& acc, const Unit& u, int wr, int wc, int fr, int fq, const LAS float* lb) const {
        const unsigned char* G8 = (const unsigned char*)G;
        const int row0 = u.pm * 256 + wr * 64 + fr, c0 = u.pn * 256 + wc * 32 + 8 * fq;
        u32x2 wg[2][4][2];
#pragma unroll
        for (int ai = 0; ai < 2; ++ai)
#pragma unroll
            for (int m = 0; m < 4; ++m)
#pragma unroll
                for (int bj = 0; bj < 2; ++bj) wg[ai][m][bj] = *(const u32x2*)(G8 + (size_t)(row0 + ai * 128 + m * 16) * 2048 + 1024 + c0 + bj * 128);
#pragma unroll
        for (int ai = 0; ai < 2; ++ai) {
#pragma unroll
            for (int m = 0; m < 4; ++m) { const int row = row0 + ai * 128 + m * 16;
#pragma unroll
                for (int bj = 0; bj < 2; ++bj) { f32x4 g0, g1; unpk8_fp8(wg[ai][m][bj], g0, g1);
                    if (MK_P5F8) { const f32x4 o0 = acc[ai][bj][m][0] * g0, o1 = acc[ai][bj][m][1] * g1; u32x2 w8; w8.x = pk4_fp8(o0[0], o0[1], o0[2], o0[3]); w8.y = pk4_fp8(o1[0], o1[1], o1[2], o1[3]);
                        st_epi((u32x2*)((unsigned char*)O + (size_t)row * D + c0 + bj * 128), w8); }
                    else st_epi((u32x4*)(O + (size_t)row * D + c0 + bj * 128), pack8(acc[ai][bj][m][0] * g0 * (1.0f / 256.0f), acc[ai][bj][m][1] * g1 * (1.0f / 256.0f))); } }
            asm volatile("" ::: "memory"); __builtin_amdgcn_sched_barrier(0); }
    }
};
struct EpiRes {
    static constexpr bool PERM = true; static constexpr int NST = 16; static constexpr bool HAS_VEC = false; static constexpr int OUT_EXP = 0; static constexpr int N1_EXP = 0;
    const float* Hf; const bf16* Hb; bf16* Hout; const float* g1;
    __device__ __forceinline__ void operator()(const Acc& acc, const Unit& u, int wr, int wc, int fr, int fq, const LAS float* lb) const {
        const int row0 = u.pm * 256 + wr * 64 + fr, c0 = u.pn * 256 + wc * 32 + 8 * fq;
        const float* gp = g1 + (size_t)((u.pm * 256) / SEQ) * 6144;
        f32x4 gv[2][2];
#pragma unroll
        for (int bj = 0; bj < 2; ++bj) { gv[bj][0] = *(const f32x4*)(gp + c0 + bj * 128); gv[bj][1] = *(const f32x4*)(gp + c0 + bj * 128 + 4); }
        if (Hb) {
            u32x4 hw[2][4][2];
#pragma unroll
            for (int ai = 0; ai < 2; ++ai)
#pragma unroll
                for (int m = 0; m < 4; ++m)
#pragma unroll
                    for (int bj = 0; bj < 2; ++bj) hw[ai][m][bj] = *(const u32x4*)(Hb + (size_t)(row0 + ai * 128 + m * 16) * D + c0 + bj * 128);
#pragma unroll
            for (int ai = 0; ai < 2; ++ai) {
#pragma unroll
                for (int m = 0; m < 4; ++m)
#pragma unroll
                    for (int bj = 0; bj < 2; ++bj) { const size_t o = (size_t)(row0 + ai * 128 + m * 16) * D + c0 + bj * 128; f32x4 h0, h1; unpack8(hw[ai][m][bj], h0, h1);
                        st_epi((u32x4*)(Hout + o), pack8(h0 + gv[bj][0] * acc[ai][bj][m][0], h1 + gv[bj][1] * acc[ai][bj][m][1])); }
                asm volatile("" ::: "memory"); __builtin_amdgcn_sched_barrier(0); }
        } else {
#pragma unroll
            for (int ai = 0; ai < 2; ++ai)
#pragma unroll
                for (int mp = 0; mp < 2; ++mp) {
                    f32x4 hx[2][2][2];
#pragma unroll
                    for (int mm = 0; mm < 2; ++mm)
#pragma unroll
                        for (int bj = 0; bj < 2; ++bj) { const size_t o = (size_t)(row0 + ai * 128 + (2 * mp + mm) * 16) * D + c0 + bj * 128; hx[mm][bj][0] = *(const f32x4*)(Hf + o); hx[mm][bj][1] = *(const f32x4*)(Hf + o + 4); }
#pragma unroll
                    for (int mm = 0; mm < 2; ++mm)
#pragma unroll
                        for (int bj = 0; bj < 2; ++bj) { const int m = 2 * mp + mm; const size_t o = (size_t)(row0 + ai * 128 + m * 16) * D + c0 + bj * 128;
                            st_epi((u32x4*)(Hout + o), pack8(hx[mm][bj][0] + gv[bj][0] * acc[ai][bj][m][0], hx[mm][bj][1] + gv[bj][1] * acc[ai][bj][m][1])); }
                    asm volatile("" ::: "memory"); __builtin_amdgcn_sched_barrier(0); }
        }
    }
};
struct EpiSwiglu {
    static constexpr bool PERM = true; static constexpr int NST = 4; static constexpr bool HAS_VEC = true; static constexpr int OUT_EXP = 0; static constexpr int N1_EXP = 2;
    const float* b1p; unsigned char* ACT;
    __device__ __forceinline__ const float* vec_ptr(const Unit& u) const { return b1p + (size_t)u.e * 2048 + u.pn * 256; }
    __device__ __forceinline__ void init(Acc& acc, int wc, int fq, const LAS float* lb) const {
        const LAS float* bp = lb + wc * 32 + 8 * fq;
#pragma unroll
        for (int bj = 0; bj < 2; ++bj) { const f32x4 b0 = *(const LAS f32x4*)(bp + bj * 128), b1 = *(const LAS f32x4*)(bp + bj * 128 + 4) * F8_XSCALE + F8_XSCALE;
#pragma unroll
            for (int ai = 0; ai < 2; ++ai)
#pragma unroll
                for (int m = 0; m < 4; ++m) { acc[ai][bj][m][0] = b0; acc[ai][bj][m][1] = b1; } } }
    __device__ __forceinline__ void operator()(const Acc& acc, const Unit& u, int wr, int wc, int fr, int fq, const LAS float* lb) const {
        float clo = -6.0f * F8_XSCALE, chi = 8.0f * F8_XSCALE; asm volatile("" : "+v"(clo), "+v"(chi));
#pragma unroll
        for (int ai = 0; ai < 2; ++ai)
#pragma unroll
            for (int mp = 0; mp < 2; ++mp) {
                u32x2 wq[2];
#pragma unroll
                for (int mm = 0; mm < 2; ++mm) { const int m = 2 * mp + mm;
                    f32x4 o[2];
#pragma unroll
                    for (int bj = 0; bj < 2; ++bj) { const f32x4 gl = acc[ai][bj][m][0];
#pragma unroll
                        for (int j = 0; j < 4; ++j) { const float xg = fminf(gl[j], 7.0f), l4 = __builtin_amdgcn_fmed3f(acc[ai][bj][m][1][j], clo, chi); o[bj][j] = (xg * fast_rcp(1.0f + fast_exp2(xg * (-1.702f * LOG2E)))) * l4; } }
                    wq[mm].x = pk4_fp8_nc(o[0][0], o[0][1], o[0][2], o[0][3]); wq[mm].y = pk4_fp8_nc(o[1][0], o[1][1], o[1][2], o[1][3]); }
                { const auto sx = __builtin_amdgcn_permlane16_swap(wq[0].x, wq[1].x, false, false), sy = __builtin_amdgcn_permlane16_swap(wq[0].y, wq[1].y, false, false);
                    const int rl = ai * 128 + wr * 64 + (2 * mp + (fq & 1)) * 16 + fr;
                    const int rr = (rl < u.rows) ? (u.row0 + rl) : (NASG + rl);
                    st_epi((u32x4*)(ACT + (size_t)rr * DFF + u.pn * 128 + 8 * (4 * wc + (fq & 2))), (u32x4){sx[0], sy[0], sx[1], sy[1]}); }
                __builtin_amdgcn_sched_barrier(0); }
    }
};
struct EpiY {
    static constexpr bool PERM = true; static constexpr int NST = 8; static constexpr bool HAS_VEC = true; static constexpr int OUT_EXP = 3; static constexpr int N1_EXP = 0;
    const float* b2; unsigned char* Y;
    __device__ __forceinline__ const float* vec_ptr(const Unit& u) const { return b2 + (size_t)u.e * 1024 + u.pn * 256; }
    __device__ __forceinline__ void init(Acc& acc, int wc, int fq, const LAS float* lb) const {
        const int cl = 64 * wc + 16 * fq;
#pragma unroll
        for (int bj = 0; bj < 2; ++bj) { const f32x4 b0 = *(const LAS f32x4*)(lb + cl + 8 * bj) * F8_YSCALE, b1 = *(const LAS f32x4*)(lb + cl + 8 * bj + 4) * F8_YSCALE;
#pragma unroll
            for (int ai = 0; ai < 2; ++ai)
#pragma unroll
                for (int m = 0; m < 4; ++m) { acc[ai][bj][m][0] = b0; acc[ai][bj][m][1] = b1; } } }
    __device__ __forceinline__ void operator()(const Acc& acc, const Unit& u, int wr, int wc, int fr, int fq, const LAS float* lb) const {
        const int cl = 64 * wc + 16 * fq, c0 = u.pn * 256 + cl;
        float c448 = 448.0f; asm volatile("" : "+v"(c448));
#pragma unroll
        for (int ai = 0; ai < 2; ++ai)
#pragma unroll
            for (int m = 0; m < 4; ++m) { const int rl = ai * 128 + wr * 64 + m * 16 + fr;
                const int rr = (rl < u.rows) ? (u.row0 + rl) : (NASG + rl);
                u32x4 w;
#pragma unroll
                for (int bj = 0; bj < 2; ++bj) { f32x4 y0, y1;
#pragma unroll
                    for (int e = 0; e < 4; ++e) { y0[e] = __builtin_amdgcn_fmed3f(acc[ai][bj][m][0][e], -c448, c448); y1[e] = __builtin_amdgcn_fmed3f(acc[ai][bj][m][1][e], -c448, c448); }
                    w[2 * bj] = pk4_fp8_nc(y0[0], y0[1], y0[2], y0[3]); w[2 * bj + 1] = pk4_fp8_nc(y1[0], y1[1], y1[2], y1[3]); }
                st_epi((u32x4*)(Y + (size_t)rr * D + c0), w);
                __builtin_amdgcn_sched_barrier(0); }
    }
};
}

enum { IN_X = 0, IN_C, IN_POS, IN_WADA, IN_BADA, IN_N1G, IN_WIN, IN_WS, IN_BS, IN_LNG, IN_LNB, IN_WPA, IN_WPG, IN_WO, IN_N2G, IN_WR, IN_BR, IN_W1, IN_B1, IN_W2, IN_B2, IN_FG, IN_OUT };
struct Args { const float* in[22]; const int* positions; float* out; unsigned char* ws; int ph_lo, ph_hi; int variant, pad; };
struct Frame {
    LAS unsigned char* lds; volatile LAS unsigned* MISC; gu32* ctl;
    int tid, lane, wave, vcu, G;
    unsigned char* ws_;
};
__device__ __forceinline__ unsigned char* ws_of(const Frame& F) { unsigned long long p = (unsigned long long)F.ws_; asm volatile("" : "+s"(p)); return (unsigned char*)(GAS unsigned char*)p; }
__device__ __forceinline__ Frame opaque_frame(const Frame& F0) { Frame F = F0; asm volatile("" : "+s"(F.wave), "+s"(F.vcu), "+s"(F.G)); F.lane = lane_id_v(); F.tid = F.wave * 64 + F.lane; asm volatile("" : "+v"(F.tid)); return F; }
__device__ __forceinline__ const float* inp(const Frame& F, int i) {
    const volatile LAS unsigned* t = F.MISC + 16 + 2 * i; const unsigned lo = __builtin_amdgcn_readfirstlane(t[0]), hi = __builtin_amdgcn_readfirstlane(t[1]);
    return (const float*)(const GAS float*)(((unsigned long long)hi << 32) | lo); }

template <int MODE> __device__ __forceinline__ int dest_row(int n) {
    if (MODE == 1) {
        if (n < 2 * AW) { const int hb = n & ~63, d = n & 63, half = d >> 5, f = d & 31; return hb + 8 * (f >> 2) + 4 * half + (f & 3); }
        return n;
    } else if (MODE == 2) {
        const int ac = n >> 1, typ = n & 1, pn = ac >> 7, al = ac & 127, q8 = al >> 3, bj = (al >> 2) & 1, j = al & 3, wc = q8 >> 2, fq = q8 & 3;
        return 256 * pn + 128 * bj + 32 * wc + 8 * fq + 4 * typ + j;
    }
    if (MODE == 3) {
        const int l = n & 255; return (n & ~255) + 128 * ((l >> 3) & 1) + 32 * (l >> 6) + 8 * ((l >> 4) & 3) + (l & 7); }
    return n;
}
template <int MODE> __device__ __forceinline__ void cvt_item(const float* W, int K, int N, bf16* WT, LAS float* scr, int item, int lane, int ldk = 0, int koff = 0) {
    if (ldk == 0) ldk = K;
    const int nblk = N / 64, kb = item / nblk, nb = item % nblk, k0 = kb * 64, n0 = nb * 64;
    const int lr = lane >> 4, lc = (lane & 15) * 4;
    f32x4 v[16];
#pragma unroll
    for (int i = 0; i < 16; ++i) v[i] = *(const f32x4*)(W + (size_t)(k0 + 4 * i + lr) * N + n0 + lc);
#pragma unroll
    for (int i = 0; i < 16; ++i) { LAS float* s = scr + (4 * i + lr) * 65 + lc; s[0] = v[i][0]; s[1] = v[i][1]; s[2] = v[i][2]; s[3] = v[i][3]; }
    LDS_WAIT(); asm volatile("" ::: "memory");
    const int kc = lane & 7;
#pragma unroll
    for (int jj = 0; jj < 8; ++jj) { const int n = (lane >> 3) + 8 * jj; const LAS float* s = scr + (8 * kc) * 65 + n;
        u32x4 o; o.x = pk2(s[0], s[65]); o.y = pk2(s[2 * 65], s[3 * 65]); o.z = pk2(s[4 * 65], s[5 * 65]); o.w = pk2(s[6 * 65], s[7 * 65]);
        *(u32x4*)(WT + (size_t)dest_row<MODE>(n0 + n) * ldk + koff + k0 + 8 * kc) = o; }
    LDS_WAIT(); asm volatile("" ::: "memory");
}

template <int MODE> __device__ __forceinline__ void cvt_item8(const float* W, int K, int N, unsigned char* WT, LAS unsigned char* scr, int item, int lane, int ldk = 0, int koff = 0) {
    if (ldk == 0) ldk = K;
    const int nblk = N / 64, kb = item / nblk, nb = item % nblk, k0 = kb * 128, n0 = nb * 64;
    const int lr = lane >> 4, lc = (lane & 15) * 4;
    f32x4 v[2][16];
#pragma unroll
    for (int hf = 0; hf < 2; ++hf)
#pragma unroll
        for (int i = 0; i < 16; ++i) v[hf][i] = __builtin_nontemporal_load((const f32x4*)(W + (size_t)(k0 + 64 * hf + 16 * lr + i) * N + n0 + lc));
#pragma unroll
    for (int hf = 0; hf < 2; ++hf) {
#pragma unroll
        for (int c = 0; c < 4; ++c) { u32x4 w;
#pragma unroll
            for (int d = 0; d < 4; ++d) w[d] = pk4_fp8(v[hf][4 * d][c] * F8_WSCALE, v[hf][4 * d + 1][c] * F8_WSCALE, v[hf][4 * d + 2][c] * F8_WSCALE, v[hf][4 * d + 3][c] * F8_WSCALE);
            *(LAS u32x4*)(scr + (lc + c) * 144 + 64 * hf + 16 * lr) = w; }
    }
    LDS_WAIT(); asm volatile("" ::: "memory");
    const int ch = lane & 7;
#pragma unroll
    for (int jj = 0; jj < 8; ++jj) { const int n = (lane >> 3) + 8 * jj;
        const u32x4 o = *(const LAS u32x4*)(scr + n * 144 + 16 * ch); u32x4* dp = (u32x4*)(WT + (size_t)dest_row<MODE>(n0 + n) * ldk + koff + k0 + 16 * ch);
        if (MODE >= 2) __builtin_nontemporal_store(o, dp); else *dp = o; }
    LDS_WAIT(); asm volatile("" ::: "memory");
}

__device__ __forceinline__ void modnorm_store(const f32x4 (&v)[4], const float* g, const float* sc, const float* sh, bf16* orow, int lane) {
    float s = 0.f;
#pragma unroll
    for (int j = 0; j < 4; ++j) s += (v[j][0] * v[j][0] + v[j][1] * v[j][1]) + (v[j][2] * v[j][2] + v[j][3] * v[j][3]);
    const float rstd = 1.0f / sqrtf(wave_sum(s) * (1.0f / D) + RMS_EPS);
#pragma unroll
    for (int j = 0; j < 4; ++j) { const int c = 4 * lane + 256 * j; const f32x4 gv = *(const f32x4*)(g + c), sv = *(const f32x4*)(sc + c), hv = *(const f32x4*)(sh + c);
        const f32x4 y = v[j] * rstd * gv * (sv + 1.0f) + hv;
        if (MK_P2F8) *(unsigned*)((unsigned char*)orow + c) = pk4_fp8(y[0] * F8_XSCALE, y[1] * F8_XSCALE, y[2] * F8_XSCALE, y[3] * F8_XSCALE);
        else { u32x2 w; w.x = pk2(y[0], y[1]); w.y = pk2(y[2], y[3]); *(u32x2*)(orow + c) = w; } }
}

__device__ __forceinline__ void modnorm_store_lds(const f32x4 (&v)[4], const LAS float* sg, const LAS float* sh, unsigned char* orow8, int lane) {
    float s = 0.f;
#pragma unroll
    for (int j = 0; j < 4; ++j) s += (v[j][0] * v[j][0] + v[j][1] * v[j][1]) + (v[j][2] * v[j][2] + v[j][3] * v[j][3]);
    const float rstd = 1.0f / sqrtf(wave_sum(s) * (1.0f / D) + RMS_EPS);
#pragma unroll
    for (int j = 0; j < 4; ++j) { const int c = 4 * lane + 256 * j; const f32x4 gs = *(const LAS f32x4*)(sg + c), hv = *(const LAS f32x4*)(sh + c);
        const f32x4 y = v[j] * rstd * gs + hv;
        *(unsigned*)(orow8 + c) = pk4_fp8(y[0] * F8_XSCALE, y[1] * F8_XSCALE, y[2] * F8_XSCALE, y[3] * F8_XSCALE); }
}

__device__ __forceinline__ void phase_pr0(const Frame& F0) {
    const Frame F = opaque_frame(F0);
    unsigned char* ws = ws_of(F);
    const float* in_c = inp(F, IN_C); const float* in_wada = inp(F, IN_WADA); const float* in_bada = inp(F, IN_BADA); const int* in_pos = (const int*)inp(F, IN_POS);
    const float* in_wr = inp(F, IN_WR); const float* in_ws = inp(F, IN_WS); const float* in_b1 = inp(F, IN_B1);
    {
        LAS float* sl = (LAS float*)F.lds;
        LAS float* red = (LAS float*)(F.lds + 32768);
        float* MOD = (float*)(ws + WS_MOD);
        for (int i = F.tid; i < BATCH * D; i += NTHR) { const int b = i >> 10, k = i & 1023; const float cv = in_c[i]; sl[k * 8 + b] = cv * sigmoidf_(cv); }
        __syncthreads();
        for (int it = blockIdx.x; it < DEPTH * 128; it += F.G) {
            const int l = it / 128, cl_ = F.lane < 48 ? F.lane : 47, col = (it % 128) * 48 + cl_;
            const float* W = in_wada + (size_t)l * D * 6144 + col;
            float a[8];
#pragma unroll
            for (int b = 0; b < 8; ++b) a[b] = 0.f;
            const int kb = F.wave * 128;
#pragma unroll 1
            for (int k0 = 0; k0 < 128; k0 += 64) {
                float wv[64];
#pragma unroll
                for (int k = 0; k < 64; ++k) wv[k] = W[(size_t)(kb + k0 + k) * 6144];
                __builtin_amdgcn_sched_barrier(0);
#pragma unroll
                for (int k = 0; k < 64; ++k) { const float w = wv[k]; const f32x4 s0 = *(const LAS f32x4*)(sl + (kb + k0 + k) * 8), s1 = *(const LAS f32x4*)(sl + (kb + k0 + k) * 8 + 4);
                    a[0] += s0[0] * w; a[1] += s0[1] * w; a[2] += s0[2] * w; a[3] += s0[3] * w; a[4] += s1[0] * w; a[5] += s1[1] * w; a[6] += s1[2] * w; a[7] += s1[3] * w;
                    if ((k & 7) == 7) __builtin_amdgcn_sched_barrier(0); } }
#pragma unroll
            for (int b = 0; b < 8; ++b) red[(F.wave * 8 + b) * 64 + F.lane] = a[b];
            __syncthreads();
            { const int b = F.wave; float s = 0.f;
#pragma unroll
              for (int w = 0; w < 8; ++w) s += red[(w * 8 + b) * 64 + F.lane];
              if (F.lane < 48) MOD[((size_t)l * BATCH + b) * 6144 + col] = s + in_bada[l * 6144 + col]; }
            __syncthreads();
        }
        __syncthreads();
    }
    const int gw = F.vcu * NWAVES + F.wave, NGW = F.G * NWAVES;
    const int gt = F.vcu * NTHR + F.tid, NGT = F.G * NTHR;
    {
        float* RC = (float*)(ws + WS_ROPEC); float* RS = (float*)(ws + WS_ROPES);
        bf16* WRH = (bf16*)(ws + WS_WRH); bf16* WRL = (bf16*)(ws + WS_WRL); bf16* WSB = (bf16*)(ws + WS_WSB); float* B1P = (float*)(ws + WS_B1P);
        constexpr int NRP = NTOK * 32, NWR = DEPTH * NE * D, NWS = DEPTH * 4 * 128 * 128, NB1 = DEPTH * NE * 2048;
        auto wr_src = [&](int i) { const int l = i / (NE * D), e = (i / D) % NE, d = i % D; return ((size_t)l * D + d) * NE + e; };
        int pz[8];
#pragma unroll
        for (int u = 0; u < 8; ++u) { const int i = gt + u * NGT; pz[u] = (i < NRP) ? in_pos[i >> 5] : 0; }
        float w1 = (gt < NWR) ? in_wr[wr_src(gt)] : 0.f, w2 = (gt < NWS) ? in_ws[gt] : 0.f, w3 = (gt < NB1) ? in_b1[gt] : 0.f;
        const float invf0 = (float)exp(-(double)(gt & 31) * (9.210340371976184 / 32.0));
        for (int i0 = gt; i0 < NRP; i0 += 8 * NGT) {
#pragma unroll
            for (int u = 0; u < 8; ++u) { const int i = i0 + u * NGT; if (i < NRP) { const int f = i & 31;
                const float invf = ((NGT & 31) == 0) ? invf0 : (float)exp(-(double)f * (9.210340371976184 / 32.0));
                const float ang = (float)pz[u] * invf;
                const double x = (double)ang; const double k = rint(x * 0.15915494309189535); const float r = (float)(x - k * 6.283185307179586);
                RC[i] = __cosf(r); RS[i] = __sinf(r); } }
            if (i0 + 8 * NGT < NRP) {
#pragma unroll
                for (int u = 0; u < 8; ++u) { const int i = i0 + (8 + u) * NGT; pz[u] = (i < NRP) ? in_pos[i >> 5] : 0; } } }
        for (int i = gt; i < NWR; i += NGT) { const float w = w1; if (i + NGT < NWR) w1 = in_wr[wr_src(i + NGT)];
            const unsigned h = pk2(w, 0.f) & 0xffffu; const float lo = w - bf2f((bf16)h); WRH[i] = (bf16)h; WRL[i] = (bf16)(pk2(lo, 0.f) & 0xffffu); }
        for (int i = gt; i < NWS; i += NGT) { const float w = w2; if (i + NGT < NWS) w2 = in_ws[i + NGT]; const int t = (i >> 7) & 127, s_ = i & 127; WSB[i] = (s_ <= t) ? (bf16)(pk2(w, 0.f) & 0xffffu) : (bf16)0; }
        for (int i = gt; i < NB1; i += NGT) { const float w = w3; if (i + NGT < NB1) w3 = in_b1[i + NGT]; const int n = i & 2047; B1P[(i & ~2047) + dest_row<2>(n)] = w; }
    }
    {
        LAS float* scr = (LAS float*)(F.lds + F.wave * 16640);
        const float* in_win = inp(F, IN_WIN); const float* in_wpa = inp(F, IN_WPA); const float* in_wpg = inp(F, IN_WPG); const float* in_wo = inp(F, IN_WO); const float* in_w1 = inp(F, IN_W1); const float* in_w2 = inp(F, IN_W2);
        constexpr int I_IN = (MK_P2F8 ? 8 : 16) * 84, I_PA = (MK_P4F8 ? 2 : 4) * 16, I_PG = (MK_P4F8 ? 4 : 8) * 16, I_O = (MK_P5F8 ? 8 : 16) * 16, I_1 = 8 * 32, I_2 = 8 * 16;
        constexpr int N_IN = DEPTH * I_IN, N_PA = DEPTH * I_PA, N_PG = DEPTH * I_PG, N_O = DEPTH * I_O, N_1 = (MK_TAILCVT ? 1 : DEPTH) * NE * I_1, N_2 = (MK_TAILCVT ? 0 : DEPTH) * NE * I_2;
        constexpr int NITEMS = N_IN + N_PA + N_PG + N_O + N_1 + N_2;
        for (int it = gw; it < NITEMS; it += NGW) {
            int r = it;
            if (r < N_IN) { const int m = r / I_IN; if (MK_P2F8) cvt_item8<1>(in_win + (size_t)m * D * INW, D, INW, (unsigned char*)(ws + WS_WTIN) + (size_t)m * INW * D, (LAS unsigned char*)scr, r % I_IN, F.lane); else cvt_item<1>(in_win + (size_t)m * D * INW, D, INW, (bf16*)(ws + WS_WTIN) + (size_t)m * INW * D, scr, r % I_IN, F.lane); continue; } r -= N_IN;
            if (r < N_PA) { const int m = r / I_PA; if (MK_P4F8) cvt_item8<0>(in_wpa + (size_t)m * AO * D, AO, D, (unsigned char*)(ws + WS_WTPA) + (size_t)m * D * AW, (LAS unsigned char*)scr, r % I_PA, F.lane, AW, 0); else cvt_item<0>(in_wpa + (size_t)m * AO * D, AO, D, (bf16*)(ws + WS_WTPA) + (size_t)m * D * AW, scr, r % I_PA, F.lane, AW, 0); continue; } r -= N_PA;
            if (r < N_PG) { const int m = r / I_PG; if (MK_P4F8) cvt_item8<0>(in_wpg + (size_t)m * GW * D, GW, D, (unsigned char*)(ws + WS_WTPA) + (size_t)m * D * AW, (LAS unsigned char*)scr, r % I_PG, F.lane, AW, AO); else cvt_item<0>(in_wpg + (size_t)m * GW * D, GW, D, (bf16*)(ws + WS_WTPA) + (size_t)m * D * AW, scr, r % I_PG, F.lane, AW, AO); continue; } r -= N_PG;
            if (r < N_O) { const int m = r / I_O; if (MK_P5F8) cvt_item8<0>(in_wo + (size_t)m * D * D, D, D, (unsigned char*)(ws + WS_WTO) + (size_t)m * D * D, (LAS unsigned char*)scr, r % I_O, F.lane); else cvt_item<0>(in_wo + (size_t)m * D * D, D, D, (bf16*)(ws + WS_WTO) + (size_t)m * D * D, scr, r % I_O, F.lane); continue; } r -= N_O;
            if (r < N_1) { const int m = r / I_1; cvt_item8<2>(in_w1 + (size_t)m * D * 2048, D, 2048, (unsigned char*)(ws + WS_W1T) + (size_t)m * 2048 * D, (LAS unsigned char*)scr, r % I_1, F.lane); continue; } r -= N_1;
            { const int m = r / I_2; cvt_item8<3>(in_w2 + (size_t)m * DFF * D, DFF, D, (unsigned char*)(ws + WS_W2T) + (size_t)m * D * DFF, (LAS unsigned char*)scr, r % I_2, F.lane); }
        }
    }
}

constexpr int Q_I1 = 8 * 32, Q_I2 = 8 * 16, QD0 = NE * Q_I2, QD1 = QD0 + NE * Q_I1, NQ = QD1 + NE * Q_I2;
__device__ __forceinline__ int tail_idle_cnt(int nwg, int G) { const int rem = nwg % G; return rem > 0 ? G - rem : 0; }
__device__ __forceinline__ int tail_ipw(int k) { return k == 2 ? MK_TAILIPW_P9 : (k == 4 ? MK_TAILIPW_L1P8 : MK_TAILIPW); }
__device__ __forceinline__ int imax_(int a, int b) { return a > b ? a : b; }
__device__ __forceinline__ int stage_pos(int k, int nM0, int G) {
    int p = 0;
    if (k == 0) return p;
    p += tail_idle_cnt((NTOK / 256) * (INW / 256), G) * NWAVES * tail_ipw(0);
    if (k == 1) return p;
    p += tail_idle_cnt(nM0 * (2048 / 256), G) * NWAVES * tail_ipw(1);
    if (k == 5) return p;
    p = imax_(p, QD0);
    if (k == 2) return p;
    p += tail_idle_cnt(nM0 * (D / 256), G) * NWAVES * tail_ipw(2);
    if (k == 3) return p;
    p += tail_idle_cnt((NTOK / 256) * (INW / 256), G) * NWAVES * tail_ipw(3);
    if (k == 6) return p;
    p = imax_(p, QD1);
    return p;
}
__device__ __forceinline__ void cvt_qitem(const Frame& F, unsigned char* ws, const float* in_w1, const float* in_w2, LAS unsigned char* scr, int q) {
    if (q < QD0) { const int m = q / Q_I2; cvt_item8<3>(in_w2 + (size_t)m * DFF * D, DFF, D, (unsigned char*)(ws + WS_W2T) + (size_t)m * D * DFF, scr, q % Q_I2, F.lane); }
    else if (q < QD1) { const int r = q - QD0, m = NE + r / Q_I1; cvt_item8<2>(in_w1 + (size_t)m * D * 2048, D, 2048, (unsigned char*)(ws + WS_W1T) + (size_t)m * 2048 * D, scr, r % Q_I1, F.lane); }
    else { const int r = q - QD1, m = NE + r / Q_I2; cvt_item8<3>(in_w2 + (size_t)m * DFF * D, DFF, D, (unsigned char*)(ws + WS_W2T) + (size_t)m * D * DFF, scr, r % Q_I2, F.lane); }
}
__device__ __forceinline__ void cvt_tail(const Frame& F0, int k, int nwg, int nM0) {
    const int rem0 = nwg % F0.G; if (rem0 == 0 || (int)blockIdx.x < rem0) return;
    const Frame F = opaque_frame(F0);
    unsigned char* ws = ws_of(F);
    const float* in_w1 = inp(F, IN_W1); const float* in_w2 = inp(F, IN_W2);
    LAS unsigned char* scr = F.lds + F.wave * 16640;
    const int rem = nwg % F.G, idle = F.G - rem, ii = (int)blockIdx.x - rem, base = stage_pos(k, nM0, F.G);
#pragma unroll 1
    for (int j = 0; j < tail_ipw(k); ++j) { const int q = base + j * idle * NWAVES + ii * NWAVES + F.wave; if (q < NQ) cvt_qitem(F, ws, in_w1, in_w2, scr, q); }
}
__device__ __forceinline__ void cvt_catch(const Frame& F0, int from, int upto) {
    if (from >= upto) return;
    const Frame F = opaque_frame(F0);
    unsigned char* ws = ws_of(F);
    const float* in_w1 = inp(F, IN_W1); const float* in_w2 = inp(F, IN_W2);
    LAS unsigned char* scr = F.lds + F.wave * 16640;
    const int gw = F.vcu * NWAVES + F.wave, NGW = F.G * NWAVES;
#pragma unroll 1
    for (int q = from + gw; q < upto; q += NGW) cvt_qitem(F, ws, in_w1, in_w2, scr, q);
}
__device__ __forceinline__ int load_nM0(const Frame& F) { return __builtin_amdgcn_readfirstlane(((const int*)(ws_of(F) + WS_ETAB))[128]); }

__device__ __forceinline__ void phase_pr1(const Frame& F0) {
    const Frame F = opaque_frame(F0);
    const int gw = F.vcu * NWAVES + F.wave, NGW = F.G * NWAVES;
    unsigned char* ws = ws_of(F);
    const float* MOD = (const float*)(ws + WS_MOD); bf16* AIN = (bf16*)(ws + WS_AIN);
    const float* in_x = inp(F, IN_X); const float* in_n1g = inp(F, IN_N1G);
    LAS float* SCG = (LAS float*)F.lds; LAS float* SH1 = SCG + BATCH * D;
    __syncthreads();
    for (int i = F.tid; i < BATCH * D; i += NTHR) { const int b = i >> 10, k = i & 1023; const float* mp = MOD + (size_t)b * 6144; SCG[i] = in_n1g[k] * (mp[1024 + k] + 1.0f); SH1[i] = mp[k]; }
    __syncthreads();
    f32x4 va[4], vb[4], vc[4], vd[4];
#define PR1_LD(v, tt) do { if ((tt) < NTOK) { _Pragma("unroll") for (int j = 0; j < 4; ++j) v[j] = __builtin_nontemporal_load((const f32x4*)(in_x + (size_t)(tt) * D + 4 * F.lane + 256 * j)); } } while (0)
#define PR1_DO(v, tt) do { if ((tt) < NTOK) { const int b = (tt) / SEQ; f32x4 w_[4]; _Pragma("unroll") for (int j = 0; j < 4; ++j) w_[j] = v[j]; PR1_LD(v, (tt) + 4 * NGW); \
        if (MK_P2F8) modnorm_store_lds(w_, SCG + b * D, SH1 + b * D, (unsigned char*)AIN + (size_t)(tt) * D, F.lane); \
        else { const float* mp = MOD + (size_t)b * 6144; modnorm_store(w_, in_n1g, mp + 1024, mp, AIN + (size_t)(tt) * D, F.lane); } } } while (0)
    PR1_LD(va, gw); PR1_LD(vb, gw + NGW); PR1_LD(vc, gw + 2 * NGW); PR1_LD(vd, gw + 3 * NGW);
    for (int t = gw; t < NTOK; t += 4 * NGW) { PR1_DO(va, t); PR1_DO(vb, t + NGW); PR1_DO(vc, t + 2 * NGW); PR1_DO(vd, t + 3 * NGW); }
#undef PR1_LD
#undef PR1_DO
}

__device__ __forceinline__ int crow(int r, int hi) { return (r & 3) + 8 * (r >> 2) + 4 * hi; }
constexpr int VSTR = 192;
__device__ __forceinline__ s16x4 tr_read(const LAS unsigned char* p) { typedef short v4i16_t __attribute__((ext_vector_type(4))); return __builtin_bit_cast(s16x4, __builtin_amdgcn_ds_read_tr16_b64_v4i16((LAS v4i16_t*)p)); }
__device__ __forceinline__ float half_swap_max(float m) { auto rr = __builtin_amdgcn_permlane32_swap(__float_as_uint(m), __float_as_uint(m), false, false); return fmaxf(__uint_as_float(rr[0]), __uint_as_float(rr[1])); }
__device__ __forceinline__ float half_swap_sum(float m) { auto rr = __builtin_amdgcn_permlane32_swap(__float_as_uint(m), __float_as_uint(m), false, false); return __uint_as_float(rr[0]) + __uint_as_float(rr[1]); }

__device__ __forceinline__ void attn_block(const Frame& F, const bf16* Qb, const bf16* Kb, const bf16* Vb, bf16* OGg, float* LSEg, int b, int r, int j, int n, int g) {
    const int lane = F.lane, w = F.wave, q = lane & 31, hh = lane >> 5;
    const unsigned lds0 = (unsigned)(__UINTPTR_TYPE__)F.lds;
    const int gi = (lane >> 4) & 1, q4 = (lane & 15) >> 2, p4 = lane & 3;
#pragma unroll 1
    for (int hp = 0; hp < 2; ++hp) {
        { const int rowin = lane >> 3, c = (lane & 7) ^ rowin;
#pragma unroll
          for (int i = 0; i < 8; ++i) { const int rg = w * 8 + i, hl = rg >> 5, rgi = rg & 31;
              if (n > 0 || rgi >= 16) {
                  const int row = 8 * rgi + rowin;
                  const unsigned voff = (unsigned)(((size_t)b * SEQ + (size_t)((n - 1) * 128 + row) * r + j) * AW + g * 256 + (2 * hp + hl) * 64 + 8 * c) * 2u;
                  glds16((unsigned long long)Kb, voff, lds0 + hl * 32768 + rgi * 1024);
                  glds16((unsigned long long)Vb, voff, lds0 + 65536 + hl * 32768 + rgi * 1024); } } }
        const int hl = w >> 2, I = w & 3, h = 2 * hp + hl;
        const size_t rowq = (size_t)b * SEQ + (size_t)(n * 128 + 32 * I + q) * r + j;
        bf16x8 qf[4];
#pragma unroll
        for (int s = 0; s < 4; ++s) qf[s] = *(const bf16x8*)(Qb + rowq * AW + g * 256 + h * 64 + 16 * s + 8 * hh);
        asm volatile("s_waitcnt vmcnt(0)" ::: "memory");
        __syncthreads();
        const LAS unsigned char* Kimg = F.lds + hl * 32768; const LAS unsigned char* Vimg = F.lds + 65536 + hl * 32768;
        f32x16 o0, o1;
#pragma unroll
        for (int i = 0; i < 16; ++i) { o0[i] = 0.f; o1[i] = 0.f; }
        float mrun = -1e30f, lrun = 0.f;
        const int Jlo = (n == 0 && I < 4) ? 4 : I, Jhi = I + 4;
#pragma unroll 1
        for (int J = Jlo; J <= Jhi; ++J) {
            f32x16 st;
#pragma unroll
            for (int i = 0; i < 16; ++i) st[i] = 0.f;
            { const int row = 32 * J + q; const LAS unsigned char* kr = Kimg + row * 128;
#pragma unroll
              for (int s = 0; s < 4; ++s) { const bf16x8 kf = *(const LAS bf16x8*)(kr + (((2 * s + hh) ^ (row & 7)) << 4)); st = __builtin_amdgcn_mfma_f32_32x32x16_bf16(kf, qf[s], st, 0, 0, 0); } }
            if (J == I) {
#pragma unroll
                for (int i = 0; i < 16; ++i) if (crow(i, hh) < q) st[i] = -1e30f;
            }
            if (J == I + 4) {
#pragma unroll
                for (int i = 0; i < 16; ++i) if (crow(i, hh) > q) st[i] = -1e30f;
            }
            float mx = st[0];
#pragma unroll
            for (int i = 1; i < 16; ++i) mx = fmaxf(mx, st[i]);
            mx = half_swap_max(mx);
            const bool upd = (mx - mrun) > 8.0f;
            const float mnew = upd ? mx : mrun;
            float rs = 0.f;
#pragma unroll
            for (int i = 0; i < 16; ++i) { st[i] = fast_exp2(st[i] - mnew); rs += st[i]; }
            rs = half_swap_sum(rs);
            if (__builtin_amdgcn_ballot_w64(upd) != 0ull) {
                const float alpha = fast_exp2(mrun - mnew);
                lrun *= alpha;
#pragma unroll
                for (int i = 0; i < 16; ++i) { o0[i] *= alpha; o1[i] *= alpha; } }
            lrun += rs; mrun = mnew;
            bf16x8 pf[2];
#pragma unroll
            for (int s = 0; s < 2; ++s) { u32x4 wv; wv.x = pk2(st[8 * s + 0], st[8 * s + 1]); wv.y = pk2(st[8 * s + 2], st[8 * s + 3]); wv.z = pk2(st[8 * s + 4], st[8 * s + 5]); wv.w = pk2(st[8 * s + 6], st[8 * s + 7]); pf[s] = __builtin_bit_cast(bf16x8, wv); }
            { const int sw = 4 * hh + q4; const LAS unsigned char* vr = Vimg + (32 * J + 4 * hh + q4) * 128 + 8 * (p4 & 1);
              const int c0 = ((2 * gi + (p4 >> 1)) ^ sw) << 4, c1 = ((4 + 2 * gi + (p4 >> 1)) ^ sw) << 4;
#pragma unroll
              for (int s = 0; s < 2; ++s) {
                  const s16x4 a0 = tr_read(vr + (16 * s) * 128 + c0), a1 = tr_read(vr + (16 * s + 8) * 128 + c0);
                  const s16x4 e0 = tr_read(vr + (16 * s) * 128 + c1), e1 = tr_read(vr + (16 * s + 8) * 128 + c1);
                  const bf16x8 v0 = (bf16x8){a0[0], a0[1], a0[2], a0[3], a1[0], a1[1], a1[2], a1[3]}, v1 = (bf16x8){e0[0], e0[1], e0[2], e0[3], e1[0], e1[1], e1[2], e1[3]};
                  o0 = __builtin_amdgcn_mfma_f32_32x32x16_bf16(v0, pf[s], o0, 0, 0, 0);
                  o1 = __builtin_amdgcn_mfma_f32_32x32x16_bf16(v1, pf[s], o1, 0, 0, 0); } }
        }
        const float inv = 1.0f / lrun;
#pragma unroll
        for (int pr = 0; pr < 2; ++pr) {
            u32x2 a0, a1, b0, b1;
            a0.x = pk2(o0[8 * pr] * inv, o0[8 * pr + 1] * inv); a0.y = pk2(o0[8 * pr + 2] * inv, o0[8 * pr + 3] * inv);
            b0.x = pk2(o0[8 * pr + 4] * inv, o0[8 * pr + 5] * inv); b0.y = pk2(o0[8 * pr + 6] * inv, o0[8 * pr + 7] * inv);
            a1.x = pk2(o1[8 * pr] * inv, o1[8 * pr + 1] * inv); a1.y = pk2(o1[8 * pr + 2] * inv, o1[8 * pr + 3] * inv);
            b1.x = pk2(o1[8 * pr + 4] * inv, o1[8 * pr + 5] * inv); b1.y = pk2(o1[8 * pr + 6] * inv, o1[8 * pr + 7] * inv);
            const auto s0x = __builtin_amdgcn_permlane32_swap(a0.x, b0.x, false, false), s0y = __builtin_amdgcn_permlane32_swap(a0.y, b0.y, false, false);
            const auto s1x = __builtin_amdgcn_permlane32_swap(a1.x, b1.x, false, false), s1y = __builtin_amdgcn_permlane32_swap(a1.y, b1.y, false, false);
            const u32x4 v0 = {s0x[0], s0y[0], s0x[1], s0y[1]}, v1 = {s1x[0], s1y[0], s1x[1], s1y[1]};
            bf16* orow = OGg + rowq * AO + h * 64 + 16 * pr + 8 * hh;
            *(u32x4*)(orow) = v0; *(u32x4*)(orow + 32) = v1; }
        if (hh == 0) LSEg[rowq * 4 + h] = (mrun + __log2f(lrun)) * LN2;
        LDS_BARRIER();
    }
}

__device__ __forceinline__ void phase_attn(const Frame& F0) {
    const Frame F = opaque_frame(F0);
    unsigned char* ws = ws_of(F);
    const bf16* Qb = (const bf16*)(ws + WS_QB); const bf16* Kb = (const bf16*)(ws + WS_KB); const bf16* Vb = (const bf16*)(ws + WS_VB);
    bf16* OG = (bf16*)(ws + WS_OG); float* LSE = (float*)(ws + WS_LSE);
    __syncthreads();
    for (int b0 = blockIdx.x * 3; b0 < 768; b0 += F.G * 3)
#pragma unroll 1
        for (int blk = b0; blk < b0 + 3 && blk < 768; ++blk) {
            const int g = blk >> 8, rem = blk & 255, b = rem >> 5, jn = rem & 31;
            const int r = (g == 0) ? 1 : (g == 1 ? 4 : 16), nb = 32 / r, j = jn / nb, n = jn % nb;
            attn_block(F, Qb, Kb, Vb, OG + (size_t)g * NTOK * AO, LSE + (size_t)g * NTOK * 4, b, r, j, n, g);
        }
}

constexpr int ISTR = 320;
__device__ __forceinline__ void phase_gmlp(const Frame& F0, int l) {
    const Frame F = opaque_frame(F0);
    unsigned char* ws = ws_of(F);
    const bf16* VG = (const bf16*)(ws + WS_VGB); const bf16* U = (const bf16*)(ws + WS_UB); bf16* GM = (bf16*)(ws + WS_ATT) + AO;
    const bf16* WSB = (const bf16*)(ws + WS_WSB) + (size_t)l * 4 * 128 * 128;
    const float* lng = inp(F, IN_LNG) + l * GW; const float* lnb = inp(F, IN_LNB) + l * GW; const float* bs = inp(F, IN_BS) + l * 4 * 128;
    LAS unsigned char* img = F.lds; LAS f32x2* ST = (LAS f32x2*)(F.lds + 128 * ISTR); LAS float* LNS = (LAS float*)(F.lds + 49152);
    const int lane = F.lane, q = lane & 31, hh = lane >> 5, gi = (lane >> 4) & 1, q4 = (lane & 15) >> 2, p4 = lane & 3;
    for (int un = blockIdx.x; un < NTILE128; un += F.G) {
        const size_t R0 = (size_t)un * 128;
        __syncthreads();
        { const float lv = lng[F.tid], bv_ = lnb[F.tid]; LNS[F.tid] = lv; LNS[GW + F.tid] = bv_; }
        u32x4 rowv[16];
#pragma unroll
        for (int i = 0; i < 16; ++i) rowv[i] = *(const u32x4*)(VG + (R0 + F.wave * 16 + i) * GW + 8 * lane);
        const int ch = lane & 15, tt = F.wave >> 1;
        u32x4 sl[4];
#pragma unroll
        for (int i = 0; i < 4; ++i) sl[i] = *(const u32x4*)(VG + (R0 + F.wave * 16 + ((lane + 64 * i) >> 4)) * GW + 8 * ch);
#pragma unroll
        for (int i = 0; i < 16; ++i) { const int tk = F.wave * 16 + i; f32x4 a, b2; pg8::unpack8(rowv[i], a, b2);
            const float s = wave_sum((a[0] + a[1]) + (a[2] + a[3]) + (b2[0] + b2[1]) + (b2[2] + b2[3])); const float mean = s * (1.0f / GW);
            const f32x4 da = a - mean, db = b2 - mean; const float ss = wave_sum((da[0] * da[0] + da[1] * da[1]) + (da[2] * da[2] + da[3] * da[3]) + (db[0] * db[0] + db[1] * db[1]) + (db[2] * db[2] + db[3] * db[3]));
            if (lane == 0) ST[tk] = (f32x2){mean, 1.0f / sqrtf(ss * (1.0f / GW) + LN_EPS)}; }
        __syncthreads();
#pragma unroll 1
        for (int g = 0; g < 4; ++g) {
            bf16x8 bw[8];
            const bf16* wrow = WSB + ((size_t)g * 128 + 32 * tt + q) * 128 + 8 * hh;
#pragma unroll
            for (int ks = 0; ks < 8; ++ks) if (ks < 2 * (tt + 1)) bw[ks] = *(const bf16x8*)(wrow + 16 * ks);
            const size_t orow = R0 + 32 * tt + q;
            u32x2 uw[2][4];
#pragma unroll
            for (int cc = 0; cc < 2; ++cc)
#pragma unroll
                for (int rq = 0; rq < 4; ++rq) uw[cc][rq] = *(const u32x2*)(U + orow * GW + g * 128 + 32 * (2 * (F.wave & 1) + cc) + 8 * rq + 4 * hh);
            const float bias = bs[g * 128 + 32 * tt + q];
            { f32x4 ga, gb, ba, bb;
              ga = *(const LAS f32x4*)(LNS + g * 128 + 8 * ch); gb = *(const LAS f32x4*)(LNS + g * 128 + 8 * ch + 4); ba = *(const LAS f32x4*)(LNS + GW + g * 128 + 8 * ch); bb = *(const LAS f32x4*)(LNS + GW + g * 128 + 8 * ch + 4);
#pragma unroll
              for (int i = 0; i < 4; ++i) { const int tk = F.wave * 16 + ((lane + 64 * i) >> 4); f32x4 a, b2; pg8::unpack8(sl[i], a, b2);
                  const f32x2 st = ST[tk]; a = (a - st.x) * st.y * ga + ba; b2 = (b2 - st.x) * st.y * gb + bb;
                  *(LAS u32x4*)(img + tk * ISTR + ch * 16) = pg8::pack8(a, b2); } }
            if (g < 3) {
#pragma unroll
                for (int i = 0; i < 4; ++i) sl[i] = *(const u32x4*)(VG + (R0 + F.wave * 16 + ((lane + 64 * i) >> 4)) * GW + (g + 1) * 128 + 8 * ch); }
            LDS_BARRIER();
            f32x16 acc[2];
#pragma unroll
            for (int i = 0; i < 16; ++i) { acc[0][i] = 0.f; acc[1][i] = 0.f; }
#pragma unroll
            for (int ks = 0; ks < 8; ++ks) if (ks < 2 * (tt + 1)) {
#pragma unroll
                for (int cc = 0; cc < 2; ++cc) { const int ct = 2 * (F.wave & 1) + cc;
                    const LAS unsigned char* tb = img + (16 * ks + 8 * hh + q4) * ISTR + (32 * ct + 16 * gi + 4 * p4) * 2;
                    const s16x4 a0 = tr_read(tb), a1 = tr_read(tb + 4 * ISTR);
                    const bf16x8 af = (bf16x8){a0[0], a0[1], a0[2], a0[3], a1[0], a1[1], a1[2], a1[3]};
                    acc[cc] = __builtin_amdgcn_mfma_f32_32x32x16_bf16(af, bw[ks], acc[cc], 0, 0, 0); }
            }
#pragma unroll
            for (int cc = 0; cc < 2; ++cc) { const int ct = 2 * (F.wave & 1) + cc;
                if (MK_P4F8) {
                    unsigned pc[4];
#pragma unroll
                    for (int rq = 0; rq < 4; ++rq) { const u32x2 u2 = uw[cc][rq];
                        pc[rq] = pk4_fp8((acc[cc][4 * rq] + bias) * bf_lo(u2.x) * F8_XSCALE, (acc[cc][4 * rq + 1] + bias) * bf_hi(u2.x) * F8_XSCALE, (acc[cc][4 * rq + 2] + bias) * bf_lo(u2.y) * F8_XSCALE, (acc[cc][4 * rq + 3] + bias) * bf_hi(u2.y) * F8_XSCALE); }
                    const auto s02 = __builtin_amdgcn_permlane32_swap(pc[0], pc[2], false, false), s13 = __builtin_amdgcn_permlane32_swap(pc[1], pc[3], false, false);
                    *(u32x4*)((unsigned char*)(GM - AO) + orow * AW + AO + g * 128 + 32 * ct + 16 * hh) = (u32x4){s02[0], s02[1], s13[0], s13[1]};
                } else {
#pragma unroll
                    for (int rq = 0; rq < 4; ++rq) { const int c0 = g * 128 + 32 * ct + 8 * rq + 4 * hh; const u32x2 u2 = uw[cc][rq];
                        u32x2 w; w.x = pk2((acc[cc][4 * rq] + bias) * bf_lo(u2.x), (acc[cc][4 * rq + 1] + bias) * bf_hi(u2.x)); w.y = pk2((acc[cc][4 * rq + 2] + bias) * bf_lo(u2.y), (acc[cc][4 * rq + 3] + bias) * bf_hi(u2.y));
                        *(u32x2*)(GM + orow * AW + c0) = w; } } }
            LDS_BARRIER();
        }
    }
}

__device__ __forceinline__ void phase_merge(const Frame& F0) {
    const Frame F = opaque_frame(F0);
    const int gw = F.vcu * NWAVES + F.wave, NGW = F.G * NWAVES;
    unsigned char* ws = ws_of(F);
    const bf16* OG = (const bf16*)(ws + WS_OG); const float* LSE = (const float*)(ws + WS_LSE); bf16* ATT = (bf16*)(ws + WS_ATT);
    const int lane = F.lane, h = lane >> 4;
    constexpr int MU = 4;
    for (int t0 = gw; t0 < NTOK; t0 += MU * NGW) {
        float l0[MU], l1[MU], l2[MU]; u32x2 a[MU], b[MU], c[MU];
#pragma unroll
        for (int u = 0; u < MU; ++u) { const int t = t0 + u * NGW; if (t < NTOK) {
            l0[u] = LSE[(size_t)t * 4 + h]; l1[u] = LSE[((size_t)NTOK + t) * 4 + h]; l2[u] = LSE[((size_t)2 * NTOK + t) * 4 + h];
            a[u] = *(const u32x2*)(OG + (size_t)t * AO + 4 * lane); b[u] = *(const u32x2*)(OG + ((size_t)NTOK + t) * AO + 4 * lane); c[u] = *(const u32x2*)(OG + ((size_t)2 * NTOK + t) * AO + 4 * lane); } }
#pragma unroll
        for (int u = 0; u < MU; ++u) { const int t = t0 + u * NGW; if (t < NTOK) {
            const float mx = fmaxf(l0[u], fmaxf(l1[u], l2[u])); float w0 = fast_exp2((l0[u] - mx) * LOG2E), w1 = fast_exp2((l1[u] - mx) * LOG2E), w2 = fast_exp2((l2[u] - mx) * LOG2E);
            const float inv = 1.0f / (w0 + w1 + w2); w0 *= inv; w1 *= inv; w2 *= inv;
            const float o0 = w0 * bf_lo(a[u].x) + w1 * bf_lo(b[u].x) + w2 * bf_lo(c[u].x), o1 = w0 * bf_hi(a[u].x) + w1 * bf_hi(b[u].x) + w2 * bf_hi(c[u].x);
            const float o2 = w0 * bf_lo(a[u].y) + w1 * bf_lo(b[u].y) + w2 * bf_lo(c[u].y), o3 = w0 * bf_hi(a[u].y) + w1 * bf_hi(b[u].y) + w2 * bf_hi(c[u].y);
            if (MK_P4F8) *(unsigned*)((unsigned char*)ATT + (size_t)t * AW + 4 * lane) = pk4_fp8(o0 * F8_XSCALE, o1 * F8_XSCALE, o2 * F8_XSCALE, o3 * F8_XSCALE);
            else { u32x2 w; w.x = pk2(o0, o1); w.y = pk2(o2, o3); *(u32x2*)(ATT + (size_t)t * AW + 4 * lane) = w; } } }
    }
}

__device__ __forceinline__ void phase_router(const Frame& F0, int l) {
    const Frame F = opaque_frame(F0);
    unsigned char* ws = ws_of(F);
    const bf16* H = (const bf16*)(ws + WS_HB1); unsigned char* FB = (unsigned char*)(ws + WS_AIN);
    const float* MOD = (const float*)(ws + WS_MOD) + (size_t)l * BATCH * 6144;
    const bf16* WRH = (const bf16*)(ws + WS_WRH) + (size_t)l * NE * D; const bf16* WRL = (const bf16*)(ws + WS_WRL) + (size_t)l * NE * D;
    int* TOPI = (int*)(ws + WS_TOPI); float* TOPG = (float*)(ws + WS_TOPG); int* WGH = (int*)(ws + WS_WGH);
    const float* n2g = inp(F, IN_N2G) + l * D; const float* br = inp(F, IN_BR) + l * NE;
    LAS float* LG = (LAS float*)(F.lds + F.wave * 2048);
    LAS int* EX = (LAS int*)(F.lds + 16384);
    LAS int* HIST = (LAS int*)(F.lds + 16384 + 2048);
    LAS float* SC = (LAS float*)(F.lds + 20480); LAS float* SH = SC + D;
    const int lane = F.lane, tl = lane & 15, kq = lane >> 4;
    for (int tile = blockIdx.x; tile < NTILE128; tile += F.G) {
        __syncthreads();
        if (F.tid < 32) HIST[F.tid] = 0;
        const int T = tile * 128 + F.wave * 16 + tl, b = (tile * 128) / SEQ;
        const bf16* hrow = H + (size_t)T * D + 8 * kq;
#pragma unroll
        for (int i = 0; i < 8; ++i) { const int pi = F.wave * 8 + i, e = pi >> 1, hf = pi & 1, c = (64 * hf + lane) ^ (e & 15);
            glds16((unsigned long long)WRH, (unsigned)(e * 2048 + c * 16), (unsigned)(__UINTPTR_TYPE__)F.lds + 32768 + pi * 1024); }
        const float rb0 = br[tl], rb1 = br[16 + tl];
        u32x4 hq[32];
#pragma unroll
        for (int ks = 0; ks < 32; ++ks) hq[ks] = *(const u32x4*)(hrow + 32 * ks);
        { const float* sc2 = MOD + (size_t)b * 6144 + 4 * 1024; const float* sh2 = MOD + (size_t)b * 6144 + 3 * 1024;
          for (int i = F.tid; i < D; i += NTHR) { SC[i] = n2g[i] * (1.0f + sc2[i]) * F8_XSCALE; SH[i] = sh2[i] * F8_XSCALE; } }
        float ss = 0.f;
#pragma unroll
        for (int ks = 0; ks < 32; ++ks) { f32x4 a, c; pg8::unpack8(hq[ks], a, c);
            ss += (a[0] * a[0] + a[1] * a[1]) + (a[2] * a[2] + a[3] * a[3]) + (c[0] * c[0] + c[1] * c[1]) + (c[2] * c[2] + c[3] * c[3]); }
        ss += __shfl_xor(ss, 16); ss += __shfl_xor(ss, 32);
        const float rstd = 1.0f / sqrtf(ss * (1.0f / D) + RMS_EPS);
        __syncthreads();
        u32x2 wsave = {0u, 0u};
        f32x4 acc0 = {0.f, 0.f, 0.f, 0.f}, acc1 = {0.f, 0.f, 0.f, 0.f};
        const LAS unsigned char* wimg0 = F.lds + 32768 + tl * 2048; const LAS unsigned char* wimg1 = wimg0 + 16 * 2048;
#pragma unroll
        for (int ks = 0; ks < 32; ++ks) {
            { const int c0 = 32 * ks + 8 * kq;
                u32x4 hraw = hq[ks]; asm volatile("" : "+v"(hraw));
                f32x4 a, c; pg8::unpack8(hraw, a, c);
                const f32x4 s0 = *(const LAS f32x4*)(SC + c0), s1 = *(const LAS f32x4*)(SC + c0 + 4), h0 = *(const LAS f32x4*)(SH + c0), h1 = *(const LAS f32x4*)(SH + c0 + 4);
                a = a * rstd * s0 + h0; c = c * rstd * s1 + h1;
                const u32x4 hi = pg8::pack8(a, c); f32x4 ah, ch; pg8::unpack8(hi, ah, ch); const u32x4 lo = pg8::pack8(a - ah, c - ch);
                { u32x2 w8; w8.x = pk4_fp8(a[0], a[1], a[2], a[3]); w8.y = pk4_fp8(c[0], c[1], c[2], c[3]);
                  if ((ks & 1) == 0) wsave = w8;
                  else { const auto sx = __builtin_amdgcn_permlane16_swap(wsave.x, w8.x, false, false), sy = __builtin_amdgcn_permlane16_swap(wsave.y, w8.y, false, false);
                      *(u32x4*)(FB + (size_t)T * D + 32 * (ks - 1 + (kq & 1)) + 16 * (kq >> 1)) = (u32x4){sx[0], sy[0], sx[1], sy[1]}; } }
                const bf16x8 fh = __builtin_bit_cast(bf16x8, hi), fl = __builtin_bit_cast(bf16x8, lo);
                const int wo = (((4 * ks + kq) ^ tl) << 4);
                const bf16x8 wh0 = *(const LAS bf16x8*)(wimg0 + wo), wh1 = *(const LAS bf16x8*)(wimg1 + wo);
                acc0 = __builtin_amdgcn_mfma_f32_16x16x32_bf16(fh, wh0, acc0, 0, 0, 0); acc0 = __builtin_amdgcn_mfma_f32_16x16x32_bf16(fl, wh0, acc0, 0, 0, 0);
                acc1 = __builtin_amdgcn_mfma_f32_16x16x32_bf16(fh, wh1, acc1, 0, 0, 0); acc1 = __builtin_amdgcn_mfma_f32_16x16x32_bf16(fl, wh1, acc1, 0, 0, 0); }
            if ((ks & 3) == 3) __builtin_amdgcn_sched_barrier(0);
        }
        {
#pragma unroll
          for (int rg = 0; rg < 4; ++rg) { LG[(4 * kq + rg) * 32 + tl] = acc0[rg] * (1.0f / F8_XSCALE) + rb0; LG[(4 * kq + rg) * 32 + 16 + tl] = acc1[rg] * (1.0f / F8_XSCALE) + rb1; } }
        LDS_WAIT();
        if (lane < 16) {
            float v[32];
#pragma unroll
            for (int i = 0; i < 8; ++i) { const f32x4 x = *(const LAS f32x4*)(LG + lane * 32 + 4 * i); v[4 * i] = x[0]; v[4 * i + 1] = x[1]; v[4 * i + 2] = x[2]; v[4 * i + 3] = x[3]; }
            int ti[4]; float tv[4];
#pragma unroll
            for (int k = 0; k < 4; ++k) { float best = -3.0e38f; int bi = 0;
#pragma unroll
                for (int e = 0; e < 32; ++e) { const bool taken = (k > 0 && ti[0] == e) || (k > 1 && ti[1] == e) || (k > 2 && ti[2] == e); if (!taken && v[e] > best) { best = v[e]; bi = e; } }
                ti[k] = bi; tv[k] = best; }
            const float e1 = fast_exp2((tv[1] - tv[0]) * LOG2E), e2 = fast_exp2((tv[2] - tv[0]) * LOG2E), e3 = fast_exp2((tv[3] - tv[0]) * LOG2E); const float inv = 1.0f / (1.0f + e1 + e2 + e3);
            const int Tt = tile * 128 + F.wave * 16 + lane;
            *(i32x4*)(TOPI + (size_t)Tt * 4) = (i32x4){ti[0], ti[1], ti[2], ti[3]}; *(f32x4*)(TOPG + (size_t)Tt * 4) = (f32x4){inv, e1 * inv, e2 * inv, e3 * inv};
            *(LAS i32x4*)(EX + (F.wave * 16 + lane) * 4) = (i32x4){ti[0], ti[1], ti[2], ti[3]};
        }
        LDS_BARRIER();
        __hip_atomic_fetch_add(&HIST[EX[F.tid]], 1, __ATOMIC_RELAXED, __HIP_MEMORY_SCOPE_WORKGROUP);
        LDS_BARRIER();
        if (F.tid < 32) WGH[tile * 32 + F.tid] = HIST[F.tid];
    }
}

__device__ __forceinline__ void phase_positions(const Frame& F0, int l) {
    const Frame F = opaque_frame(F0);
    unsigned char* ws = ws_of(F);
    const int* WGH = (const int*)(ws + WS_WGH); const int* TOPI = (const int*)(ws + WS_TOPI);
    int* POS = (int*)(ws + WS_POS); int* SORT = (int*)(ws + WS_SORT); int* ETAB = (int*)(ws + WS_ETAB);
    LAS int* PT = (LAS int*)F.lds;
    LAS int* PB = PT + 512;
    LAS int* CNT = PB + 512;
    LAS int* BASE = CNT + 32;
    LAS int* WC = BASE + 32;
    const int lane = F.lane;
    for (int tile = blockIdx.x; tile < NTILE128; tile += F.G) {
        __syncthreads();
        const int e = TOPI[(size_t)(tile * 128 + (F.tid >> 2)) * 4 + (F.tid & 3)];
        { const int eh = F.tid & 31, part = F.tid >> 5; int cv[16];
#pragma unroll
          for (int i = 0; i < 16; ++i) cv[i] = WGH[(part * 16 + i) * 32 + eh];
          int tot = 0, bef = 0;
#pragma unroll
          for (int i = 0; i < 16; ++i) { tot += cv[i]; bef += (part * 16 + i < tile) ? cv[i] : 0; }
          PT[part * 32 + eh] = tot; PB[part * 32 + eh] = bef; }
        __syncthreads();
        if (F.tid < 64) {
            const int ex = lane & 31; int tot = 0, bef = 0;
#pragma unroll
            for (int p = 0; p < 16; ++p) { tot += PT[p * 32 + ex]; bef += PB[p * 32 + ex]; }
            int incl = tot, tinc = (tot + 255) >> 8;
#pragma unroll
            for (int o = 1; o < 32; o <<= 1) { const int a = __shfl_up(incl, o), b2 = __shfl_up(tinc, o); if ((lane & 31) >= o) { incl += a; tinc += b2; } }
            const int off = incl - tot, ts = tinc - ((tot + 255) >> 8);
            if (lane < 32) { BASE[ex] = bef + off;
                if (tile == 0) { ETAB[ex] = tot; ETAB[32 + ex] = off; ETAB[64 + ex] = ts; if (ex == 31) { ETAB[96] = tinc; ETAB[128 + l] = tinc; } } } }
        if (tile == 0 && F.tid < 256) SORT[NASG + F.tid] = 0;
        const int tok = tile * 128 + (F.tid >> 2), k = F.tid & 3;
        int rnk = 0, mycnt = 0;
#pragma unroll 1
        for (int E = 0; E < 32; ++E) { const unsigned long long m = __ballot(e == E); if (e == E) rnk = __popcll(m & ((1ull << lane) - 1ull)); if (lane == E) mycnt = __popcll(m); }
        if (lane < 32) WC[F.wave * 32 + lane] = mycnt;
        __syncthreads();
        int wo = 0;
        for (int w = 0; w < F.wave; ++w) wo += WC[w * 32 + e];
        const int pos = BASE[e] + wo + rnk;
        SORT[pos] = tok; POS[(size_t)tok * 4 + k] = pos;
    }
}

__device__ __forceinline__ void phase_loadtab(const Frame& F0) {
    const Frame F = opaque_frame(F0);
    unsigned char* ws = ws_of(F);
    LAS int* tab = (LAS int*)(F.lds + TAB_OFF);
    __syncthreads();
    if (F.tid < 97) tab[F.tid] = ((const int*)(ws + WS_ETAB))[F.tid];
    __syncthreads();
}

struct CbRows { u32x2 y[2][4]; u32x4 h[2]; };
__device__ __forceinline__ void cb_load(CbRows& R, const unsigned char* Y, const bf16* H1, int t, const i32x4& pp, int lane) {
#pragma unroll
    for (int j = 0; j < 2; ++j) { const int c = 8 * lane + 512 * j;
        R.y[j][0] = *(const u32x2*)(Y + (size_t)pp[0] * D + c); R.y[j][1] = *(const u32x2*)(Y + (size_t)pp[1] * D + c); R.y[j][2] = *(const u32x2*)(Y + (size_t)pp[2] * D + c); R.y[j][3] = *(const u32x2*)(Y + (size_t)pp[3] * D + c);
        R.h[j] = *(const u32x4*)(H1 + (size_t)t * D + c); }
}
__device__ __forceinline__ void phase_combine(const Frame& F0, int l) {
    const Frame F = opaque_frame(F0);
    const int gw = F.vcu * NWAVES + F.wave, NGW = F.G * NWAVES;
    unsigned char* ws = ws_of(F);
    const float* in_n1g = inp(F, IN_N1G) + (l + 1 < DEPTH ? (l + 1) * D : 0); const float* in_fg = inp(F, IN_FG); float* outp = (float*)inp(F, IN_OUT);
    const bf16* H1 = (const bf16*)(ws + WS_HB1); bf16* H2 = (bf16*)(ws + WS_HB2); const unsigned char* Y = (const unsigned char*)(ws + WS_Y);
    const int* POS = (const int*)(ws + WS_POS); const float* TOPG = (const float*)(ws + WS_TOPG);
    const float* MOD = (const float*)(ws + WS_MOD); bf16* AIN = (bf16*)(ws + WS_AIN);
    const int lane = F.lane;
    LAS float* G2L = (LAS float*)F.lds; LAS float* SCG = G2L + BATCH * D; LAS float* SH1 = SCG + BATCH * D;
    __syncthreads();
    for (int i = F.tid; i < BATCH * D; i += NTHR) { const int b = i >> 10, k = i & 1023;
        G2L[i] = MOD[((size_t)l * BATCH + b) * 6144 + 5 * 1024 + k];
        if (l + 1 < DEPTH) { const float* mp = MOD + ((size_t)(l + 1) * BATCH + b) * 6144; SCG[i] = in_n1g[k] * (mp[1024 + k] + 1.0f); SH1[i] = mp[k]; }
        else if (b == 0) SCG[k] = in_fg[k]; }
    __syncthreads();
    CbRows RA, RB, RC; i32x4 pq[3]; f32x4 gq[4];
#define CB_ROUTE(tt, P, G) do { if ((tt) < NTOK) { P = *(const i32x4*)(POS + (size_t)(tt) * 4); G = *(const f32x4*)(TOPG + (size_t)(tt) * 4); } else { P = (i32x4){0, 0, 0, 0}; G = (f32x4){0.f, 0.f, 0.f, 0.f}; } } while (0)
    { i32x4 p0, p1, p2; CB_ROUTE(gw, p0, gq[0]); CB_ROUTE(gw + NGW, p1, gq[1]); CB_ROUTE(gw + 2 * NGW, p2, gq[2]); CB_ROUTE(gw + 3 * NGW, pq[0], gq[3]);
      if (gw < NTOK) cb_load(RA, Y, H1, gw, p0, lane);
      if (gw + NGW < NTOK) cb_load(RB, Y, H1, gw + NGW, p1, lane);
      if (gw + 2 * NGW < NTOK) cb_load(RC, Y, H1, gw + 2 * NGW, p2, lane); }
#define CB_STEP(R, t) do { \
        const int b = (t) / SEQ; const LAS float* g2 = G2L + b * D; \
        const f32x4 gc = gq[0] * (1.0f / F8_YSCALE); \
        float v[2][8]; \
        _Pragma("unroll") for (int j = 0; j < 2; ++j) { const int c = 8 * lane + 512 * j; \
            f32x4 h0, h1; pg8::unpack8(R.h[j], h0, h1); \
            const f32x4 ga = *(const LAS f32x4*)(g2 + c), gb = *(const LAS f32x4*)(g2 + c + 4); \
            float a0[8], a1[8], a2[8], a3[8]; \
            unpk4_fp8(R.y[j][0].x, a0[0], a0[1], a0[2], a0[3]); unpk4_fp8(R.y[j][0].y, a0[4], a0[5], a0[6], a0[7]); \
            unpk4_fp8(R.y[j][1].x, a1[0], a1[1], a1[2], a1[3]); unpk4_fp8(R.y[j][1].y, a1[4], a1[5], a1[6], a1[7]); \
            unpk4_fp8(R.y[j][2].x, a2[0], a2[1], a2[2], a2[3]); unpk4_fp8(R.y[j][2].y, a2[4], a2[5], a2[6], a2[7]); \
            unpk4_fp8(R.y[j][3].x, a3[0], a3[1], a3[2], a3[3]); unpk4_fp8(R.y[j][3].y, a3[4], a3[5], a3[6], a3[7]); \
            _Pragma("unroll") for (int e = 0; e < 8; ++e) { const float sm = gc[0] * a0[e] + gc[1] * a1[e] + gc[2] * a2[e] + gc[3] * a3[e]; \
                v[j][e] = (e < 4 ? h0[e] : h1[e - 4]) + (e < 4 ? ga[e] : gb[e - 4]) * sm; } } \
          \
        { const int t2 = (t) + 3 * NGW; if (t2 < NTOK) cb_load(R, Y, H1, t2, pq[0], lane); \
          gq[0] = gq[1]; gq[1] = gq[2]; gq[2] = gq[3]; CB_ROUTE((t) + 4 * NGW, pq[0], gq[3]); } \
        float sq = 0.f; \
        _Pragma("unroll") for (int j = 0; j < 2; ++j) _Pragma("unroll") for (int e = 0; e < 8; ++e) sq += v[j][e] * v[j][e]; \
        const float rstd = 1.0f / sqrtf(wave_sum(sq) * (1.0f / D) + RMS_EPS); \
        if (l + 1 < DEPTH) { \
            const float* mp = MOD + ((size_t)(l + 1) * BATCH + b) * 6144; \
            _Pragma("unroll") for (int j = 0; j < 2; ++j) { const int c = 8 * lane + 512 * j; \
                u32x4 hw; hw.x = pk2(v[j][0], v[j][1]); hw.y = pk2(v[j][2], v[j][3]); hw.z = pk2(v[j][4], v[j][5]); hw.w = pk2(v[j][6], v[j][7]); \
                *(u32x4*)(H2 + (size_t)(t) * D + c) = hw; \
                float y[8]; \
                _Pragma("unroll") for (int q = 0; q < 2; ++q) { const f32x4 gs = *(const LAS f32x4*)(SCG + b * D + c + 4 * q), hx = *(const LAS f32x4*)(SH1 + b * D + c + 4 * q); \
                    _Pragma("unroll") for (int e = 0; e < 4; ++e) y[4 * q + e] = v[j][4 * q + e] * rstd * gs[e] + hx[e]; } \
                if (MK_P2F8) { u32x2 aw; aw.x = pk4_fp8(y[0] * F8_XSCALE, y[1] * F8_XSCALE, y[2] * F8_XSCALE, y[3] * F8_XSCALE); aw.y = pk4_fp8(y[4] * F8_XSCALE, y[5] * F8_XSCALE, y[6] * F8_XSCALE, y[7] * F8_XSCALE); \
                    *(u32x2*)((unsigned char*)AIN + (size_t)(t) * D + c) = aw; } \
                else { u32x4 aw; aw.x = pk2(y[0], y[1]); aw.y = pk2(y[2], y[3]); aw.z = pk2(y[4], y[5]); aw.w = pk2(y[6], y[7]); \
                    *(u32x4*)(AIN + (size_t)(t) * D + c) = aw; } } \
        } else { \
            _Pragma("unroll") for (int j = 0; j < 2; ++j) { const int c = 8 * lane + 512 * j; \
                _Pragma("unroll") for (int q = 0; q < 2; ++q) { const f32x4 gv = *(const LAS f32x4*)(SCG + c + 4 * q); f32x4 o; \
                    _Pragma("unroll") for (int e = 0; e < 4; ++e) o[e] = v[j][4 * q + e] * rstd * gv[e]; \
                    *(f32x4*)(outp + (size_t)(t) * D + c + 4 * q) = o; } } \
        } } while (0)
    for (int t = gw; t < NTOK; t += 3 * NGW) {
        CB_STEP(RA, t);
        if (t + NGW < NTOK) CB_STEP(RB, t + NGW);
        if (t + 2 * NGW < NTOK) CB_STEP(RC, t + 2 * NGW);
    }
#undef CB_STEP
#undef CB_ROUTE
}

constexpr int PH_PR0 = 0, PH_PR1 = 1, PH_L0 = 2, PH_PER_LAYER = 10, PH_TOTAL = PH_L0 + DEPTH * PH_PER_LAYER;

template <int VARK> __global__ void __launch_bounds__(NTHR, 2) mk_fwd_t(Args args) {
    extern __shared__ __attribute__((aligned(16))) unsigned char lds_raw[];
    Frame F;
    F.lds = (LAS unsigned char*)lds_raw;
    F.MISC = (volatile LAS unsigned*)(F.lds + MISC_OFF);
    F.tid = threadIdx.x; F.lane = F.tid & 63; F.wave = __builtin_amdgcn_readfirstlane(F.tid >> 6);
    F.G = gridDim.x; { const int bx = blockIdx.x; F.vcu = (F.G % 8 == 0) ? (bx % 8) * (F.G / 8) + bx / 8 : bx; }
    F.ws_ = args.ws; F.ctl = (gu32*)(args.ws + WS_CTL);
    for (int u = F.tid; u < (LDS_BYTES - MISC_OFF) / 4; u += NTHR) ((LAS unsigned*)(F.lds + MISC_OFF))[u] = 0u;
    __syncthreads();
    if (F.tid == 0) {
        LAS unsigned long long* pt = (LAS unsigned long long*)(F.lds + MISC_OFF + 64);
#define PT_(i) pt[i] = (unsigned long long)args.in[i]
        PT_(0); PT_(1); PT_(2); PT_(3); PT_(4); PT_(5); PT_(6); PT_(7); PT_(8); PT_(9); PT_(10); PT_(11); PT_(12); PT_(13); PT_(14); PT_(15); PT_(16); PT_(17); PT_(18); PT_(19); PT_(20); PT_(21);
#undef PT_
        pt[IN_POS] = (unsigned long long)args.positions; pt[IN_OUT] = (unsigned long long)args.out;
    }
    __syncthreads();
    XcdBarrier bar; bar.bar = (unsigned*)(F.ctl + CW_BAR); bar.x = 0; bar.st = nullptr; bar.wave = F.wave;
#if !MK_PER_PHASE
    bar = xcd_barrier_post((unsigned*)(F.ctl + CW_BAR), F.MISC + 8, F.wave);
#endif
    const int lo = args.ph_lo, hi = args.ph_hi;
    constexpr int VAR = VARK;
#ifndef MK_EN
#define MK_EN 0x1FFF
#endif
#ifndef MK_VAR_EN
#define MK_VAR_EN 0x1FFF
#endif
#define EN(j) (VARK ? (((MK_VAR_EN) >> (j)) & 1) : (((MK_EN) >> (j)) & 1))
#ifndef MK_REP
#define MK_REP 0
#endif
#define RP(j) _Pragma("unroll 1") for (int rr_ = 0; rr_ <= (((MK_REP) >> (j)) & 1) * MK_REPN; ++rr_)
#ifndef MK_REPN
#define MK_REPN 1
#endif
#define IN(k) (lo <= (k) && (k) < hi)
#if MK_PER_PHASE
#define SEAM(k) do { } while (0)
#else
#define SEAM(k) do { if (IN(k) && IN((k) + 1)) xcd_barrier(bar); } while (0)
#endif
    if (EN(0) && IN(PH_PR0)) RP(0) { phase_pr0(F); } SEAM(PH_PR0);
    if (EN(1) && IN(PH_PR1)) RP(1) { phase_pr1(F); } SEAM(PH_PR1);
#define LAYER_BODY(l) do { \
        const int P = PH_L0 + l * PH_PER_LAYER; \
        if (EN(2) && IN(P + 0)) RP(2) { unsigned char* ws = ws_of(F); \
            pg8::PlainSched S; S.T.init(NTOK / 256, INW / 256, F.G, (int)blockIdx.x); S.A = (const char*)(ws + WS_AIN); S.B = (const char*)(ws + WS_WTIN) + (size_t)l * INW * D * (MK_P2F8 ? 1 : 2); S.K = MK_P2F8 ? D / 2 : D; \
            pg8::EpiIn E{(bf16*)(ws + WS_QB), (bf16*)(ws + WS_KB), (bf16*)(ws + WS_VB), (bf16*)(ws + WS_UB), (bf16*)(ws + WS_VGB), (bf16*)(ws + WS_GB), (const float*)(ws + WS_ROPEC), (const float*)(ws + WS_ROPES)}; \
            pg8::gemm_phase<pg8::EpiIn, pg8::PlainSched, false, MK_P2F8 != 0>(F.lds, MK_P2F8 ? D / 2 : D, S, E, nullptr, nullptr, F.wave, VAR); \
            if (MK_TAILCVT) { if (l == 0) cvt_tail(F, 0, (NTOK / 256) * (INW / 256), 0); else if (tail_idle_cnt((NTOK / 256) * (INW / 256), F.G) > 0 && (int)blockIdx.x >= ((NTOK / 256) * (INW / 256)) % F.G) cvt_tail(F, 3, (NTOK / 256) * (INW / 256), load_nM0(F)); } \
        } \
        SEAM(P + 0); \
        if (EN(3) && IN(P + 1)) RP(3) { phase_attn(F); } \
        SEAM(P + 1); \
        if (EN(4) && IN(P + 2)) RP(4) { phase_gmlp(F, l); } \
        if (EN(5) && IN(P + 2)) RP(5) { phase_merge(F); } \
        SEAM(P + 2); \
        if (EN(6) && IN(P + 3)) RP(6) { unsigned char* ws = ws_of(F); \
            pg8::PlainSched S; S.T.init(NTOK / 256, D / 256, F.G, (int)blockIdx.x); S.A = (const char*)(ws + WS_ATT); S.B = (const char*)(ws + WS_WTPA) + (size_t)l * D * AW * (MK_P4F8 ? 1 : 2); S.K = MK_P4F8 ? AW / 2 : AW; \
            pg8::EpiMrg E{(const bf16*)(ws + WS_GB), (bf16*)(ws + WS_MRG)}; \
            pg8::gemm_phase<pg8::EpiMrg, pg8::PlainSched, false, MK_P4F8 != 0, (MK_P4F8 ? AO / 128 : AO / 64)>(F.lds, MK_P4F8 ? AW / 2 : AW, S, E, nullptr, nullptr, F.wave, VAR); \
        } \
        SEAM(P + 3); \
        if (EN(7) && IN(P + 4)) RP(7) { unsigned char* ws = ws_of(F); const float* MODl = (const float*)(ws + WS_MOD) + (size_t)l * BATCH * 6144; \
            pg8::PlainSched S; S.T.init(NTOK / 256, D / 256, F.G, (int)blockIdx.x); S.A = (const char*)(ws + WS_MRG); S.B = (const char*)(ws + WS_WTO) + (size_t)l * D * D * (MK_P5F8 ? 1 : 2); S.K = MK_P5F8 ? D / 2 : D; \
            pg8::EpiRes E{inp(F, IN_X), l == 0 ? (const bf16*)nullptr : (const bf16*)(ws + WS_HB2), (bf16*)(ws + WS_HB1), MODl + 2 * 1024}; \
            pg8::gemm_phase<pg8::EpiRes, pg8::PlainSched, false, MK_P5F8 != 0>(F.lds, MK_P5F8 ? D / 2 : D, S, E, nullptr, nullptr, F.wave, VAR); \
        } \
        SEAM(P + 4); \
        if (EN(8) && IN(P + 5)) RP(8) { phase_router(F, l); } \
        SEAM(P + 5); \
        if (EN(9) && IN(P + 6)) RP(9) { phase_positions(F, l); } \
        if (MK_TAILCVT && l == 1 && IN(P + 6)) { const int nM0_ = load_nM0(F); cvt_catch(F, stage_pos(6, nM0_, F.G), QD1); }         \
        SEAM(P + 6); \
        if (IN(P + 7) || IN(P + 8)) phase_loadtab(F); \
        if (EN(10) && IN(P + 7)) RP(10) { unsigned char* ws = ws_of(F); \
            LAS int* tab = (LAS int*)(F.lds + TAB_OFF); \
            pg8::MoeSched S; S.T.init(tab[96], 2048 / 256, F.G, (int)blockIdx.x); S.A = (const char*)(ws + WS_AIN); S.B = (const char*)(ws + WS_W1T) + (size_t)l * NE * 2048 * D; S.K = D / 2; S.bstride = (size_t)2048 * D; S.tab = tab; S.gather = true; S.load(); \
            pg8::EpiSwiglu E{(const float*)(ws + WS_B1P) + (size_t)l * NE * 2048, (unsigned char*)(ws + WS_ACT)}; \
            pg8::gemm_phase<pg8::EpiSwiglu, pg8::MoeSched, true, true>(F.lds, D / 2, S, E, (const int*)(ws + WS_SORT), (LAS int*)(F.lds + IDX_OFF), F.wave, VAR); \
            if (MK_TAILCVT) { if (l == 0) { cvt_tail(F, 1, tab[96] * (2048 / 256), tab[96]); cvt_catch(F, stage_pos(5, tab[96], F.G), QD0); } \
                else { const int nwg_ = tab[96] * (2048 / 256), rem_ = nwg_ % F.G, cap4_ = tail_idle_cnt(nwg_, F.G) * NWAVES * tail_ipw(4); const bool idle_ = rem_ > 0 && (int)blockIdx.x >= rem_; \
                    if (idle_ || cap4_ < NQ - QD1) { const int nM0_ = load_nM0(F); if (idle_) cvt_tail(F, 4, nwg_, nM0_); if (cap4_ < NQ - QD1) cvt_catch(F, stage_pos(4, nM0_, F.G) + cap4_, NQ); } } } \
        } \
        SEAM(P + 7); \
        if (EN(11) && IN(P + 8)) RP(11) { unsigned char* ws = ws_of(F); \
            LAS int* tab = (LAS int*)(F.lds + TAB_OFF); \
            pg8::MoeSched S; S.T.init(tab[96], D / 256, F.G, (int)blockIdx.x); S.A = (const char*)(ws + WS_ACT); S.B = (const char*)(ws + WS_W2T) + (size_t)l * NE * D * DFF; S.K = DFF / 2; S.bstride = (size_t)D * DFF; S.tab = tab; S.gather = false; S.load(); \
            pg8::EpiY E{inp(F, IN_B2) + (size_t)l * NE * D, (unsigned char*)(ws + WS_Y)}; \
            pg8::gemm_phase<pg8::EpiY, pg8::MoeSched, false, true>(F.lds, DFF / 2, S, E, nullptr, nullptr, F.wave, VAR); \
            if (MK_TAILCVT && l == 0) cvt_tail(F, 2, tab[96] * (D / 256), tab[96]); \
        } \
        SEAM(P + 8); \
        if (EN(12) && IN(P + 9)) RP(12) { phase_combine(F, l); } \
        if (l + 1 < DEPTH) SEAM(P + 9); \
    } while (0)
    LAYER_BODY(0);
    LAYER_BODY(1);
#undef LAYER_BODY
#undef IN
#undef SEAM
}

#define mk_fwd mk_fwd_t<0>
extern "C" void kernel_launch(void* const* d_in, const int* in_sizes, int n_in, void* d_out, int out_size, void* d_ws, size_t ws_size, hipStream_t stream) {
    static int grid = 0;
    if (grid == 0) {
        if (n_in != 22 || in_sizes[0] != NTOK * D || out_size != NTOK * D || ws_size < WS_END) { fprintf(stderr, "kernel_launch: unexpected shapes (n_in %d, in0 %d, out %d, ws %zu)\n", n_in, n_in > 0 ? in_sizes[0] : -1, out_size, ws_size); grid = -1; return; }
        int dev = 0, cus = 0, per_cu = 0;
        if (hipGetDevice(&dev) != hipSuccess || hipDeviceGetAttribute(&cus, hipDeviceAttributeMultiprocessorCount, dev) != hipSuccess) { grid = -1; return; }
#ifdef MK_VARIANT
        (void)hipFuncSetAttribute((const void*)mk_fwd_t<MK_VARIANT>, hipFuncAttributeMaxDynamicSharedMemorySize, LDS_BYTES);
#endif
        if (hipFuncSetAttribute((const void*)mk_fwd, hipFuncAttributeMaxDynamicSharedMemorySize, LDS_BYTES) != hipSuccess) { fprintf(stderr, "kernel_launch: hipFuncSetAttribute failed\n"); grid = -1; return; }
        if (hipOccupancyMaxActiveBlocksPerMultiprocessor(&per_cu, (const void*)mk_fwd, NTHR, LDS_BYTES) != hipSuccess || per_cu < 1) fprintf(stderr, "kernel_launch: occupancy query reports %d\n", per_cu);
        (void)hipGetLastError();
        grid = cus;
    }
    if (grid < 0) return;
    if (hipMemsetAsync((char*)d_ws + WS_CTL, 0, CTL_ZERO_BYTES, stream) != hipSuccess) return;
    Args a{};
    for (int i = 0; i < 22; ++i) a.in[i] = (const float*)d_in[i];
    a.positions = (const int*)d_in[IN_POS]; a.out = (float*)d_out; a.ws = (unsigned char*)d_ws;
#if MK_PER_PHASE
    for (int p = 0; p < PH_TOTAL; ++p) { a.ph_lo = p; a.ph_hi = p + 1; hipLaunchKernelGGL(mk_fwd, dim3(grid), dim3(NTHR), LDS_BYTES, stream, a);
#ifdef MK_HREP
        { const int ty = p < 2 ? p : 2 + (p - 2) % PH_PER_LAYER; if (ty == MK_HREP) {

#ifdef MK_VARIANT
            hipLaunchKernelGGL(mk_fwd_t<MK_VARIANT>, dim3(grid), dim3(NTHR), LDS_BYTES, stream, a);
#else
            hipLaunchKernelGGL(mk_fwd, dim3(grid), dim3(NTHR), LDS_BYTES, stream, a);
#endif
        } }
#endif
    }
#else
    a.ph_lo = 0; a.ph_hi = PH_TOTAL; hipLaunchKernelGGL(mk_fwd, dim3(grid), dim3(NTHR), LDS_BYTES, stream, a);
#endif
}
```
